# Optimizing an MI355X kernel written in HIP

```python
import jax, jax.numpy as jnp
from jax import lax
import numpy as np

D_MODEL = 2048
BATCH = 4
SEQ = 4096
DEPTH = 4

CHUNK = 64
N_A_LAYERS = DEPTH // 2
N_B_LAYERS = DEPTH - N_A_LAYERS
HG_KDIM = 128
HG_HEADS = D_MODEL // HG_KDIM
HG_VDIM = D_MODEL // HG_HEADS
HG_FDIM = HG_HEADS * HG_KDIM
HG_BLOCK = CHUNK // 4
FOX_HDIM = 128
FOX_HEADS = D_MODEL // FOX_HDIM
Q_BLOCK = 128
FORGET_BIAS_INIT = 2.0
EPS = 1e-6

kernel_name = "hgrn2_fox_yoco_streaming_trunk"


def rmsnorm(x, w):
    xf = x.astype(jnp.float32)
    y = xf * lax.rsqrt(jnp.mean(xf * xf, axis=-1, keepdims=True) + EPS)
    return (y * w.astype(jnp.float32)).astype(x.dtype)


def head_rmsnorm(x, w):
    xf = x.astype(jnp.float32)
    return xf * lax.rsqrt(jnp.mean(xf * xf, axis=-1, keepdims=True) + EPS) * w.astype(jnp.float32)


def hgrn2_chunkwise(q, k, v, g):
    B, H, T, dk = q.shape
    dv = v.shape[-1]
    n = T // HG_BLOCK

    def to_blocks(a):
        return jnp.moveaxis(a.reshape(B, H, n, HG_BLOCK, a.shape[-1]), 2, 0)

    mask = jnp.tril(jnp.ones((HG_BLOCK, HG_BLOCK), dtype=bool))[:, :, None]

    def step(S, blk):
        qc, kc, vc, gc = blk
        b = jnp.cumsum(gc, axis=-2)
        diff = b[..., :, None, :] - b[..., None, :, :]
        decay = jnp.exp(jnp.where(mask, diff, -jnp.inf))
        A = jnp.einsum('bhtd,bhsd,bhtsd->bhts', qc, kc, decay)
        o = (jnp.einsum('bhts,bhse->bhte', A, vc)
             + jnp.einsum('bhtd,bhde->bhte', qc * jnp.exp(b), S))
        b_last = b[..., -1:, :]
        S = (jnp.exp(b_last[..., 0, :])[..., None] * S
             + jnp.einsum('bhsd,bhse->bhde', kc * jnp.exp(b_last - b), vc))
        return S, o

    S0 = jnp.zeros((B, H, dk, dv), jnp.float32)
    _, o = lax.scan(step, S0, (to_blocks(q), to_blocks(k), to_blocks(v), to_blocks(g)))
    return jnp.moveaxis(o, 0, 2).reshape(B, H, T, dv)


def hgrn2_layer(x, norm_w, w_in, lb, out_norm_w, w_out):
    B, T, _ = x.shape
    h = rmsnorm(x, norm_w)
    proj = h @ w_in
    q = proj[..., :HG_FDIM]
    fz = proj[..., HG_FDIM:2 * HG_FDIM]
    i = proj[..., 2 * HG_FDIM:2 * HG_FDIM + D_MODEL]
    gate = proj[..., 2 * HG_FDIM + D_MODEL:]
    heads_k = lambda a: a.reshape(B, T, HG_HEADS, HG_KDIM).astype(jnp.float32).transpose(0, 2, 1, 3)
    q, fz = heads_k(q), heads_k(fz)
    i = i.reshape(B, T, HG_HEADS, HG_VDIM).astype(jnp.float32).transpose(0, 2, 1, 3)
    lb = lb.reshape(HG_HEADS, 1, HG_KDIM)
    log_f = jnp.logaddexp(jnp.log(lb), jnp.log1p(-lb) + jax.nn.log_sigmoid(fz))
    k = (1.0 - lb) * jax.nn.sigmoid(-fz)
    o = hgrn2_chunkwise(q, k, i, log_f)
    o = head_rmsnorm(o.transpose(0, 2, 1, 3), out_norm_w.reshape(HG_HEADS, HG_VDIM))
    o = o.reshape(B, T, D_MODEL) * jax.nn.silu(gate.astype(jnp.float32))
    return x + (o.astype(x.dtype) @ w_out)


def shared_kv(x, norm_w, w_kvf, f_bias, k_norm_w):
    B, T, _ = x.shape
    h = rmsnorm(x, norm_w)
    kvf = h @ w_kvf
    k = kvf[..., :D_MODEL].reshape(B, T, FOX_HEADS, FOX_HDIM)
    v = kvf[..., D_MODEL:2 * D_MODEL].reshape(B, T, FOX_HEADS, FOX_HDIM)
    fz = kvf[..., 2 * D_MODEL:].astype(jnp.float32) + f_bias.astype(jnp.float32)
    k = head_rmsnorm(k, k_norm_w).transpose(0, 2, 1, 3)
    v = v.astype(jnp.float32).transpose(0, 2, 1, 3)
    F = jnp.cumsum(jax.nn.log_sigmoid(fz), axis=1).transpose(0, 2, 1)
    return k, v, F


def forgetting_attention(q, k, v, F):
    T = q.shape[2]
    scale = FOX_HDIM ** -0.5
    local = jnp.arange(Q_BLOCK)
    outs = []
    for blk in range(T // Q_BLOCK):
        q0 = blk * Q_BLOCK
        kend = q0 + Q_BLOCK
        s = (jnp.einsum('bhqd,bhkd->bhqk', q[:, :, q0:kend], k[:, :, :kend]) * scale
             + F[:, :, q0:kend, None] - F[:, :, None, :kend])
        causal = (q0 + local)[:, None] >= jnp.arange(kend)[None, :]
        p = jax.nn.softmax(jnp.where(causal, s, -jnp.inf), axis=-1)
        outs.append(jnp.einsum('bhqk,bhkd->bhqd', p, v[:, :, :kend]))
    return jnp.concatenate(outs, axis=2)


def fox_layer(x, norm_w, w_in, q_norm_w, out_norm_w, w_out, k, v, F):
    B, T, _ = x.shape
    h = rmsnorm(x, norm_w)
    proj = h @ w_in
    q = proj[..., :D_MODEL].reshape(B, T, FOX_HEADS, FOX_HDIM)
    gate = proj[..., D_MODEL:]
    q = head_rmsnorm(q, q_norm_w).transpose(0, 2, 1, 3)
    o = forgetting_attention(q, k, v, F)
    o = head_rmsnorm(o.transpose(0, 2, 1, 3), out_norm_w.reshape(FOX_HEADS, FOX_HDIM))
    o = o.reshape(B, T, D_MODEL) * jax.nn.silu(gate.astype(jnp.float32))
    return x + (o.astype(x.dtype) @ w_out)


def setup_inputs(seed: int = 0) -> dict:
    key = jax.random.key(seed)
    ks = jax.random.split(key, 16)
    D = D_MODEL
    s = D ** -0.5
    nrm = jax.random.normal
    return {
        "x": nrm(ks[0], (BATCH, SEQ, D), jnp.float32),
        "a_norm_w": 1.0 + 0.02 * nrm(ks[1], (N_A_LAYERS, D), jnp.float32),
        "a_w_in": s * nrm(ks[2], (N_A_LAYERS, D, 2 * HG_FDIM + 2 * D), jnp.float32),
        "a_lb_logits": 0.1 * nrm(ks[3], (N_A_LAYERS, HG_FDIM), jnp.float32),
        "a_out_norm_w": 1.0 + 0.02 * nrm(ks[4], (N_A_LAYERS, D), jnp.float32),
        "a_w_out": s * nrm(ks[5], (N_A_LAYERS, D, D), jnp.float32),
        "kv_norm_w": 1.0 + 0.02 * nrm(ks[6], (D,), jnp.float32),
        "kv_w": s * nrm(ks[7], (D, 2 * D + FOX_HEADS), jnp.float32),
        "kv_f_bias": FORGET_BIAS_INIT + 0.1 * nrm(ks[8], (FOX_HEADS,), jnp.float32),
        "k_norm_w": 1.0 + 0.02 * nrm(ks[9], (FOX_HDIM,), jnp.float32),
        "b_norm_w": 1.0 + 0.02 * nrm(ks[10], (N_B_LAYERS, D), jnp.float32),
        "b_w_in": s * nrm(ks[11], (N_B_LAYERS, D, 2 * D), jnp.float32),
        "b_q_norm_w": 1.0 + 0.02 * nrm(ks[12], (N_B_LAYERS, FOX_HDIM), jnp.float32),
        "b_out_norm_w": 1.0 + 0.02 * nrm(ks[13], (N_B_LAYERS, D), jnp.float32),
        "b_w_out": s * nrm(ks[14], (N_B_LAYERS, D, D), jnp.float32),
    }


def reference(x, a_norm_w, a_w_in, a_lb_logits, a_out_norm_w, a_w_out,
              kv_norm_w, kv_w, kv_f_bias, k_norm_w,
              b_norm_w, b_w_in, b_q_norm_w, b_out_norm_w, b_w_out):
    lb_all = jnp.cumsum(jax.nn.softmax(a_lb_logits.astype(jnp.float32), axis=0), axis=0)
    lb_all = lb_all - lb_all[0:1]
    k = v = F = None
    for layer in range(DEPTH):
        if layer < N_A_LAYERS:
            x = hgrn2_layer(x, a_norm_w[layer], a_w_in[layer], lb_all[layer],
                            a_out_norm_w[layer], a_w_out[layer])
        else:
            if layer == N_A_LAYERS:
                k, v, F = shared_kv(x, kv_norm_w, kv_w, kv_f_bias, k_norm_w)
            j = layer - N_A_LAYERS
            x = fox_layer(x, b_norm_w[j], b_w_in[j], b_q_norm_w[j], b_out_norm_w[j],
                          b_w_out[j], k, v, F)
    return x
```

```cpp
#include <hip/hip_runtime.h>
#include <hip/hip_bf16.h>
#include <cstdio>
#include <cstdint>
#include <cmath>
namespace pg8 {
#define PG8_LAS __attribute__((address_space(3)))
typedef unsigned short bf16_t;
typedef short bf16x8 __attribute__((ext_vector_type(8)));
typedef float f32x4 __attribute__((ext_vector_type(4)));
typedef unsigned u32x4 __attribute__((ext_vector_type(4)));
constexpr int BM = 256, BK = 64, HALF = 128, HTB = HALF * BK * 2  , STAGE_BYTES = 8 * HTB, NXCD = 8, WGM = 8;

__host__ __device__ __forceinline__ int lds_byte(int r, int c) { const int st = (r >> 4) * 2 + (c >> 5), rr = r & 15, cc = c & 31, ob = rr * 64 + cc * 2; return st * 1024 + (ob ^ (((ob >> 9) & 1) << 5)); }
__host__ __device__ __forceinline__ void stage_rc(int b, int& R, int& C) { const int st = b / 1024, sb = b % 1024, swz = sb ^ (((sb >> 9) & 1) << 5); R = (st >> 1) * 16 + swz / 64; C = (st & 1) * 32 + (swz % 64) / 2; }
__host__ __device__ __forceinline__ int perm32(int rho) { const int n = rho >> 4, i = rho & 15; return 8 * (i >> 2) + 4 * n + (i & 3); }

struct Unit { int pm, pn; };
struct Gemm { const bf16_t* A; const bf16_t* Bt; int M, N, K; };

struct StaticOrder {
    int nM, nN, nwg, G, c;
    __host__ __device__ void init(int M, int N, int G_, int c_) { nM = M / BM; nN = N / BM; nwg = nM * nN; G = G_; c = c_; }
    __host__ __device__ bool next(int i, Unit& u) const {
        const long L = (long)i * G + c; if (L >= nwg) return false;
        int wgid = (int)L; { const int q = nwg / NXCD, r = nwg % NXCD, xcd = wgid % NXCD, off = wgid / NXCD; wgid = (xcd < r ? xcd * (q + 1) : r * (q + 1) + (xcd - r) * q) + off; }
        const int nig = WGM * nN, gid = wgid / nig, fm = gid * WGM, gsz = (nM - fm) < WGM ? (nM - fm) : WGM;
        u.pm = fm + ((wgid % nig) % gsz); u.pn = (wgid % nig) / gsz; return true;
    }
    __device__ __forceinline__ void a_ready(const Unit&) const {}
    __device__ __forceinline__ void done(const Unit&) const {}
};

__device__ __forceinline__ unsigned cvt_pk_bf16(float lo, float hi) { unsigned r; asm volatile("v_cvt_pk_bf16_f32 %0, %1, %2" : "=v"(r) : "v"(lo), "v"(hi)); return r; }
typedef float f32x2 __attribute__((ext_vector_type(2)));
__device__ __forceinline__ f32x2 gelu_pk(f32x2 v) {
    const f32x2 av = __builtin_elementwise_abs(v), d = av * 0.2316418882f + 1.0f;
    f32x2 t; t.x = __builtin_amdgcn_rcpf(d.x); t.y = __builtin_amdgcn_rcpf(d.y);
    f32x2 q = t * 0.5307027145f + (-0.7265760135f); q = q * t + 0.7107068705f; q = q * t + (-0.142248368f); q = q * t + 0.127414796f; q = q * t;
    const f32x2 s = (v * v) * (-0.72134752044f);
    f32x2 e; e.x = __builtin_amdgcn_exp2f(s.x); e.y = __builtin_amdgcn_exp2f(s.y);
    const f32x2 m = v * (q * e), r = v - m;
    f32x2 o; o.x = v.x < 0.f ? m.x : r.x; o.y = v.y < 0.f ? m.y : r.y; return o;
}

template <int ACT  > struct EpiBf16 {
    static constexpr bool PERM = true, AFTER_DRAIN = false; static_assert(ACT == 0 || ACT == 1, "EpiBf16: ACT is 0 (none) or 1 (gelu_pk)");
    bf16_t* O; int ldc; const float* bias; int split_cols; size_t split_stride; float scale0;
    __device__ __forceinline__ void operator()(const f32x4 (&acc)[2][2][4][2], const Unit& u, int wr, int wc, int fr, int fq) const {
        const int row0 = u.pm * BM + wr * 64 + fr; int colt = u.pn * BM; bf16_t* base = O;
        float sc = 1.f; if (split_cols) { const int t = colt / split_cols; base += (size_t)t * split_stride; colt -= t * split_cols; if (t == 0) sc = scale0; }
        const int col0 = colt + wc * 32 + 8 * fq, bcol0 = u.pn * BM + wc * 32 + 8 * fq;
        f32x4 bv[2][2];
#pragma unroll
        for (int bj = 0; bj < 2; ++bj)
#pragma unroll
            for (int n = 0; n < 2; ++n) bv[bj][n] = bias ? *(const f32x4*)(bias + bcol0 + bj * HALF + 4 * n) : (f32x4){0.f, 0.f, 0.f, 0.f};
#pragma unroll
        for (int ai = 0; ai < 2; ++ai)
#pragma unroll
            for (int m = 0; m < 4; ++m) { bf16_t* rowp = base + (size_t)(row0 + ai * HALF + m * 16) * ldc + col0;
#pragma unroll
                for (int bj = 0; bj < 2; ++bj) { f32x4 v0 = acc[ai][bj][m][0] + bv[bj][0], v1 = acc[ai][bj][m][1] + bv[bj][1];
                    if (ACT == 1) { f32x2 a = gelu_pk((f32x2){v0[0], v0[1]}), b = gelu_pk((f32x2){v0[2], v0[3]}), c = gelu_pk((f32x2){v1[0], v1[1]}), d = gelu_pk((f32x2){v1[2], v1[3]});
                        v0 = (f32x4){a.x, a.y, b.x, b.y}; v1 = (f32x4){c.x, c.y, d.x, d.y}; }
                    v0 = v0 * sc; v1 = v1 * sc; u32x4 w; w.x = cvt_pk_bf16(v0[0], v0[1]); w.y = cvt_pk_bf16(v0[2], v0[3]); w.z = cvt_pk_bf16(v1[0], v1[1]); w.w = cvt_pk_bf16(v1[2], v1[3]);
                    *(u32x4*)(rowp + bj * HALF) = w; } }
    }
};
struct EpiRes {
    static constexpr bool PERM = false, AFTER_DRAIN = false;
    const float* res; float* out; int ldc;
    __device__ __forceinline__ void operator()(const f32x4 (&acc)[2][2][4][2], const Unit& u, int wr, int wc, int fr, int fq) const {
        const int row0 = u.pm * BM + wr * 64 + fr, col0 = u.pn * BM + wc * 32 + 4 * fq;
#pragma unroll
        for (int ai = 0; ai < 2; ++ai)
#pragma unroll
            for (int m = 0; m < 4; ++m) { const size_t off = (size_t)(row0 + ai * HALF + m * 16) * ldc + col0;
                f32x4 r[2][2];
#pragma unroll
                for (int bj = 0; bj < 2; ++bj)
#pragma unroll
                    for (int n = 0; n < 2; ++n) r[bj][n] = *(const f32x4*)(res + off + bj * HALF + n * 16);
#pragma unroll
                for (int bj = 0; bj < 2; ++bj)
#pragma unroll
                    for (int n = 0; n < 2; ++n) *(f32x4*)(out + off + bj * HALF + n * 16) = r[bj][n] + acc[ai][bj][m][n]; }
    }
};
template <class Epi, class Sched, bool ALIGN_EPI = false, bool SP2 = false>
__device__ __forceinline__ void gemm_phase(PG8_LAS unsigned char* lds, const Gemm g, const Sched& S, const Epi& E) {
    int tid_ = threadIdx.x; asm volatile("" : "+v"(tid_));
    const int tid = tid_, wid = __builtin_amdgcn_readfirstlane(tid >> 6), lane = tid & 63, wr = wid >> 2, wc = wid & 3, fr = lane & 15, fq = lane >> 4;
    const int K = g.K, nt = K / BK;
    unsigned voffA[2], voffB[2];
#pragma unroll
    for (int i = 0; i < 2; ++i) { int R, C; stage_rc(tid * 16 + i * 8192, R, C); const int Rb = Epi::PERM ? ((R & ~31) + perm32(R & 31)) : R;
        voffA[i] = (unsigned)(R * K + C) * 2u; voffB[i] = (unsigned)(Rb * K + C) * 2u; }
    const size_t kstep = (size_t)(BK * 2);
    const size_t hstep = (size_t)HALF * K * 2;
    const size_t tstep = 2 * hstep;
    const unsigned ldsw = (unsigned)wid * 1024u;
    const int aoff = lds_byte(wr * 64 + fr, fq * 8), boff = lds_byte(wc * 32 + fr, fq * 8);
#define PG8_SA(b, h) (((b) * 2 + (h)) * HTB)
#define PG8_SB(b, h) ((4 + (b) * 2 + (h)) * HTB)
#define PG8_STAGE(bufoff, gbase, voff) do { _Pragma("unroll") for (int _i = 0; _i < 2; ++_i) \
        __builtin_amdgcn_global_load_lds((const unsigned*)((const char*)(gbase) + (voff)[_i]), (PG8_LAS unsigned*)(lds + (bufoff) + ldsw + _i * 8192), 16, 0, 0); } while (0)
#define PG8_LDA(dst, b, h) do { _Pragma("unroll") for (int m = 0; m < 4; ++m) _Pragma("unroll") for (int k = 0; k < 2; ++k) dst[m][k] = *(const PG8_LAS bf16x8*)(lds + PG8_SA(b, h) + aoff + m * 2048 + k * 1024); } while (0)
#define PG8_LDB(dst, b, h) do { _Pragma("unroll") for (int n = 0; n < 2; ++n) _Pragma("unroll") for (int k = 0; k < 2; ++k) dst[n][k] = *(const PG8_LAS bf16x8*)(lds + PG8_SB(b, h) + boff + n * 2048 + k * 1024); } while (0)
#define PG8_MMA(ai, bj, At, Bt) do { __builtin_amdgcn_s_setprio(1); _Pragma("unroll") for (int m = 0; m < 4; ++m) _Pragma("unroll") for (int n = 0; n < 2; ++n) _Pragma("unroll") for (int k = 0; k < 2; ++k) \
        acc[ai][bj][m][n] = __builtin_amdgcn_mfma_f32_16x16x32_bf16(Bt[n][k], At[m][k], acc[ai][bj][m][n], 0, 0, 0); __builtin_amdgcn_s_setprio(0); } while (0)
#define PG8_WAIT_V(n) asm volatile("s_waitcnt vmcnt(" #n ")" ::: "memory")
#define PG8_WAIT_L(n) asm volatile("s_waitcnt lgkmcnt(" #n ")" ::: "memory")
#define PG8_BAR __builtin_amdgcn_s_barrier()
#define PG8_SCHED __builtin_amdgcn_sched_barrier(0)
    Unit cur, nxt; int ui = 0;
    if (!S.next(0, cur)) return;
    f32x4 acc[2][2][4][2];
#pragma unroll
    for (int a = 0; a < 2; ++a)
#pragma unroll
        for (int b = 0; b < 2; ++b)
#pragma unroll
            for (int m = 0; m < 4; ++m)
#pragma unroll
                for (int n = 0; n < 2; ++n) acc[a][b][m][n] = (f32x4){0.f, 0.f, 0.f, 0.f};
    bf16x8 At[4][2], B0[2][2], B1[2][2];
    const char* cA = (const char*)g.A + (size_t)cur.pm * tstep; const char* cB = (const char*)g.Bt + (size_t)cur.pn * tstep;
    S.a_ready(cur);
    if constexpr (SP2) {
        PG8_STAGE(PG8_SB(0, 0), cB, voffB); PG8_STAGE(PG8_SB(0, 1), cB + hstep, voffB); PG8_STAGE(PG8_SA(0, 0), cA, voffA); PG8_STAGE(PG8_SA(0, 1), cA + hstep, voffA);
        if (wr == 1) PG8_BAR;
        PG8_WAIT_V(2); PG8_BAR;
        PG8_STAGE(PG8_SB(1, 0), cB + kstep, voffB); PG8_STAGE(PG8_SA(1, 0), cA + kstep, voffA); PG8_STAGE(PG8_SB(1, 1), cB + hstep + kstep, voffB);
        PG8_WAIT_V(6); PG8_BAR;
    } else {
        PG8_STAGE(PG8_SB(0, 0), cB, voffB); PG8_STAGE(PG8_SA(0, 0), cA, voffA); PG8_STAGE(PG8_SB(0, 1), cB + hstep, voffB); PG8_STAGE(PG8_SA(0, 1), cA + hstep, voffA);
        if (wr == 1) PG8_BAR;
        PG8_WAIT_V(4); PG8_BAR;
        PG8_STAGE(PG8_SB(1, 0), cB + kstep, voffB); PG8_STAGE(PG8_SA(1, 0), cA + kstep, voffA); PG8_STAGE(PG8_SB(1, 1), cB + hstep + kstep, voffB);
        PG8_WAIT_V(6); PG8_BAR;
    }
    for (;;) {
        const bool has_next = S.next(ui + 1, nxt);
        const char* nA = has_next ? (const char*)g.A + (size_t)nxt.pm * tstep : cA; const char* nB = has_next ? (const char*)g.Bt + (size_t)nxt.pn * tstep : cB;
        for (int t = 0; t < nt; t += 2) {
            const bool last = (t == nt - 2);
            const char* a1 = cA + (size_t)(t + 1) * kstep;
            const char* a2 = last ? nA : cA + (size_t)(t + 2) * kstep; const char* b2 = last ? nB : cB + (size_t)(t + 2) * kstep;
            const char* a3 = a2 + kstep; const char* b3 = b2 + kstep;
            if (last && has_next) S.a_ready(nxt);
            if constexpr (SP2) {
            PG8_LDB(B0, 0, 0); PG8_LDB(B1, 0, 1); PG8_SCHED; PG8_LDA(At, 0, 0); PG8_STAGE(PG8_SA(1, 1), a1 + hstep, voffA);
            PG8_WAIT_V(8); PG8_WAIT_L(0); PG8_BAR; PG8_MMA(0, 0, At, B0); PG8_MMA(0, 1, At, B1); PG8_BAR; PG8_SCHED;
            PG8_LDA(At, 0, 1); PG8_STAGE(PG8_SB(0, 0), b2, voffB); PG8_STAGE(PG8_SB(0, 1), b2 + hstep, voffB); PG8_STAGE(PG8_SA(0, 0), a2, voffA);
            PG8_WAIT_V(8); PG8_WAIT_L(0); PG8_BAR; PG8_MMA(1, 0, At, B0); PG8_MMA(1, 1, At, B1); PG8_BAR; PG8_SCHED;
            PG8_LDB(B0, 1, 0); PG8_LDB(B1, 1, 1); PG8_SCHED; PG8_LDA(At, 1, 0); PG8_STAGE(PG8_SA(0, 1), a2 + hstep, voffA);
            PG8_WAIT_V(8); PG8_WAIT_L(0); PG8_BAR; PG8_MMA(0, 0, At, B0); PG8_MMA(0, 1, At, B1); PG8_BAR; PG8_SCHED;
            PG8_LDA(At, 1, 1); PG8_STAGE(PG8_SB(1, 0), b3, voffB); PG8_STAGE(PG8_SB(1, 1), b3 + hstep, voffB); PG8_STAGE(PG8_SA(1, 0), a3, voffA);
            PG8_WAIT_V(8); PG8_WAIT_L(0); PG8_BAR; PG8_MMA(1, 0, At, B0); PG8_MMA(1, 1, At, B1); PG8_BAR; PG8_SCHED;
            } else {
            PG8_LDB(B0, 0, 0); PG8_SCHED; PG8_LDA(At, 0, 0); PG8_STAGE(PG8_SA(1, 1), a1 + hstep, voffA);
            PG8_WAIT_L(8); PG8_BAR; PG8_WAIT_L(0); PG8_MMA(0, 0, At, B0); PG8_BAR; PG8_SCHED;
            PG8_LDB(B1, 0, 1); PG8_STAGE(PG8_SB(0, 0), b2, voffB);
            PG8_BAR; PG8_WAIT_L(0); PG8_MMA(0, 1, At, B1); PG8_BAR;
            PG8_LDA(At, 0, 1); PG8_STAGE(PG8_SA(0, 0), a2, voffA);
            PG8_BAR; PG8_WAIT_L(0); PG8_MMA(1, 0, At, B0); PG8_BAR; PG8_SCHED;
            PG8_STAGE(PG8_SB(0, 1), b2 + hstep, voffB);
            PG8_WAIT_V(6); PG8_BAR; PG8_MMA(1, 1, At, B1); PG8_BAR;
            PG8_LDB(B0, 1, 0); PG8_SCHED; PG8_LDA(At, 1, 0); PG8_STAGE(PG8_SA(0, 1), a2 + hstep, voffA);
            PG8_WAIT_L(8); PG8_BAR; PG8_WAIT_L(0); PG8_MMA(0, 0, At, B0); PG8_BAR; PG8_SCHED;
            PG8_LDB(B1, 1, 1); PG8_STAGE(PG8_SB(1, 0), b3, voffB);
            PG8_BAR; PG8_WAIT_L(0); PG8_MMA(0, 1, At, B1); PG8_BAR;
            PG8_LDA(At, 1, 1); PG8_STAGE(PG8_SA(1, 0), a3, voffA);
            PG8_BAR; PG8_WAIT_L(0); PG8_MMA(1, 0, At, B0); PG8_BAR; PG8_SCHED;
            PG8_STAGE(PG8_SB(1, 1), b3 + hstep, voffB);
            PG8_WAIT_V(6); PG8_BAR; PG8_MMA(1, 1, At, B1); PG8_BAR;
            }
        }
        if constexpr (ALIGN_EPI) { if (wr == 0) PG8_BAR; }
        if constexpr (!Epi::AFTER_DRAIN) { E(acc, cur, wr, wc, fr, fq); S.done(cur); }
        if (!has_next) break;
#pragma unroll
        for (int a = 0; a < 2; ++a)
#pragma unroll
            for (int b = 0; b < 2; ++b)
#pragma unroll
                for (int m = 0; m < 4; ++m)
#pragma unroll
                    for (int n = 0; n < 2; ++n) acc[a][b][m][n] = (f32x4){0.f, 0.f, 0.f, 0.f};
        cur = nxt; cA = nA; cB = nB; ++ui;
        if constexpr (ALIGN_EPI) { if (wr == 1) PG8_BAR; }
    }
    PG8_WAIT_V(0);
    if constexpr (!ALIGN_EPI) { if (wr == 0) PG8_BAR; }
    PG8_BAR;
    if constexpr (Epi::AFTER_DRAIN) { E.fused(acc, cur, wr, wc, fr, fq, lds, wid, lane); S.done(cur); }
#undef PG8_SA
#undef PG8_SB
#undef PG8_STAGE
#undef PG8_LDA
#undef PG8_LDB
#undef PG8_MMA
#undef PG8_WAIT_V
#undef PG8_WAIT_L
#undef PG8_BAR
#undef PG8_SCHED
}
}
namespace fox {
constexpr int ALD = 2048;
constexpr int AD = 128;
constexpr float SCALE = 0.08838834764831845f;
constexpr float INVS = 11.313708498984761f;
constexpr float THR = 8.f;
constexpr int NW = 8, QBLK = 32, KVBLK = 64, QB = NW * QBLK;
constexpr int SHM_V = KVBLK * AD * 2, SHM_K = KVBLK * AD * 2;
constexpr int LDS_F = 2 * SHM_V + 2 * SHM_K + NW * 64 * 4;
constexpr int LDS_BYTES = LDS_F + 2 * 256;

using bf16 = __hip_bfloat16;
typedef short bf16x8 __attribute__((ext_vector_type(8)));
typedef short s16x4 __attribute__((ext_vector_type(4)));
typedef float f32x16 __attribute__((ext_vector_type(16)));
typedef float f32x4 __attribute__((ext_vector_type(4)));
typedef unsigned u32x4 __attribute__((ext_vector_type(4)));

#define KSWZ(row, colB) ((row) * 256 + ((colB) ^ (((row) & 7) << 4)))
#define SBAR() __builtin_amdgcn_sched_barrier(0)
__device__ __forceinline__ int v_st(int k, int c) { const int kk = (k & ~0xC) | ((k & 4) << 1) | ((k & 8) >> 1); return ((kk >> 3) * 4 + (c >> 5)) * 512 + ((kk & 7) * 32 + (c & 31)) * 2; }
__device__ __forceinline__ int v_rd_base(int lane) { return ((lane & 3) << 3) | (((lane >> 2) & 3) << 6) | (((lane >> 4) & 1) << 5) | (((lane >> 5) & 1) << 8); }
constexpr int v_rd_off(int d0, int ks, int half) { return d0 * 512 + ks * 4096 + half * 2048; }
__device__ __forceinline__ int crow(int r, int hi) { return (r & 3) + 8 * (r >> 2) + 4 * hi; }
__device__ __forceinline__ unsigned cvtpk(float lo, float hi) {
    unsigned r; asm volatile("v_cvt_pk_bf16_f32 %0, %1, %2" : "=v"(r) : "v"(lo), "v"(hi)); return r;
}
typedef __amdgpu_buffer_rsrc_t rsrc_t;
__device__ __forceinline__ rsrc_t mk_rsrc(const void* p) { return __builtin_amdgcn_make_buffer_rsrc((void*)p, (short)0, 0x7ffffff0, 0x00020000); }
__device__ __forceinline__ bf16x8 ldb8(rsrc_t r, int voff, int soff) { return __builtin_bit_cast(bf16x8, __builtin_amdgcn_raw_buffer_load_b128(r, voff, soff, 0)); }
__device__ __forceinline__ f32x4 ldf4(rsrc_t r, int voff, int soff) { return __builtin_bit_cast(f32x4, __builtin_amdgcn_raw_buffer_load_b128(r, voff, soff, 0)); }
__device__ __forceinline__ void mask_tile(f32x16& p0, f32x16& p1, int dq, unsigned W) {
    const float NEG = -__builtin_inff();
#pragma unroll
    for (int r = 0; r < 16; ++r) {
        const int c = (r & 3) + 8 * (r >> 2);
        if ((unsigned)(dq - c) >= W) p0[r] = NEG;
        if ((unsigned)(dq - c - 32) >= W) p1[r] = NEG;
    }
}
__device__ __forceinline__ void partialSM(f32x16& p0, f32x16& p1, float& m_reg, float& mn, float& alpha) {
    float pmax = p0[0]; for (int r = 1; r < 16; ++r) pmax = fmaxf(pmax, p0[r]); for (int r = 0; r < 16; ++r) pmax = fmaxf(pmax, p1[r]);
    { auto rr = __builtin_amdgcn_permlane32_swap(__float_as_uint(pmax), __float_as_uint(pmax), false, false);
      pmax = fmaxf(__uint_as_float(rr[0]), __uint_as_float(rr[1])); }
    constexpr float C2 = 1.4426950408889634f * SCALE;
    if (__builtin_expect(__all((pmax - m_reg) * SCALE <= THR), 1)) { mn = m_reg; alpha = 1.f; }
    else { mn = fmaxf(m_reg, pmax); alpha = __builtin_amdgcn_exp2f((m_reg - mn) * C2); m_reg = mn; }
    const float mnL = -mn * C2;
    for (int r = 0; r < 16; ++r) p0[r] = fmaf(p0[r], C2, mnL); for (int r = 0; r < 16; ++r) p1[r] = fmaf(p1[r], C2, mnL);
    for (int r = 0; r < 16; ++r) p0[r] = __builtin_amdgcn_exp2f(p0[r]);
}
__device__ __forceinline__ void finishSM(f32x16& p0, f32x16& p1, float alpha, float& l_reg, bf16x8& pa0, bf16x8& pa1, bf16x8& pa2, bf16x8& pa3) {
    for (int r = 0; r < 16; ++r) p1[r] = __builtin_amdgcn_exp2f(p1[r]);
    float ps = 0; for (int r = 0; r < 16; ++r) ps += p0[r]; for (int r = 0; r < 16; ++r) ps += p1[r];
    { auto rr = __builtin_amdgcn_permlane32_swap(__float_as_uint(ps), __float_as_uint(ps), false, false);
      ps = __uint_as_float(rr[0]) + __uint_as_float(rr[1]); }
    l_reg = l_reg * alpha + ps;
#define PK4(P, B_, OUT) do { unsigned a0 = cvtpk(P[B_+0], P[B_+1]), a1 = cvtpk(P[B_+2], P[B_+3]);                          \
        unsigned b0 = cvtpk(P[B_+4], P[B_+5]), b1 = cvtpk(P[B_+6], P[B_+7]);                                             \
        auto r0 = __builtin_amdgcn_permlane32_swap(a0, b0, false, false); auto r1 = __builtin_amdgcn_permlane32_swap(a1, b1, false, false); \
        u32x4 w = {r0[0], r1[0], r0[1], r1[1]}; OUT = *reinterpret_cast<bf16x8*>(&w); } while (0)
    PK4(p0, 0, pa0); PK4(p0, 8, pa1); PK4(p1, 0, pa2); PK4(p1, 8, pa3);
#undef PK4
}
template <int KB>
__device__ __forceinline__ void qkt(f32x16& p0, f32x16& p1, const char* K_lds, const char* F_lds, int r32, int hi, const bf16x8* qr) {
    { const f32x4* fk = reinterpret_cast<const f32x4*>(F_lds + KB * 256);
#pragma unroll
      for (int g = 0; g < 4; ++g) { const f32x4 a = fk[2 * g + hi], b = fk[8 + 2 * g + hi];
#pragma unroll
          for (int e = 0; e < 4; ++e) { p0[4 * g + e] = a[e]; p1[4 * g + e] = b[e]; } } }
    const char* kb[4];
#pragma unroll
    for (int dd = 0; dd < 4; ++dd) kb[dd] = K_lds + KB * SHM_K + KSWZ(r32, (dd * 16 + hi * 8) * 2);
#pragma unroll
    for (int d0 = 0; d0 < 8; ++d0) { const char* a = kb[d0 & 3] + (d0 >> 2) * 128;
        bf16x8 b0 = *reinterpret_cast<const bf16x8*>(a);
        bf16x8 b1 = *reinterpret_cast<const bf16x8*>(a + 32 * 256);
        p0 = __builtin_amdgcn_mfma_f32_32x32x16_bf16(b0, qr[d0], p0, 0, 0, 0);
        p1 = __builtin_amdgcn_mfma_f32_32x32x16_bf16(b1, qr[d0], p1, 0, 0, 0); }
}
template <int VB>
__device__ __forceinline__ void pv_tile(f32x16* o, int vb0, bf16x8 pa0, bf16x8 pa1, bf16x8 pa2, bf16x8 pa3) {
#define TRRD(dst, off) asm volatile("ds_read_b64_tr_b16 %0, %1 offset:%2" : "=&v"(dst) : "v"(vb0), "i"(off) : "memory")
#define PV_D0(d0) do { s16x4 l0, l1, l2, l3, h0, h1, h2, h3; constexpr int b_ = VB * SHM_V + v_rd_off(d0, 0, 0);     \
        TRRD(l0, b_); TRRD(h0, b_ + 2048); TRRD(l1, b_ + 4096); TRRD(h1, b_ + 6144); TRRD(l2, b_ + 8192); TRRD(h2, b_ + 10240); TRRD(l3, b_ + 12288); TRRD(h3, b_ + 14336); \
        asm volatile("s_waitcnt lgkmcnt(0)" ::: "memory"); SBAR();                 \
        o[d0] = __builtin_amdgcn_mfma_f32_32x32x16_bf16(pa0, (bf16x8){l0[0], l0[1], l0[2], l0[3], h0[0], h0[1], h0[2], h0[3]}, o[d0], 0, 0, 0);   \
        o[d0] = __builtin_amdgcn_mfma_f32_32x32x16_bf16(pa1, (bf16x8){l1[0], l1[1], l1[2], l1[3], h1[0], h1[1], h1[2], h1[3]}, o[d0], 0, 0, 0);   \
        o[d0] = __builtin_amdgcn_mfma_f32_32x32x16_bf16(pa2, (bf16x8){l2[0], l2[1], l2[2], l2[3], h2[0], h2[1], h2[2], h2[3]}, o[d0], 0, 0, 0);   \
        o[d0] = __builtin_amdgcn_mfma_f32_32x32x16_bf16(pa3, (bf16x8){l3[0], l3[1], l3[2], l3[3], h3[0], h3[1], h3[2], h3[3]}, o[d0], 0, 0, 0); } while (0)
    PV_D0(0); PV_D0(1); PV_D0(2); PV_D0(3);
#undef PV_D0
#undef TRRD
}

struct BlockRef { const bf16* Q; const bf16* K; const bf16* V; bf16* O; const float* F; int P0; };
struct Seam {
    bf16x8 qr[8];
    bf16x8 st_v0, st_v1, st_k0, st_k1; f32x4 st_f;
};
#define VMW() asm volatile("s_waitcnt vmcnt(0)" ::: "memory")
#define VMWN(n) asm volatile("s_waitcnt vmcnt(%0)" :: "i"(n) : "memory")
#define SLOAD_H(rK_, rV_, rF_, k0) do { const int so_ = (k0) * (ALD * 2);                                                    \
                         S.st_v0 = ldb8(rV_, kvoff, so_); S.st_v1 = ldb8(rV_, kvoff, so_ + 32 * ALD * 2);                    \
                         S.st_k0 = ldb8(rK_, kvoff, so_); S.st_k1 = ldb8(rK_, kvoff, so_ + 32 * ALD * 2);                    \
                         if (tid < 16) S.st_f = ldf4(rF_, tid * 16, (k0) * 4); } while (0)
#define QLOAD(rQ_) do { _Pragma("unroll") for (int d0 = 0; d0 < 8; ++d0) S.qr[d0] = ldb8(rQ_, qoff + d0 * 32, 0); } while (0)
#define SWRITE_HK(bf) do { *(bf16x8*)(K_lds + (bf) * SHM_K + kws) = S.st_k0; *(bf16x8*)(K_lds + (bf) * SHM_K + kws + 32 * 256) = S.st_k1; \
                           if (tid < 16) *(f32x4*)(F_lds + (bf) * 256 + tid * 16) = S.st_f; } while (0)
#define SWRITE_HV(bf) do { *(bf16x8*)(V_lds + (bf) * SHM_V + vst0) = S.st_v0; *(bf16x8*)(V_lds + (bf) * SHM_V + vst1) = S.st_v1; } while (0)
#define SWRITE_H(bf) do { SWRITE_HV(bf); SWRITE_HK(bf); } while (0)
__device__ __forceinline__ void causal_prime(const BlockRef& cur, char* lds, Seam& S) {
    int tid_ = threadIdx.x; asm volatile("" : "+v"(tid_));
    const int tid = tid_, wid = __builtin_amdgcn_readfirstlane(tid >> 6), lane = tid & 63, r32 = lane & 31, hi = lane >> 5;
    const int sr = tid >> 4, sc = (tid & 15) * 8, kws = KSWZ(sr, sc * 2); char* K_lds = lds + 2 * SHM_V; char* F_lds = lds + LDS_F;
    const int kvoff = (sr * ALD + sc) * 2, qoff = ((wid * QBLK + r32) * ALD + hi * 8) * 2;
    const rsrc_t rQ = mk_rsrc(cur.Q), rK = mk_rsrc(cur.K), rV = mk_rsrc(cur.V), rF = mk_rsrc(cur.F);
    QLOAD(rQ);
    SLOAD_H(rK, rV, rF, 0); VMW(); SWRITE_HK(0);
    __syncthreads();
}
__device__ __forceinline__ void causal_block(const BlockRef& cur, const BlockRef& nxt, char* lds, Seam& S) {
    int tid_ = threadIdx.x; asm volatile("" : "+v"(tid_));
    const int tid = tid_, wid = __builtin_amdgcn_readfirstlane(tid >> 6), lane = tid & 63, r32 = lane & 31, hi = lane >> 5;
    constexpr int W = 1 << 30;
    const int NT = (cur.P0 + QB - 1) / KVBLK + 1;
    const int qlo = cur.P0 + wid * QBLK, qm = qlo + r32 - 4 * hi;
    char* V_lds = lds; char* K_lds = lds + 2 * SHM_V; char* F_lds = lds + LDS_F;
    float* ws = (float*)(lds + 2 * SHM_V + 2 * SHM_K) + wid * 64; float* li_l = ws, * al_l = ws + 32;
    float m_reg = -1e30f, l_reg = 0; f32x16 o[4] = {};
    const int sr = tid >> 4, sc = (tid & 15) * 8, vst0 = v_st(sr, sc), vst1 = v_st(32 + sr, sc), kws = KSWZ(sr, sc * 2);
    const int vb0 = (int)(uintptr_t)V_lds + v_rd_base(lane);
    const int kvoff = (sr * ALD + sc) * 2, qoff = ((wid * QBLK + r32) * ALD + hi * 8) * 2;
    const rsrc_t Kh = mk_rsrc(cur.K), Vh = mk_rsrc(cur.V), Fh = mk_rsrc(cur.F);
#define RESC(a) do { if (__any((a) < 1.f)) { if (hi == 0) al_l[r32] = (a); asm volatile("s_waitcnt lgkmcnt(0)" ::: "memory");              \
                     for (int d_ = 0; d_ < 4; ++d_) for (int r = 0; r < 16; ++r) o[d_][r] *= al_l[crow(r, hi)]; } } while (0)
#define KBASE(t) ((t) * KVBLK)
#define MASKT(P0_, P1_, t) do { const int kb_ = KBASE(t); if (kb_ + KVBLK - 1 > qlo) mask_tile(P0_, P1_, qm - kb_, (unsigned)W); } while (0)
    constexpr int NQL = 8;
#define SEAM_K0() do { VMWN(NQL); SWRITE_HK(0); SBAR(); } while (0)
    f32x16 pA0, pA1, pB0, pB1; float mnA, mnB, alA, alB; bf16x8 pa0, pa1, pa2, pa3;
    SWRITE_HV(0); SBAR();
    if (NT > 1) { SLOAD_H(Kh, Vh, Fh, KBASE(1)); }
    SBAR(); qkt<0>(pA0, pA1, K_lds, F_lds, r32, hi, S.qr);
    MASKT(pA0, pA1, 0); partialSM(pA0, pA1, m_reg, mnA, alA);
    if (NT > 1) { VMW(); SWRITE_H(1); }
    __syncthreads();
#define HALF_STEP(PX0, PX1, mnX, alX, PY0, PY1, alY, t, KB, VB, SB) do {                                                      \
        SBAR(); qkt<KB>(PX0, PX1, K_lds, F_lds, r32, hi, S.qr);                                                               \
        finishSM(PY0, PY1, alY, l_reg, pa0, pa1, pa2, pa3); SBAR();                                                           \
        if ((t) + 1 < NT) { SLOAD_H(Kh, Vh, Fh, KBASE((t) + 1)); SBAR(); }                                                    \
        pv_tile<VB>(o, vb0, pa0, pa1, pa2, pa3); MASKT(PX0, PX1, (t)); partialSM(PX0, PX1, m_reg, mnX, alX);                  \
        __syncthreads();                                                                                                      \
        if ((t) + 1 < NT) { VMW(); SWRITE_H(SB); }                                                                            \
        RESC(alX); __syncthreads(); } while (0)
    for (int t = 1; t + 1 < NT; t += 2) {
        HALF_STEP(pB0, pB1, mnB, alB, pA0, pA1, alA, t, 1, 0, 0);
        HALF_STEP(pA0, pA1, mnA, alA, pB0, pB1, alB, t + 1, 0, 1, 1);
    }
    const bool even = (NT & 1) == 0;
    if (even) { SBAR(); qkt<1>(pB0, pB1, K_lds, F_lds, r32, hi, S.qr); SBAR(); }
    { const rsrc_t nK = mk_rsrc(nxt.K), nV = mk_rsrc(nxt.V), nF = mk_rsrc(nxt.F), nQ = mk_rsrc(nxt.Q);
      SLOAD_H(nK, nV, nF, 0); SBAR();
      QLOAD(nQ); }
    SBAR();
    finishSM(pA0, pA1, alA, l_reg, pa0, pa1, pa2, pa3); SBAR();
    pv_tile<0>(o, vb0, pa0, pa1, pa2, pa3);
    if (even) { MASKT(pB0, pB1, NT - 1); partialSM(pB0, pB1, m_reg, mnB, alB); __syncthreads(); RESC(alB);
        finishSM(pB0, pB1, alB, l_reg, pa0, pa1, pa2, pa3); SBAR(); pv_tile<1>(o, vb0, pa0, pa1, pa2, pa3); }
    SBAR(); SEAM_K0();
    if (hi == 0) li_l[r32] = l_reg; asm volatile("s_waitcnt lgkmcnt(0)" ::: "memory");
    float rli[16];
#pragma unroll
    for (int r = 0; r < 16; ++r) rli[r] = __builtin_amdgcn_rcpf(li_l[crow(r, hi)]);
    { const rsrc_t rO = mk_rsrc(cur.O); const int ooff = ((wid * QBLK + 4 * hi) * ALD + r32) * 2;
#pragma unroll
      for (int r = 0; r < 16; ++r) {
#pragma unroll
        for (int d0 = 0; d0 < 4; ++d0) { const float v = o[d0][r] * rli[r];
            const float vn = __shfl_xor(v, 1);
            if ((r32 & 1) == 0) __builtin_amdgcn_raw_buffer_store_b32(cvtpk(v, vn), rO, ooff + d0 * 64, ((r & 3) + 8 * (r >> 2)) * (ALD * 2), 0); } } }
    __syncthreads();
#undef RESC
#undef KBASE
#undef MASKT
#undef SEAM_K0
#undef HALF_STEP
}
#undef QLOAD
#undef VMW
#undef VMWN
#undef SLOAD_H
#undef SWRITE_HK
#undef SWRITE_HV
#undef SWRITE_H
#undef KSWZ
#undef SBAR
}
#define GAS __attribute__((address_space(1)))
#define LAS __attribute__((address_space(3)))
typedef unsigned short bf16;
typedef unsigned v4u __attribute__((ext_vector_type(4)));
typedef float f32x4 __attribute__((ext_vector_type(4)));
typedef short bf16x8 __attribute__((ext_vector_type(8)));
typedef GAS unsigned gu32;
typedef GAS unsigned long long gu64;
#define RLX_AGENT __ATOMIC_RELAXED, __HIP_MEMORY_SCOPE_AGENT
#define LDS_WAIT() asm volatile("s_waitcnt lgkmcnt(0)" ::: "memory")
#define VM_WAIT() asm volatile("s_waitcnt vmcnt(0)" ::: "memory")
__device__ __forceinline__ unsigned long long rt() { return __builtin_amdgcn_s_memrealtime(); }
__device__ __forceinline__ unsigned f2bf(float f) { unsigned u = __builtin_bit_cast(unsigned, f); return (u + 0x7fffu + ((u >> 16) & 1u)) >> 16; }
__device__ __forceinline__ unsigned pk2(float lo, float hi) { return f2bf(lo) | (f2bf(hi) << 16); }
#define XB_TMO      128
#define XB_XCNT(j)  (256  + 64 * (j))
#define XB_XSUB(j)  (1280 + 64 * (j))
#define XB_XGEN(j)  (2304 + 64 * (j))
#define XB_TOP      3328
#define XB_TOPGEN   3392
#define XCD_BAR_WORDS 3456
#define XB_SPIN_CAP (1u << 18)

__device__ __forceinline__ unsigned xb_ld(unsigned* p)              { return __hip_atomic_load(p, __ATOMIC_RELAXED, __HIP_MEMORY_SCOPE_AGENT); }
__device__ __forceinline__ unsigned xb_add(unsigned* p, unsigned v) { return __hip_atomic_fetch_add(p, v, __ATOMIC_RELAXED, __HIP_MEMORY_SCOPE_AGENT); }
__device__ __forceinline__ unsigned xb_xcc_id() { return (unsigned)__builtin_amdgcn_s_getreg((3 << 11) | 20) & 0xFu; }
#define XB_SPIN(cond, bar) do { unsigned _sp = 0; while (cond) { __builtin_amdgcn_s_sleep(1); \
    if ((++_sp & 255u) == 0u) { if (xb_ld(&(bar)[XB_TMO])) break; if (_sp > XB_SPIN_CAP) { atomicAdd(&(bar)[XB_TMO], 1u); break; } } } } while (0)

struct XcdBarrier {
    unsigned* bar; unsigned x;
    volatile LAS unsigned* st;
};

__device__ __forceinline__ XcdBarrier xcd_barrier_post(unsigned* bar, volatile LAS unsigned* st) {
    XcdBarrier b; b.bar = bar; b.x = xb_xcc_id(); b.st = st;
    if (threadIdx.x == 0) (void)xb_add(&bar[XB_XCNT(b.x)], 1u);
    return b;
}
__device__ __forceinline__ void xcd_barrier_complete(unsigned* bar, unsigned x, unsigned& nloc, unsigned& nx) {
    const unsigned G = gridDim.x * gridDim.y * gridDim.z;
    unsigned sum, cnt, mine, sp = 0u;
    for (;;) {
        sum = 0u; cnt = 0u; mine = 0u;
#pragma unroll
        for (unsigned j = 0; j < 16; ++j) { const unsigned c = xb_ld(&bar[XB_XCNT(j)]); sum += c; cnt += (c > 0u) ? 1u : 0u; mine = (j == x) ? c : mine; }
        if (sum == G) break;
        __builtin_amdgcn_s_sleep(1);
        if ((++sp & 255u) == 0u) { if (xb_ld(&bar[XB_TMO])) break; if (sp > XB_SPIN_CAP) { atomicAdd(&bar[XB_TMO], 1u); break; } }
    }
    nloc = mine > 0u ? mine : 1u; nx = cnt > 0u ? cnt : 1u;
}

__device__ __forceinline__ void xcd_barrier(const XcdBarrier& b) {
    asm volatile("s_waitcnt vmcnt(0)" ::: "memory");
    __syncthreads();
    if (threadIdx.x == 0) {
        unsigned* bar = b.bar;
        __builtin_amdgcn_s_waitcnt(0);
        unsigned nloc = b.st[0], nx = b.st[1];
        if (nloc == 0u) { xcd_barrier_complete(bar, b.x, nloc, nx); b.st[0] = nloc; b.st[1] = nx; }
        const unsigned old = xb_add(&bar[XB_XSUB(b.x)], 1u);
        const unsigned gen = old / nloc;
        if (old + 1u == (gen + 1u) * nloc) {
            __builtin_amdgcn_fence(__ATOMIC_RELEASE, "agent");
            asm volatile("s_waitcnt vmcnt(0)" ::: "memory");
            const unsigned og = xb_add(&bar[XB_TOP], 1u);
            const unsigned tg = og / nx;
            if (og + 1u == (tg + 1u) * nx) xb_add(&bar[XB_TOPGEN], 1u);
            else XB_SPIN(xb_ld(&bar[XB_TOPGEN]) == tg, bar);
            __builtin_amdgcn_fence(__ATOMIC_ACQUIRE, "agent");
            xb_add(&bar[XB_XGEN(b.x)], 1u);
            asm volatile("s_waitcnt vmcnt(0)" ::: "memory");
        } else {
            XB_SPIN(xb_ld(&bar[XB_XGEN(b.x)]) == gen, bar);
            __builtin_amdgcn_fence(__ATOMIC_ACQUIRE, "agent");
            asm volatile("s_waitcnt vmcnt(0)" ::: "memory");
        }
    }
    __syncthreads();
}
constexpr int NWAVES = 8;
#ifndef ONE_LAUNCH
#define ONE_LAUNCH 0
#endif
constexpr int BATCH = 4, T = 4096, D = 2048, H = 16, HD = 128;
constexpr int M = BATCH * T;
constexpr int NPA = 8192;
constexpr float EPS = 1e-6f;
constexpr size_t MiB = 1u << 20;
constexpr size_t WS_CTL = 0, CTL_ZERO_BYTES = 1 * MiB;
constexpr size_t WS_WINA = 2 * MiB;
constexpr size_t WS_WOUTA = 66 * MiB;
constexpr size_t WS_WKVQ = 82 * MiB;
constexpr size_t WS_WINB1 = 114 * MiB;
constexpr size_t WS_WOUTB = 130 * MiB;
constexpr size_t WS_XN = 146 * MiB;
constexpr size_t WS_PROJ = 210 * MiB;
constexpr size_t WS_FZ = 466 * MiB;
constexpr size_t WS_F = 467 * MiB;
constexpr size_t WS_END = 468 * MiB;
constexpr size_t SLOT = (size_t)M * D;
constexpr int CW_TMO = 0, CW_CODE = 1;
constexpr int CW_BAR = 4096;
constexpr int RING_OFF = 0, RING_BYTES = 131072;
constexpr int SCRATCH_BYTES = 139264;
constexpr int LDSCTL_OFF = SCRATCH_BYTES, MISC_OFF = LDSCTL_OFF + 320;
constexpr int LDS_BYTES = 147456;
static_assert(MISC_OFF + 128 <= LDS_BYTES, "LDS map");

struct Frame {
    LAS unsigned char* lds;
    volatile LAS unsigned* MISC;
    gu32* ctl;
    int tid, lane, wave;
    int vcu, G;
};
__device__ __forceinline__ void phase_tid(Frame& F) { int t = threadIdx.x; asm volatile("" : "+v"(t)); F.tid = t; F.lane = t & 63; F.wave = __builtin_amdgcn_readfirstlane(t >> 6); }

__device__ __forceinline__ float wave_sum(float v) {
#pragma unroll
    for (int o = 1; o < 64; o <<= 1) v += __shfl_xor(v, o);
    return v;
}
__device__ __forceinline__ float bf2f(unsigned short b) { return __uint_as_float((unsigned)b << 16); }
__device__ __forceinline__ float bflo(unsigned w) { return __uint_as_float(w << 16); }
__device__ __forceinline__ float bfhi(unsigned w) { return __uint_as_float(w & 0xffff0000u); }

__device__ __forceinline__ void p0_transpose_item(const float* W, int ldw, int ncols, const float* nw, bf16* WT, LAS float* scr, int item, int lane) {
    const int nblk = ncols / 32, kb = item / nblk, nb = item % nblk, k0 = 64 * kb, n0 = 32 * nb;
#pragma unroll 8
    for (int i = 0; i < 32; ++i) { const int kk = 2 * i + (lane >> 5); const float s = nw ? nw[k0 + kk] : 1.f; scr[kk * 33 + (lane & 31)] = W[(size_t)(k0 + kk) * ldw + n0 + (lane & 31)] * s; }
    LDS_WAIT(); asm volatile("" ::: "memory");
    const int c = lane & 7;
#pragma unroll
    for (int j = 0; j < 4; ++j) { const int n = (lane >> 3) + 8 * j; const LAS float* s = scr + (8 * c) * 33 + n;
        v4u o; o.x = pk2(s[0 * 33], s[1 * 33]); o.y = pk2(s[2 * 33], s[3 * 33]); o.z = pk2(s[4 * 33], s[5 * 33]); o.w = pk2(s[6 * 33], s[7 * 33]);
        *(GAS v4u*)(WT + (size_t)(n0 + n) * D + k0 + 8 * c) = o; }
    LDS_WAIT(); asm volatile("" ::: "memory");
}
__device__ __forceinline__ void norm_rows(Frame& F, const float* xin, bf16* xn) {
    const int gw = F.vcu * NWAVES + F.wave, NGW = F.G * NWAVES;
    for (int m = gw; m < M; m += NGW) {
        const GAS f32x4* xr = (const GAS f32x4*)(xin + (size_t)m * D) + F.lane;
        f32x4 v[8]; float s = 0.f;
#pragma unroll
        for (int j = 0; j < 8; ++j) { v[j] = xr[64 * j]; s += (v[j].x * v[j].x + v[j].y * v[j].y) + (v[j].z * v[j].z + v[j].w * v[j].w); }
        const float r = 1.0f / sqrtf(wave_sum(s) * (1.f / D) + EPS);
        GAS unsigned long long* o8 = (GAS unsigned long long*)(xn + (size_t)m * D) + F.lane;
#pragma unroll
        for (int j = 0; j < 8; ++j) o8[64 * j] = (unsigned long long)pk2(v[j].x * r, v[j].y * r) | ((unsigned long long)pk2(v[j].z * r, v[j].w * r) << 32);
    }
}
__device__ __forceinline__ void p0_prologue(Frame& F, const float* const* in, unsigned char* ws) {
    LAS float* scr = (LAS float*)(F.lds + RING_OFF + F.wave * 16384);
    const int gw = F.vcu * NWAVES + F.wave, NGW = F.G * NWAVES;
    constexpr int I_INA = 32 * 256, I_SQ = 32 * 64, I_4K = 32 * 128;
    constexpr int NITEMS = 2 * I_INA + 2 * I_SQ + 3 * I_4K + 2 * I_SQ;
    for (int it = gw; it < NITEMS; it += NGW) {
        int r = it;
        if (r < 2 * I_INA) { const int l = r / I_INA; r -= l * I_INA; p0_transpose_item(in[2] + (size_t)l * D * NPA, NPA, NPA, in[1] + l * D, (bf16*)(ws + WS_WINA) + (size_t)l * NPA * D, scr, r, F.lane); continue; } r -= 2 * I_INA;
        if (r < 2 * I_SQ) { const int l = r / I_SQ; r -= l * I_SQ; p0_transpose_item(in[5] + (size_t)l * D * D, D, D, nullptr, (bf16*)(ws + WS_WOUTA) + (size_t)l * D * D, scr, r, F.lane); continue; } r -= 2 * I_SQ;
        if (r < I_4K) { p0_transpose_item(in[7], 2 * D + H, 2 * D, in[6], (bf16*)(ws + WS_WKVQ), scr, r, F.lane); continue; } r -= I_4K;
        if (r < I_4K) { p0_transpose_item(in[11], 2 * D, 2 * D, in[10], (bf16*)(ws + WS_WKVQ) + (size_t)2 * D * D, scr, r, F.lane); continue; } r -= I_4K;
        if (r < I_4K) { p0_transpose_item(in[11] + (size_t)D * 2 * D, 2 * D, 2 * D, in[10] + D, (bf16*)(ws + WS_WINB1), scr, r, F.lane); continue; } r -= I_4K;
        { const int l = r / I_SQ; r -= l * I_SQ; p0_transpose_item(in[14] + (size_t)l * D * D, D, D, nullptr, (bf16*)(ws + WS_WOUTB) + (size_t)l * D * D, scr, r, F.lane); }
    }
    norm_rows(F, in[0], (bf16*)(ws + WS_XN));
}
__device__ __forceinline__ float sum16(float v) { v += __shfl_xor(v, 1); v += __shfl_xor(v, 2); v += __shfl_xor(v, 4); v += __shfl_xor(v, 8); return v; }
__device__ __forceinline__ void headnorm_rows(Frame& F, bf16* X, const float* w) {
    const int gw = F.vcu * NWAVES + F.wave, NGW = F.G * NWAVES;
    for (int m = gw; m < M; m += NGW) {
        GAS v4u* xr = (GAS v4u*)(X + (size_t)m * D) + F.lane;
#pragma unroll
        for (int j = 0; j < 4; ++j) {
            const v4u x = xr[64 * j]; float f[8] = {bflo(x.x), bfhi(x.x), bflo(x.y), bfhi(x.y), bflo(x.z), bfhi(x.z), bflo(x.w), bfhi(x.w)};
            float s = 0.f;
#pragma unroll
            for (int e = 0; e < 8; ++e) s += f[e] * f[e];
            const float r = 1.0f / sqrtf(sum16(s) * (1.f / HD) + EPS);
            const int d0 = (8 * F.lane) & 127;
            const f32x4 w0 = *(const f32x4*)(w + d0), w1 = *(const f32x4*)(w + d0 + 4);
            v4u o; o.x = pk2(f[0] * r * w0.x, f[1] * r * w0.y); o.y = pk2(f[2] * r * w0.z, f[3] * r * w0.w); o.z = pk2(f[4] * r * w1.x, f[5] * r * w1.y); o.w = pk2(f[6] * r * w1.z, f[7] * r * w1.w);
            xr[64 * j] = o;
        }
    }
}
__device__ __forceinline__ float silu_f(float g) { return g / (1.f + __expf(-g)); }
__device__ __forceinline__ void gatenorm_rows(Frame& F, bf16* O, const bf16* G, const float* w) {
    const int gw = F.vcu * NWAVES + F.wave, NGW = F.G * NWAVES;
    for (int m = gw; m < M; m += NGW) {
        GAS v4u* xr = (GAS v4u*)(O + (size_t)m * D) + F.lane; const GAS v4u* gr = (const GAS v4u*)(G + (size_t)m * D) + F.lane;
#pragma unroll
        for (int j = 0; j < 4; ++j) {
            const v4u x = xr[64 * j], g = gr[64 * j];
            float f[8] = {bflo(x.x), bfhi(x.x), bflo(x.y), bfhi(x.y), bflo(x.z), bfhi(x.z), bflo(x.w), bfhi(x.w)};
            const float q[8] = {bflo(g.x), bfhi(g.x), bflo(g.y), bfhi(g.y), bflo(g.z), bfhi(g.z), bflo(g.w), bfhi(g.w)};
            float s = 0.f;
#pragma unroll
            for (int e = 0; e < 8; ++e) s += f[e] * f[e];
            const float r = 1.0f / sqrtf(sum16(s) * (1.f / HD) + EPS);
            const int c0 = 8 * (F.lane + 64 * j);
            const f32x4 w0 = *(const f32x4*)(w + c0), w1 = *(const f32x4*)(w + c0 + 4);
            const float ww[8] = {w0.x, w0.y, w0.z, w0.w, w1.x, w1.y, w1.z, w1.w};
#pragma unroll
            for (int e = 0; e < 8; ++e) f[e] = f[e] * r * ww[e] * silu_f(q[e]);
            v4u o; o.x = pk2(f[0], f[1]); o.y = pk2(f[2], f[3]); o.z = pk2(f[4], f[5]); o.w = pk2(f[6], f[7]);
            xr[64 * j] = o;
        }
    }
}
__device__ __forceinline__ void recur_naive(Frame& F, const bf16* Qp, const bf16* Zp, const bf16* Vp, bf16* Op, const float* lbl, int layer) {
    LAS float* sq = (LAS float*)(F.lds); LAS float* sk = sq + 2048; LAS float* sf = sk + 2048; LAS float* sv = sf + 2048; LAS float* part = sv + 2048;
    const int tid = F.tid, dv = tid & 127, kq = tid >> 7, ts = tid >> 5, d4 = (tid & 31) * 4;
    for (int u = blockIdx.x; u < BATCH * H; u += F.G) {
        const int b = u / H, h = u % H;
        float lb[4];
#pragma unroll
        for (int e = 0; e < 4; ++e) { const int c = h * HD + d4 + e; const float l0 = lbl[c], l1 = lbl[D + c]; lb[e] = layer == 0 ? 0.f : 1.f / (1.f + __expf(l0 - l1)); }
        float S[32];
#pragma unroll
        for (int i = 0; i < 32; ++i) S[i] = 0.f;
        for (int tb = 0; tb < T; tb += 16) {
            const size_t off = (size_t)(b * T + tb + ts) * D + h * HD + d4;
            const uint2 q2 = *(const uint2*)(Qp + off), z2 = *(const uint2*)(Zp + off), v2 = *(const uint2*)(Vp + off);
            const float qf[4] = {bflo(q2.x), bfhi(q2.x), bflo(q2.y), bfhi(q2.y)}, zf[4] = {bflo(z2.x), bfhi(z2.x), bflo(z2.y), bfhi(z2.y)}, vf[4] = {bflo(v2.x), bfhi(v2.x), bflo(v2.y), bfhi(v2.y)};
#pragma unroll
            for (int e = 0; e < 4; ++e) {
                const float z = zf[e], ez = __expf(-fabsf(z)), inv = 1.f / (1.f + ez);
                const float sig = z >= 0.f ? inv : ez * inv, nsig = z >= 0.f ? ez * inv : inv;
                sq[ts * 128 + d4 + e] = qf[e]; sk[ts * 128 + d4 + e] = (1.f - lb[e]) * nsig; sf[ts * 128 + d4 + e] = lb[e] + (1.f - lb[e]) * sig; sv[ts * 128 + d4 + e] = vf[e];
            }
            __syncthreads();
#pragma unroll 1
            for (int tt = 0; tt < 16; ++tt) {
                const float vv = sv[tt * 128 + dv]; float p = 0.f;
#pragma unroll
                for (int i4 = 0; i4 < 8; ++i4) {
                    const f32x4 f4 = *(const LAS f32x4*)(sf + tt * 128 + kq * 32 + 4 * i4), k4 = *(const LAS f32x4*)(sk + tt * 128 + kq * 32 + 4 * i4), q4 = *(const LAS f32x4*)(sq + tt * 128 + kq * 32 + 4 * i4);
#pragma unroll
                    for (int e = 0; e < 4; ++e) { S[4 * i4 + e] = f4[e] * S[4 * i4 + e] + k4[e] * vv; p += q4[e] * S[4 * i4 + e]; }
                }
                part[(kq * 16 + tt) * 128 + dv] = p;
            }
            __syncthreads();
            float o4[4];
#pragma unroll
            for (int e = 0; e < 4; ++e) o4[e] = (part[(0 * 16 + ts) * 128 + d4 + e] + part[(1 * 16 + ts) * 128 + d4 + e]) + (part[(2 * 16 + ts) * 128 + d4 + e] + part[(3 * 16 + ts) * 128 + d4 + e]);
            uint2 o2; o2.x = pk2(o4[0], o4[1]); o2.y = pk2(o4[2], o4[3]);
            *(uint2*)(Op + off) = o2;
        }
        __syncthreads();
    }
}
__device__ __forceinline__ void fz_rows(Frame& F, const bf16* xn, const float* kvw, const float* kvnw, const float* fbias, float* fzls) {
    LAS float* wf = (LAS float*)(F.lds);
    for (int idx = F.tid; idx < D * 16; idx += NWAVES * 64) { const int k = idx >> 4, j = idx & 15; wf[k * 16 + (k >> 3) * 4 + j] = kvw[(size_t)k * (2 * D + H) + 2 * D + j] * kvnw[k]; }
    __syncthreads();
    const int gw = F.vcu * NWAVES + F.wave, NGW = F.G * NWAVES;
    for (int m = gw; m < M; m += NGW) {
        const GAS v4u* xr = (const GAS v4u*)(xn + (size_t)m * D) + F.lane;
        float acc[16];
#pragma unroll
        for (int j = 0; j < 16; ++j) acc[j] = 0.f;
#pragma unroll 1
        for (int jj = 0; jj < 4; ++jj) {
            const v4u x = xr[64 * jj]; const float f[8] = {bflo(x.x), bfhi(x.x), bflo(x.y), bfhi(x.y), bflo(x.z), bfhi(x.z), bflo(x.w), bfhi(x.w)};
            const int c = F.lane + 64 * jj;
#pragma unroll 2
            for (int e = 0; e < 8; ++e) { const LAS f32x4* wr = (const LAS f32x4*)(wf + (8 * c + e) * 16 + c * 4);
#pragma unroll
                for (int q = 0; q < 4; ++q) { const f32x4 w4 = wr[q]; acc[4 * q + 0] += f[e] * w4.x; acc[4 * q + 1] += f[e] * w4.y; acc[4 * q + 2] += f[e] * w4.z; acc[4 * q + 3] += f[e] * w4.w; } }
        }
        float mine = 0.f;
#pragma unroll
        for (int j = 0; j < 16; ++j) { const float s = wave_sum(acc[j]); if (F.lane == j) mine = s; }
        if (F.lane < 16) { const float z = mine + fbias[F.lane]; fzls[(size_t)m * 16 + F.lane] = fminf(z, 0.f) - log1pf(__expf(-fabsf(z))); }
    }
    __syncthreads();
}
__device__ __forceinline__ void fscan(Frame& F, const float* fzls, float* Fo) {
    LAS float* wt = (LAS float*)(F.lds);
    for (int u = blockIdx.x; u < BATCH * H; u += F.G) {
        const int b = u / H, h = u % H, t0 = F.tid * 8;
        float v[8];
#pragma unroll
        for (int e = 0; e < 8; ++e) v[e] = fzls[(size_t)(b * T + t0 + e) * 16 + h];
#pragma unroll
        for (int e = 1; e < 8; ++e) v[e] += v[e - 1];
        float incl = v[7];
#pragma unroll
        for (int o = 1; o < 64; o <<= 1) { const float n = __shfl_up(incl, o); if (F.lane >= o) incl += n; }
        if (F.lane == 63) wt[F.wave] = incl;
        __syncthreads();
        float base = incl - v[7];
        for (int w = 0; w < F.wave; ++w) base += wt[w];
#pragma unroll
        for (int e = 0; e < 8; ++e) Fo[(size_t)u * T + t0 + e] = -(v[e] + base) * fox::INVS;
        __syncthreads();
    }
}
__device__ __forceinline__ fox::BlockRef attn_ref(int L, int pass, const bf16* Q, const bf16* K, const bf16* V, bf16* O, const float* Fc) {
    const int bh = L >> 3, x = L & 7, qb = pass ? 15 - x : x, b = bh / H, h = bh % H;
    fox::BlockRef r; const size_t base = (size_t)b * T * D + h * HD;
    r.Q = (const fox::bf16*)Q + base + (size_t)qb * 256 * D; r.O = (fox::bf16*)O + base + (size_t)qb * 256 * D; r.K = (const fox::bf16*)K + base; r.V = (const fox::bf16*)V + base;
    r.F = Fc + (size_t)bh * T; r.P0 = qb * 256; return r;
}
__device__ __forceinline__ void attn_phase(Frame& F, char* lds, const bf16* Q, const bf16* K, const bf16* V, bf16* O, const float* Fc) {
    constexpr int total = BATCH * H * 8; const int stride = F.G;
    int L = F.vcu; if (L >= total) return;
    int pass = 0;
    fox::BlockRef cur = attn_ref(L, 0, Q, K, V, O, Fc);
    fox::Seam S;
    fox::causal_prime(cur, lds, S);
    for (;;) {
        const bool more_pass = pass == 0, more_item = L + stride < total, last = !more_pass && !more_item;
        int passn = pass + 1, Ln = L;
        if (!more_pass) { passn = 0; Ln = more_item ? L + stride : L; }
        const fox::BlockRef nxt = last ? cur : attn_ref(Ln, passn, Q, K, V, O, Fc);
        fox::causal_block(cur, nxt, lds, S);
        if (last) break;
        cur = nxt; pass = passn; L = Ln;
    }
}

constexpr int NPHASE = 29;
__host__ __device__ constexpr bool phase_live(int id) {
    if (id == 0) return true;
    const int L = (id - 1) / 7, s = (id - 1) % 7;
    if (s == 1) return L >= 2;
    if (s == 2) return L == 2;
    if (s == 6) return L < 3;
    return true;
}
struct Args { const float* in[15]; float* out; unsigned char* ws; int ph_lo, ph_hi; };
__global__ void __launch_bounds__(NWAVES * 64, 2) fwd_kernel(Args args) {
    extern __shared__ __attribute__((aligned(16))) unsigned char lds[];
    Frame F;
    F.lds = (LAS unsigned char*)lds;
    F.MISC = (volatile LAS unsigned*)(F.lds + MISC_OFF);
    phase_tid(F);
    F.G = gridDim.x; { const int bx = blockIdx.x; F.vcu = (F.G % 8 == 0) ? (bx % 8) * (F.G / 8) + bx / 8 : bx; }
    unsigned char* ws = args.ws;
    F.ctl = (gu32*)(ws + WS_CTL);
    for (int u = F.tid; u < (LDS_BYTES - LDSCTL_OFF) / 4; u += NWAVES * 64) ((LAS unsigned*)(F.lds + LDSCTL_OFF))[u] = 0u;
    __syncthreads();
#if ONE_LAUNCH
    XcdBarrier bar = xcd_barrier_post((unsigned*)(F.ctl + CW_BAR), F.MISC + 8);
#define GRID_BAR() xcd_barrier(bar)
#else
#define GRID_BAR() do {} while (0)
#endif
    const int lo = args.ph_lo, hi = args.ph_hi;
#define IN(k) (lo <= (k) && (k) < hi)
#define SEAM(k) do { if ((k) + 1 < hi) GRID_BAR(); } while (0)
    const float* const* in = args.in;
    bf16* XN = (bf16*)(ws + WS_XN); bf16* PROJ = (bf16*)(ws + WS_PROJ);
    float* FZ = (float*)(ws + WS_FZ); float* FC = (float*)(ws + WS_F);

    #ifndef NO_P0
    if (IN(0)) { phase_tid(F); p0_prologue(F, in, ws); SEAM(0); }
#endif

#pragma unroll 1
    for (int L = 0; L < 4; ++L) {
        const int pb = 1 + 7 * L; const bool isA = L < 2; const int j = L & 1;
        if (IN(pb + 0)) {
            const bf16* Bt = isA ? (const bf16*)(ws + WS_WINA) + (size_t)j * NPA * D : (L == 2 ? (const bf16*)(ws + WS_WKVQ) : (const bf16*)(ws + WS_WINB1));
            const int N = (L == 3) ? 2 * D : NPA;
            bf16* outp = (L == 3) ? PROJ + 2 * SLOT : PROJ;
            pg8::Gemm g{XN, Bt, M, N, D}; pg8::StaticOrder S; S.init(M, N, F.G, (int)blockIdx.x);
            pg8::EpiBf16<0> E{outp, D, nullptr, D, SLOT, 1.f};
#ifndef NO_G1
            pg8::gemm_phase<pg8::EpiBf16<0>, pg8::StaticOrder, true, true>(F.lds + RING_OFF, g, S, E);
#endif
            SEAM(pb + 0);
        }
        if (IN(pb + 1) && !isA) { phase_tid(F);
#ifndef NO_FZ
            if (L == 2) { fz_rows(F, XN, in[7], in[6], in[8], FZ); headnorm_rows(F, PROJ, in[9]); }
#endif
            headnorm_rows(F, PROJ + 2 * SLOT, in[12] + j * HD);
            SEAM(pb + 1);
        }
        if (IN(pb + 2) && L == 2) { phase_tid(F); fscan(F, FZ, FC); SEAM(pb + 2); }
        if (IN(pb + 3)) { phase_tid(F);
#ifndef NO_REC
            if (isA) recur_naive(F, PROJ, PROJ + SLOT, PROJ + 2 * SLOT, XN, in[3], L);
#endif
#ifndef NO_ATT
            if (!isA) attn_phase(F, (char*)lds + RING_OFF, PROJ + 2 * SLOT, PROJ, PROJ + SLOT, XN, FC);
#endif
            SEAM(pb + 3);
        }
        if (IN(pb + 4)) { phase_tid(F); gatenorm_rows(F, XN, PROJ + 3 * SLOT, (isA ? in[4] : in[13]) + j * D); SEAM(pb + 4); }
        if (IN(pb + 5)) {
            const bf16* Bt = (const bf16*)(ws + (isA ? WS_WOUTA : WS_WOUTB)) + (size_t)j * D * D;
            pg8::Gemm g{XN, Bt, M, D, D}; pg8::StaticOrder S; S.init(M, D, F.G, (int)blockIdx.x);
            pg8::EpiRes E{L == 0 ? in[0] : args.out, args.out, D};
#ifndef NO_G2
            pg8::gemm_phase<pg8::EpiRes, pg8::StaticOrder, true, true>(F.lds + RING_OFF, g, S, E);
#endif
            SEAM(pb + 5);
        }
        if (IN(pb + 6) && L < 3) { phase_tid(F); norm_rows(F, args.out, XN); SEAM(pb + 6); }
    }
#undef IN
#undef SEAM
}

extern "C" void kernel_launch(void* const* d_in, const int* in_sizes, int n_in, void* d_out, int out_size, void* d_ws, size_t ws_size, hipStream_t stream) {
    static int grid = 0;
    if (grid == 0) {
        if (n_in != 15 || in_sizes[0] != M * D || out_size != M * D || ws_size < WS_END) { fprintf(stderr, "kernel_launch: unexpected shapes (n_in %d, in0 %d, out %d, ws %zu)\n", n_in, n_in > 0 ? in_sizes[0] : -1, out_size, ws_size); grid = -1; return; }
        int dev = 0, cus = 0;
        if (hipGetDevice(&dev) != hipSuccess || hipDeviceGetAttribute(&cus, hipDeviceAttributeMultiprocessorCount, dev) != hipSuccess) { grid = -1; return; }
        if (hipFuncSetAttribute((const void*)fwd_kernel, hipFuncAttributeMaxDynamicSharedMemorySize, LDS_BYTES) != hipSuccess) { fprintf(stderr, "kernel_launch: hipFuncSetAttribute failed\n"); grid = -1; return; }
        int per_cu = 0;
        if (hipOccupancyMaxActiveBlocksPerMultiprocessor(&per_cu, (const void*)fwd_kernel, NWAVES * 64, LDS_BYTES) != hipSuccess || per_cu < 1) fprintf(stderr, "kernel_launch: occupancy query says %d\n", per_cu);
        (void)hipGetLastError();
        grid = cus;
    }
    if (grid < 0) return;
    (void)hipMemsetAsync((char*)d_ws + WS_CTL, 0, CTL_ZERO_BYTES, stream);
    Args a{};
    for (int i = 0; i < 15; ++i) a.in[i] = (const float*)d_in[i];
    a.out = (float*)d_out; a.ws = (unsigned char*)d_ws;
#if ONE_LAUNCH
    a.ph_lo = 0; a.ph_hi = NPHASE;
    hipLaunchKernelGGL(fwd_kernel, dim3(grid), dim3(NWAVES * 64), LDS_BYTES, stream, a);
#else
    for (int p = 0; p < NPHASE; ++p) { if (!phase_live(p)) continue; a.ph_lo = p; a.ph_hi = p + 1; hipLaunchKernelGGL(fwd_kernel, dim3(grid), dim3(NWAVES * 64), LDS_BYTES, stream, a); }
#endif
}
```

```cpp
#include <hip/hip_runtime.h>
#include <hip/hip_bf16.h>
#include <cstdio>
#include <cstdint>
#include <cmath>
namespace pg8 {
#define PG8_LAS __attribute__((address_space(3)))
typedef unsigned short bf16_t;
typedef short bf16x8 __attribute__((ext_vector_type(8)));
typedef float f32x4 __attribute__((ext_vector_type(4)));
typedef unsigned u32x4 __attribute__((ext_vector_type(4)));
constexpr int BM = 256, BK = 64, HALF = 128, HTB = HALF * BK * 2  , STAGE_BYTES = 8 * HTB, NXCD = 8, WGM = 8;

__host__ __device__ __forceinline__ int lds_byte(int r, int c) { const int st = (r >> 4) * 2 + (c >> 5), rr = r & 15, cc = c & 31, ob = rr * 64 + cc * 2; return st * 1024 + (ob ^ (((ob >> 9) & 1) << 5)); }
__host__ __device__ __forceinline__ void stage_rc(int b, int& R, int& C) { const int st = b / 1024, sb = b % 1024, swz = sb ^ (((sb >> 9) & 1) << 5); R = (st >> 1) * 16 + swz / 64; C = (st & 1) * 32 + (swz % 64) / 2; }
__host__ __device__ __forceinline__ int perm32(int rho) { const int n = rho >> 4, i = rho & 15; return 8 * (i >> 2) + 4 * n + (i & 3); }

struct Unit { int pm, pn; };
struct Gemm { const bf16_t* A; const bf16_t* Bt; int M, N, K; };

struct StaticOrder {
    int nM, nN, nwg, G, c;
    __host__ __device__ void init(int M, int N, int G_, int c_) { nM = M / BM; nN = N / BM; nwg = nM * nN; G = G_; c = c_; }
    __host__ __device__ bool next(int i, Unit& u) const {
        const long L = (long)i * G + c; if (L >= nwg) return false;
        int wgid = (int)L; { const int q = nwg / NXCD, r = nwg % NXCD, xcd = wgid % NXCD, off = wgid / NXCD; wgid = (xcd < r ? xcd * (q + 1) : r * (q + 1) + (xcd - r) * q) + off; }
        const int nig = WGM * nN, gid = wgid / nig, fm = gid * WGM, gsz = (nM - fm) < WGM ? (nM - fm) : WGM;
        u.pm = fm + ((wgid % nig) % gsz); u.pn = (wgid % nig) / gsz; return true;
    }
    __device__ __forceinline__ void a_ready(const Unit&) const {}
    __device__ __forceinline__ void done(const Unit&) const {}
};

__device__ __forceinline__ unsigned cvt_pk_bf16(float lo, float hi) { unsigned r; asm volatile("v_cvt_pk_bf16_f32 %0, %1, %2" : "=v"(r) : "v"(lo), "v"(hi)); return r; }
typedef float f32x2 __attribute__((ext_vector_type(2)));
__device__ __forceinline__ f32x2 gelu_pk(f32x2 v) {
    const f32x2 av = __builtin_elementwise_abs(v), d = av * 0.2316418882f + 1.0f;
    f32x2 t; t.x = __builtin_amdgcn_rcpf(d.x); t.y = __builtin_amdgcn_rcpf(d.y);
    f32x2 q = t * 0.5307027145f + (-0.7265760135f); q = q * t + 0.7107068705f; q = q * t + (-0.142248368f); q = q * t + 0.127414796f; q = q * t;
    const f32x2 s = (v * v) * (-0.72134752044f);
    f32x2 e; e.x = __builtin_amdgcn_exp2f(s.x); e.y = __builtin_amdgcn_exp2f(s.y);
    const f32x2 m = v * (q * e), r = v - m;
    f32x2 o; o.x = v.x < 0.f ? m.x : r.x; o.y = v.y < 0.f ? m.y : r.y; return o;
}

template <int ACT  > struct EpiBf16 {
    static constexpr bool PERM = true, AFTER_DRAIN = false; static_assert(ACT == 0 || ACT == 1, "EpiBf16: ACT is 0 (none) or 1 (gelu_pk)");
    bf16_t* O; int ldc; const float* bias; int split_cols; size_t split_stride; float scale0;
    __device__ __forceinline__ void operator()(const f32x4 (&acc)[2][2][4][2], const Unit& u, int wr, int wc, int fr, int fq) const {
        const int row0 = u.pm * BM + wr * 64 + fr; int colt = u.pn * BM; bf16_t* base = O;
        float sc = 1.f; if (split_cols) { const int t = colt / split_cols; base += (size_t)t * split_stride; colt -= t * split_cols; if (t == 0) sc = scale0; }
        const int col0 = colt + wc * 32 + 8 * fq, bcol0 = u.pn * BM + wc * 32 + 8 * fq;
        f32x4 bv[2][2];
#pragma unroll
        for (int bj = 0; bj < 2; ++bj)
#pragma unroll
            for (int n = 0; n < 2; ++n) bv[bj][n] = bias ? *(const f32x4*)(bias + bcol0 + bj * HALF + 4 * n) : (f32x4){0.f, 0.f, 0.f, 0.f};
#pragma unroll
        for (int ai = 0; ai < 2; ++ai)
#pragma unroll
            for (int m = 0; m < 4; ++m) { bf16_t* rowp = base + (size_t)(row0 + ai * HALF + m * 16) * ldc + col0;
#pragma unroll
                for (int bj = 0; bj < 2; ++bj) { f32x4 v0 = acc[ai][bj][m][0] + bv[bj][0], v1 = acc[ai][bj][m][1] + bv[bj][1];
                    if (ACT == 1) { f32x2 a = gelu_pk((f32x2){v0[0], v0[1]}), b = gelu_pk((f32x2){v0[2], v0[3]}), c = gelu_pk((f32x2){v1[0], v1[1]}), d = gelu_pk((f32x2){v1[2], v1[3]});
                        v0 = (f32x4){a.x, a.y, b.x, b.y}; v1 = (f32x4){c.x, c.y, d.x, d.y}; }
                    v0 = v0 * sc; v1 = v1 * sc; u32x4 w; w.x = cvt_pk_bf16(v0[0], v0[1]); w.y = cvt_pk_bf16(v0[2], v0[3]); w.z = cvt_pk_bf16(v1[0], v1[1]); w.w = cvt_pk_bf16(v1[2], v1[3]);
                    *(u32x4*)(rowp + bj * HALF) = w; } }
    }
};
struct EpiRes {
    static constexpr bool PERM = false, AFTER_DRAIN = false;
    const float* res; float* out; int ldc;
    __device__ __forceinline__ void operator()(const f32x4 (&acc)[2][2][4][2], const Unit& u, int wr, int wc, int fr, int fq) const {
        const int row0 = u.pm * BM + wr * 64 + fr, col0 = u.pn * BM + wc * 32 + 4 * fq;
#pragma unroll
        for (int ai = 0; ai < 2; ++ai)
#pragma unroll
            for (int m = 0; m < 4; ++m) { const size_t off = (size_t)(row0 + ai * HALF + m * 16) * ldc + col0;
                f32x4 r[2][2];
#pragma unroll
                for (int bj = 0; bj < 2; ++bj)
#pragma unroll
                    for (int n = 0; n < 2; ++n) r[bj][n] = *(const f32x4*)(res + off + bj * HALF + n * 16);
#pragma unroll
                for (int bj = 0; bj < 2; ++bj)
#pragma unroll
                    for (int n = 0; n < 2; ++n) *(f32x4*)(out + off + bj * HALF + n * 16) = r[bj][n] + acc[ai][bj][m][n]; }
    }
};
template <class Epi, class Sched, bool ALIGN_EPI = false, bool SP2 = false>
__device__ __forceinline__ void gemm_phase(PG8_LAS unsigned char* lds, const Gemm g, const Sched& S, const Epi& E) {
    int tid_ = threadIdx.x; asm volatile("" : "+v"(tid_));
    const int tid = tid_, wid = __builtin_amdgcn_readfirstlane(tid >> 6), lane = tid & 63, wr = wid >> 2, wc = wid & 3, fr = lane & 15, fq = lane >> 4;
    const int K = g.K, nt = K / BK;
    unsigned voffA[2], voffB[2];
#pragma unroll
    for (int i = 0; i < 2; ++i) { int R, C; stage_rc(tid * 16 + i * 8192, R, C); const int Rb = Epi::PERM ? ((R & ~31) + perm32(R & 31)) : R;
        voffA[i] = (unsigned)(R * K + C) * 2u; voffB[i] = (unsigned)(Rb * K + C) * 2u; }
    const size_t kstep = (size_t)(BK * 2);
    const size_t hstep = (size_t)HALF * K * 2;
    const size_t tstep = 2 * hstep;
    const unsigned ldsw = (unsigned)wid * 1024u;
    const int aoff = lds_byte(wr * 64 + fr, fq * 8), boff = lds_byte(wc * 32 + fr, fq * 8);
#define PG8_SA(b, h) (((b) * 2 + (h)) * HTB)
#define PG8_SB(b, h) ((4 + (b) * 2 + (h)) * HTB)
#define PG8_STAGE(bufoff, gbase, voff) do { _Pragma("unroll") for (int _i = 0; _i < 2; ++_i) \
        __builtin_amdgcn_global_load_lds((const unsigned*)((const char*)(gbase) + (voff)[_i]), (PG8_LAS unsigned*)(lds + (bufoff) + ldsw + _i * 8192), 16, 0, 0); } while (0)
#define PG8_LDA(dst, b, h) do { _Pragma("unroll") for (int m = 0; m < 4; ++m) _Pragma("unroll") for (int k = 0; k < 2; ++k) dst[m][k] = *(const PG8_LAS bf16x8*)(lds + PG8_SA(b, h) + aoff + m * 2048 + k * 1024); } while (0)
#define PG8_LDB(dst, b, h) do { _Pragma("unroll") for (int n = 0; n < 2; ++n) _Pragma("unroll") for (int k = 0; k < 2; ++k) dst[n][k] = *(const PG8_LAS bf16x8*)(lds + PG8_SB(b, h) + boff + n * 2048 + k * 1024); } while (0)
#define PG8_MMA(ai, bj, At, Bt) do { __builtin_amdgcn_s_setprio(1); _Pragma("unroll") for (int m = 0; m < 4; ++m) _Pragma("unroll") for (int n = 0; n < 2; ++n) _Pragma("unroll") for (int k = 0; k < 2; ++k) \
        acc[ai][bj][m][n] = __builtin_amdgcn_mfma_f32_16x16x32_bf16(Bt[n][k], At[m][k], acc[ai][bj][m][n], 0, 0, 0); __builtin_amdgcn_s_setprio(0); } while (0)
#define PG8_WAIT_V(n) asm volatile("s_waitcnt vmcnt(" #n ")" ::: "memory")
#define PG8_WAIT_L(n) asm volatile("s_waitcnt lgkmcnt(" #n ")" ::: "memory")
#define PG8_BAR __builtin_amdgcn_s_barrier()
#define PG8_SCHED __builtin_amdgcn_sched_barrier(0)
    Unit cur, nxt; int ui = 0;
    if (!S.next(0, cur)) return;
    f32x4 acc[2][2][4][2];
#pragma unroll
    for (int a = 0; a < 2; ++a)
#pragma unroll
        for (int b = 0; b < 2; ++b)
#pragma unroll
            for (int m = 0; m < 4; ++m)
#pragma unroll
                for (int n = 0; n < 2; ++n) acc[a][b][m][n] = (f32x4){0.f, 0.f, 0.f, 0.f};
    bf16x8 At[4][2], B0[2][2], B1[2][2];
    const char* cA = (const char*)g.A + (size_t)cur.pm * tstep; const char* cB = (const char*)g.Bt + (size_t)cur.pn * tstep;
    S.a_ready(cur);
    if constexpr (SP2) {
        PG8_STAGE(PG8_SB(0, 0), cB, voffB); PG8_STAGE(PG8_SB(0, 1), cB + hstep, voffB); PG8_STAGE(PG8_SA(0, 0), cA, voffA); PG8_STAGE(PG8_SA(0, 1), cA + hstep, voffA);
        if (wr == 1) PG8_BAR;
        PG8_WAIT_V(2); PG8_BAR;
        PG8_STAGE(PG8_SB(1, 0), cB + kstep, voffB); PG8_STAGE(PG8_SA(1, 0), cA + kstep, voffA); PG8_STAGE(PG8_SB(1, 1), cB + hstep + kstep, voffB);
        PG8_WAIT_V(6); PG8_BAR;
    } else {
        PG8_STAGE(PG8_SB(0, 0), cB, voffB); PG8_STAGE(PG8_SA(0, 0), cA, voffA); PG8_STAGE(PG8_SB(0, 1), cB + hstep, voffB); PG8_STAGE(PG8_SA(0, 1), cA + hstep, voffA);
        if (wr == 1) PG8_BAR;
        PG8_WAIT_V(4); PG8_BAR;
        PG8_STAGE(PG8_SB(1, 0), cB + kstep, voffB); PG8_STAGE(PG8_SA(1, 0), cA + kstep, voffA); PG8_STAGE(PG8_SB(1, 1), cB + hstep + kstep, voffB);
        PG8_WAIT_V(6); PG8_BAR;
    }
    for (;;) {
        const bool has_next = S.next(ui + 1, nxt);
        const char* nA = has_next ? (const char*)g.A + (size_t)nxt.pm * tstep : cA; const char* nB = has_next ? (const char*)g.Bt + (size_t)nxt.pn * tstep : cB;
        for (int t = 0; t < nt; t += 2) {
            const bool last = (t == nt - 2);
            const char* a1 = cA + (size_t)(t + 1) * kstep;
            const char* a2 = last ? nA : cA + (size_t)(t + 2) * kstep; const char* b2 = last ? nB : cB + (size_t)(t + 2) * kstep;
            const char* a3 = a2 + kstep; const char* b3 = b2 + kstep;
            if (last && has_next) S.a_ready(nxt);
            if constexpr (SP2) {
            PG8_LDB(B0, 0, 0); PG8_LDB(B1, 0, 1); PG8_SCHED; PG8_LDA(At, 0, 0); PG8_STAGE(PG8_SA(1, 1), a1 + hstep, voffA);
            PG8_WAIT_V(8); PG8_WAIT_L(0); PG8_BAR; PG8_MMA(0, 0, At, B0); PG8_MMA(0, 1, At, B1); PG8_BAR; PG8_SCHED;
            PG8_LDA(At, 0, 1); PG8_STAGE(PG8_SB(0, 0), b2, voffB); PG8_STAGE(PG8_SB(0, 1), b2 + hstep, voffB); PG8_STAGE(PG8_SA(0, 0), a2, voffA);
            PG8_WAIT_V(8); PG8_WAIT_L(0); PG8_BAR; PG8_MMA(1, 0, At, B0); PG8_MMA(1, 1, At, B1); PG8_BAR; PG8_SCHED;
            PG8_LDB(B0, 1, 0); PG8_LDB(B1, 1, 1); PG8_SCHED; PG8_LDA(At, 1, 0); PG8_STAGE(PG8_SA(0, 1), a2 + hstep, voffA);
            PG8_WAIT_V(8); PG8_WAIT_L(0); PG8_BAR; PG8_MMA(0, 0, At, B0); PG8_MMA(0, 1, At, B1); PG8_BAR; PG8_SCHED;
            PG8_LDA(At, 1, 1); PG8_STAGE(PG8_SB(1, 0), b3, voffB); PG8_STAGE(PG8_SB(1, 1), b3 + hstep, voffB); PG8_STAGE(PG8_SA(1, 0), a3, voffA);
            PG8_WAIT_V(8); PG8_WAIT_L(0); PG8_BAR; PG8_MMA(1, 0, At, B0); PG8_MMA(1, 1, At, B1); PG8_BAR; PG8_SCHED;
            } else {
            PG8_LDB(B0, 0, 0); PG8_SCHED; PG8_LDA(At, 0, 0); PG8_STAGE(PG8_SA(1, 1), a1 + hstep, voffA);
            PG8_WAIT_L(8); PG8_BAR; PG8_WAIT_L(0); PG8_MMA(0, 0, At, B0); PG8_BAR; PG8_SCHED;
            PG8_LDB(B1, 0, 1); PG8_STAGE(PG8_SB(0, 0), b2, voffB);
            PG8_BAR; PG8_WAIT_L(0); PG8_MMA(0, 1, At, B1); PG8_BAR;
            PG8_LDA(At, 0, 1); PG8_STAGE(PG8_SA(0, 0), a2, voffA);
            PG8_BAR; PG8_WAIT_L(0); PG8_MMA(1, 0, At, B0); PG8_BAR; PG8_SCHED;
            PG8_STAGE(PG8_SB(0, 1), b2 + hstep, voffB);
            PG8_WAIT_V(6); PG8_BAR; PG8_MMA(1, 1, At, B1); PG8_BAR;
            PG8_LDB(B0, 1, 0); PG8_SCHED; PG8_LDA(At, 1, 0); PG8_STAGE(PG8_SA(0, 1), a2 + hstep, voffA);
            PG8_WAIT_L(8); PG8_BAR; PG8_WAIT_L(0); PG8_MMA(0, 0, At, B0); PG8_BAR; PG8_SCHED;
            PG8_LDB(B1, 1, 1); PG8_STAGE(PG8_SB(1, 0), b3, voffB);
            PG8_BAR; PG8_WAIT_L(0); PG8_MMA(0, 1, At, B1); PG8_BAR;
            PG8_LDA(At, 1, 1); PG8_STAGE(PG8_SA(1, 0), a3, voffA);
            PG8_BAR; PG8_WAIT_L(0); PG8_MMA(1, 0, At, B0); PG8_BAR; PG8_SCHED;
            PG8_STAGE(PG8_SB(1, 1), b3 + hstep, voffB);
            PG8_WAIT_V(6); PG8_BAR; PG8_MMA(1, 1, At, B1); PG8_BAR;
            }
        }
        if constexpr (ALIGN_EPI) { if (wr == 0) PG8_BAR; }
        if constexpr (!Epi::AFTER_DRAIN) { E(acc, cur, wr, wc, fr, fq); S.done(cur); }
        if (!has_next) break;
#pragma unroll
        for (int a = 0; a < 2; ++a)
#pragma unroll
            for (int b = 0; b < 2; ++b)
#pragma unroll
                for (int m = 0; m < 4; ++m)
#pragma unroll
                    for (int n = 0; n < 2; ++n) acc[a][b][m][n] = (f32x4){0.f, 0.f, 0.f, 0.f};
        cur = nxt; cA = nA; cB = nB; ++ui;
        if constexpr (ALIGN_EPI) { if (wr == 1) PG8_BAR; }
    }
    PG8_WAIT_V(0);
    if constexpr (!ALIGN_EPI) { if (wr == 0) PG8_BAR; }
    PG8_BAR;
    if constexpr (Epi::AFTER_DRAIN) { E.fused(acc, cur, wr, wc, fr, fq, lds, wid, lane); S.done(cur); }
#undef PG8_SA
#undef PG8_SB
#undef PG8_STAGE
#undef PG8_LDA
#undef PG8_LDB
#undef PG8_MMA
#undef PG8_WAIT_V
#undef PG8_WAIT_L
#undef PG8_BAR
#undef PG8_SCHED
}
}
namespace fox {
constexpr int ALD = 2048;
constexpr int AD = 128;
constexpr float SCALE = 0.08838834764831845f;
constexpr float INVS = 11.313708498984761f;
constexpr float THR = 8.f;
constexpr int NW = 8, QBLK = 32, KVBLK = 64, QB = NW * QBLK;
constexpr int SHM_V = KVBLK * AD * 2, SHM_K = KVBLK * AD * 2;
constexpr int LDS_F = 2 * SHM_V + 2 * SHM_K + NW * 64 * 4;
constexpr int LDS_BYTES = LDS_F + 2 * 256;

using bf16 = __hip_bfloat16;
typedef short bf16x8 __attribute__((ext_vector_type(8)));
typedef short s16x4 __attribute__((ext_vector_type(4)));
typedef float f32x16 __attribute__((ext_vector_type(16)));
typedef float f32x4 __attribute__((ext_vector_type(4)));
typedef unsigned u32x4 __attribute__((ext_vector_type(4)));

#define KSWZ(row, colB) ((row) * 256 + ((colB) ^ (((row) & 7) << 4)))
#define SBAR() __builtin_amdgcn_sched_barrier(0)
__device__ __forceinline__ int v_st(int k, int c) { const int kk = (k & ~0xC) | ((k & 4) << 1) | ((k & 8) >> 1); return ((kk >> 3) * 4 + (c >> 5)) * 512 + ((kk & 7) * 32 + (c & 31)) * 2; }
__device__ __forceinline__ int v_rd_base(int lane) { return ((lane & 3) << 3) | (((lane >> 2) & 3) << 6) | (((lane >> 4) & 1) << 5) | (((lane >> 5) & 1) << 8); }
constexpr int v_rd_off(int d0, int ks, int half) { return d0 * 512 + ks * 4096 + half * 2048; }
__device__ __forceinline__ int crow(int r, int hi) { return (r & 3) + 8 * (r >> 2) + 4 * hi; }
__device__ __forceinline__ unsigned cvtpk(float lo, float hi) {
    unsigned r; asm volatile("v_cvt_pk_bf16_f32 %0, %1, %2" : "=v"(r) : "v"(lo), "v"(hi)); return r;
}
typedef __amdgpu_buffer_rsrc_t rsrc_t;
__device__ __forceinline__ rsrc_t mk_rsrc(const void* p) { return __builtin_amdgcn_make_buffer_rsrc((void*)p, (short)0, 0x7ffffff0, 0x00020000); }
__device__ __forceinline__ bf16x8 ldb8(rsrc_t r, int voff, int soff) { return __builtin_bit_cast(bf16x8, __builtin_amdgcn_raw_buffer_load_b128(r, voff, soff, 0)); }
__device__ __forceinline__ f32x4 ldf4(rsrc_t r, int voff, int soff) { return __builtin_bit_cast(f32x4, __builtin_amdgcn_raw_buffer_load_b128(r, voff, soff, 0)); }
__device__ __forceinline__ void mask_tile(f32x16& p0, f32x16& p1, int dq, unsigned W) {
    const float NEG = -__builtin_inff();
#pragma unroll
    for (int r = 0; r < 16; ++r) {
        const int c = (r & 3) + 8 * (r >> 2);
        if ((unsigned)(dq - c) >= W) p0[r] = NEG;
        if ((unsigned)(dq - c - 32) >= W) p1[r] = NEG;
    }
}
__device__ __forceinline__ void partialSM(f32x16& p0, f32x16& p1, float& m_reg, float& mn, float& alpha) {
    float pmax = p0[0]; for (int r = 1; r < 16; ++r) pmax = fmaxf(pmax, p0[r]); for (int r = 0; r < 16; ++r) pmax = fmaxf(pmax, p1[r]);
    { auto rr = __builtin_amdgcn_permlane32_swap(__float_as_uint(pmax), __float_as_uint(pmax), false, false);
      pmax = fmaxf(__uint_as_float(rr[0]), __uint_as_float(rr[1])); }
    constexpr float C2 = 1.4426950408889634f * SCALE;
    if (__builtin_expect(__all((pmax - m_reg) * SCALE <= THR), 1)) { mn = m_reg; alpha = 1.f; }
    else { mn = fmaxf(m_reg, pmax); alpha = __builtin_amdgcn_exp2f((m_reg - mn) * C2); m_reg = mn; }
    const float mnL = -mn * C2;
    for (int r = 0; r < 16; ++r) p0[r] = fmaf(p0[r], C2, mnL); for (int r = 0; r < 16; ++r) p1[r] = fmaf(p1[r], C2, mnL);
    for (int r = 0; r < 16; ++r) p0[r] = __builtin_amdgcn_exp2f(p0[r]);
}
__device__ __forceinline__ void finishSM(f32x16& p0, f32x16& p1, float alpha, float& l_reg, bf16x8& pa0, bf16x8& pa1, bf16x8& pa2, bf16x8& pa3) {
    for (int r = 0; r < 16; ++r) p1[r] = __builtin_amdgcn_exp2f(p1[r]);
    float ps = 0; for (int r = 0; r < 16; ++r) ps += p0[r]; for (int r = 0; r < 16; ++r) ps += p1[r];
    { auto rr = __builtin_amdgcn_permlane32_swap(__float_as_uint(ps), __float_as_uint(ps), false, false);
      ps = __uint_as_float(rr[0]) + __uint_as_float(rr[1]); }
    l_reg = l_reg * alpha + ps;
#define PK4(P, B_, OUT) do { unsigned a0 = cvtpk(P[B_+0], P[B_+1]), a1 = cvtpk(P[B_+2], P[B_+3]);                          \
        unsigned b0 = cvtpk(P[B_+4], P[B_+5]), b1 = cvtpk(P[B_+6], P[B_+7]);                                             \
        auto r0 = __builtin_amdgcn_permlane32_swap(a0, b0, false, false); auto r1 = __builtin_amdgcn_permlane32_swap(a1, b1, false, false); \
        u32x4 w = {r0[0], r1[0], r0[1], r1[1]}; OUT = *reinterpret_cast<bf16x8*>(&w); } while (0)
    PK4(p0, 0, pa0); PK4(p0, 8, pa1); PK4(p1, 0, pa2); PK4(p1, 8, pa3);
#undef PK4
}
template <int KB>
__device__ __forceinline__ void qkt(f32x16& p0, f32x16& p1, const char* K_lds, const char* F_lds, int r32, int hi, const bf16x8* qr) {
    { const f32x4* fk = reinterpret_cast<const f32x4*>(F_lds + KB * 256);
#pragma unroll
      for (int g = 0; g < 4; ++g) { const f32x4 a = fk[2 * g + hi], b = fk[8 + 2 * g + hi];
#pragma unroll
          for (int e = 0; e < 4; ++e) { p0[4 * g + e] = a[e]; p1[4 * g + e] = b[e]; } } }
    const char* kb[4];
#pragma unroll
    for (int dd = 0; dd < 4; ++dd) kb[dd] = K_lds + KB * SHM_K + KSWZ(r32, (dd * 16 + hi * 8) * 2);
#pragma unroll
    for (int d0 = 0; d0 < 8; ++d0) { const char* a = kb[d0 & 3] + (d0 >> 2) * 128;
        bf16x8 b0 = *reinterpret_cast<const bf16x8*>(a);
        bf16x8 b1 = *reinterpret_cast<const bf16x8*>(a + 32 * 256);
        p0 = __builtin_amdgcn_mfma_f32_32x32x16_bf16(b0, qr[d0], p0, 0, 0, 0);
        p1 = __builtin_amdgcn_mfma_f32_32x32x16_bf16(b1, qr[d0], p1, 0, 0, 0); }
}
template <int VB>
__device__ __forceinline__ void pv_tile(f32x16* o, int vb0, bf16x8 pa0, bf16x8 pa1, bf16x8 pa2, bf16x8 pa3) {
#define TRRD(dst, off) asm volatile("ds_read_b64_tr_b16 %0, %1 offset:%2" : "=&v"(dst) : "v"(vb0), "i"(off) : "memory")
#define PV_D0(d0) do { s16x4 l0, l1, l2, l3, h0, h1, h2, h3; constexpr int b_ = VB * SHM_V + v_rd_off(d0, 0, 0);     \
        TRRD(l0, b_); TRRD(h0, b_ + 2048); TRRD(l1, b_ + 4096); TRRD(h1, b_ + 6144); TRRD(l2, b_ + 8192); TRRD(h2, b_ + 10240); TRRD(l3, b_ + 12288); TRRD(h3, b_ + 14336); \
        asm volatile("s_waitcnt lgkmcnt(0)" ::: "memory"); SBAR();                 \
        o[d0] = __builtin_amdgcn_mfma_f32_32x32x16_bf16(pa0, (bf16x8){l0[0], l0[1], l0[2], l0[3], h0[0], h0[1], h0[2], h0[3]}, o[d0], 0, 0, 0);   \
        o[d0] = __builtin_amdgcn_mfma_f32_32x32x16_bf16(pa1, (bf16x8){l1[0], l1[1], l1[2], l1[3], h1[0], h1[1], h1[2], h1[3]}, o[d0], 0, 0, 0);   \
        o[d0] = __builtin_amdgcn_mfma_f32_32x32x16_bf16(pa2, (bf16x8){l2[0], l2[1], l2[2], l2[3], h2[0], h2[1], h2[2], h2[3]}, o[d0], 0, 0, 0);   \
        o[d0] = __builtin_amdgcn_mfma_f32_32x32x16_bf16(pa3, (bf16x8){l3[0], l3[1], l3[2], l3[3], h3[0], h3[1], h3[2], h3[3]}, o[d0], 0, 0, 0); } while (0)
    PV_D0(0); PV_D0(1); PV_D0(2); PV_D0(3);
#undef PV_D0
#undef TRRD
}

struct BlockRef { const bf16* Q; const bf16* K; const bf16* V; bf16* O; const float* F; int P0; };
struct Seam {
    bf16x8 qr[8];
    bf16x8 st_v0, st_v1, st_k0, st_k1; f32x4 st_f;
};
#define VMW() asm volatile("s_waitcnt vmcnt(0)" ::: "memory")
#define VMWN(n) asm volatile("s_waitcnt vmcnt(%0)" :: "i"(n) : "memory")
#define SLOAD_H(rK_, rV_, rF_, k0) do { const int so_ = (k0) * (ALD * 2);                                                    \
                         S.st_v0 = ldb8(rV_, kvoff, so_); S.st_v1 = ldb8(rV_, kvoff, so_ + 32 * ALD * 2);                    \
                         S.st_k0 = ldb8(rK_, kvoff, so_); S.st_k1 = ldb8(rK_, kvoff, so_ + 32 * ALD * 2);                    \
                         if (tid < 16) S.st_f = ldf4(rF_, tid * 16, (k0) * 4); } while (0)
#define QLOAD(rQ_) do { _Pragma("unroll") for (int d0 = 0; d0 < 8; ++d0) S.qr[d0] = ldb8(rQ_, qoff + d0 * 32, 0); } while (0)
#define SWRITE_HK(bf) do { *(bf16x8*)(K_lds + (bf) * SHM_K + kws) = S.st_k0; *(bf16x8*)(K_lds + (bf) * SHM_K + kws + 32 * 256) = S.st_k1; \
                           if (tid < 16) *(f32x4*)(F_lds + (bf) * 256 + tid * 16) = S.st_f; } while (0)
#define SWRITE_HV(bf) do { *(bf16x8*)(V_lds + (bf) * SHM_V + vst0) = S.st_v0; *(bf16x8*)(V_lds + (bf) * SHM_V + vst1) = S.st_v1; } while (0)
#define SWRITE_H(bf) do { SWRITE_HV(bf); SWRITE_HK(bf); } while (0)
__device__ __forceinline__ void causal_prime(const BlockRef& cur, char* lds, Seam& S) {
    int tid_ = threadIdx.x; asm volatile("" : "+v"(tid_));
    const int tid = tid_, wid = __builtin_amdgcn_readfirstlane(tid >> 6), lane = tid & 63, r32 = lane & 31, hi = lane >> 5;
    const int sr = tid >> 4, sc = (tid & 15) * 8, kws = KSWZ(sr, sc * 2); char* K_lds = lds + 2 * SHM_V; char* F_lds = lds + LDS_F;
    const int kvoff = (sr * ALD + sc) * 2, qoff = ((wid * QBLK + r32) * ALD + hi * 8) * 2;
    const rsrc_t rQ = mk_rsrc(cur.Q), rK = mk_rsrc(cur.K), rV = mk_rsrc(cur.V), rF = mk_rsrc(cur.F);
    QLOAD(rQ);
    SLOAD_H(rK, rV, rF, 0); VMW(); SWRITE_HK(0);
    __syncthreads();
}
__device__ __forceinline__ void causal_block(const BlockRef& cur, const BlockRef& nxt, char* lds, Seam& S) {
    int tid_ = threadIdx.x; asm volatile("" : "+v"(tid_));
    const int tid = tid_, wid = __builtin_amdgcn_readfirstlane(tid >> 6), lane = tid & 63, r32 = lane & 31, hi = lane >> 5;
    constexpr int W = 1 << 30;
    const int NT = (cur.P0 + QB - 1) / KVBLK + 1;
    const int qlo = cur.P0 + wid * QBLK, qm = qlo + r32 - 4 * hi;
    char* V_lds = lds; char* K_lds = lds + 2 * SHM_V; char* F_lds = lds + LDS_F;
    float* ws = (float*)(lds + 2 * SHM_V + 2 * SHM_K) + wid * 64; float* li_l = ws, * al_l = ws + 32;
    float m_reg = -1e30f, l_reg = 0; f32x16 o[4] = {};
    const int sr = tid >> 4, sc = (tid & 15) * 8, vst0 = v_st(sr, sc), vst1 = v_st(32 + sr, sc), kws = KSWZ(sr, sc * 2);
    const int vb0 = (int)(uintptr_t)V_lds + v_rd_base(lane);
    const int kvoff = (sr * ALD + sc) * 2, qoff = ((wid * QBLK + r32) * ALD + hi * 8) * 2;
    const rsrc_t Kh = mk_rsrc(cur.K), Vh = mk_rsrc(cur.V), Fh = mk_rsrc(cur.F);
#define RESC(a) do { if (__any((a) < 1.f)) { if (hi == 0) al_l[r32] = (a); asm volatile("s_waitcnt lgkmcnt(0)" ::: "memory");              \
                     for (int d_ = 0; d_ < 4; ++d_) for (int r = 0; r < 16; ++r) o[d_][r] *= al_l[crow(r, hi)]; } } while (0)
#define KBASE(t) ((t) * KVBLK)
#define MASKT(P0_, P1_, t) do { const int kb_ = KBASE(t); if (kb_ + KVBLK - 1 > qlo) mask_tile(P0_, P1_, qm - kb_, (unsigned)W); } while (0)
    constexpr int NQL = 8;
#define SEAM_K0() do { VMWN(NQL); SWRITE_HK(0); SBAR(); } while (0)
    f32x16 pA0, pA1, pB0, pB1; float mnA, mnB, alA, alB; bf16x8 pa0, pa1, pa2, pa3;
    SWRITE_HV(0); SBAR();
    if (NT > 1) { SLOAD_H(Kh, Vh, Fh, KBASE(1)); }
    SBAR(); qkt<0>(pA0, pA1, K_lds, F_lds, r32, hi, S.qr);
    MASKT(pA0, pA1, 0); partialSM(pA0, pA1, m_reg, mnA, alA);
    if (NT > 1) { VMW(); SWRITE_H(1); }
    __syncthreads();
#define HALF_STEP(PX0, PX1, mnX, alX, PY0, PY1, alY, t, KB, VB, SB) do {                                                      \
        SBAR(); qkt<KB>(PX0, PX1, K_lds, F_lds, r32, hi, S.qr);                                                               \
        finishSM(PY0, PY1, alY, l_reg, pa0, pa1, pa2, pa3); SBAR();                                                           \
        if ((t) + 1 < NT) { SLOAD_H(Kh, Vh, Fh, KBASE((t) + 1)); SBAR(); }                                                    \
        pv_tile<VB>(o, vb0, pa0, pa1, pa2, pa3); MASKT(PX0, PX1, (t)); partialSM(PX0, PX1, m_reg, mnX, alX);                  \
        __syncthreads();                                                                                                      \
        if ((t) + 1 < NT) { VMW(); SWRITE_H(SB); }                                                                            \
        RESC(alX); __syncthreads(); } while (0)
    for (int t = 1; t + 1 < NT; t += 2) {
        HALF_STEP(pB0, pB1, mnB, alB, pA0, pA1, alA, t, 1, 0, 0);
        HALF_STEP(pA0, pA1, mnA, alA, pB0, pB1, alB, t + 1, 0, 1, 1);
    }
    const bool even = (NT & 1) == 0;
    if (even) { SBAR(); qkt<1>(pB0, pB1, K_lds, F_lds, r32, hi, S.qr); SBAR(); }
    { const rsrc_t nK = mk_rsrc(nxt.K), nV = mk_rsrc(nxt.V), nF = mk_rsrc(nxt.F), nQ = mk_rsrc(nxt.Q);
      SLOAD_H(nK, nV, nF, 0); SBAR();
      QLOAD(nQ); }
    SBAR();
    finishSM(pA0, pA1, alA, l_reg, pa0, pa1, pa2, pa3); SBAR();
    pv_tile<0>(o, vb0, pa0, pa1, pa2, pa3);
    if (even) { MASKT(pB0, pB1, NT - 1); partialSM(pB0, pB1, m_reg, mnB, alB); __syncthreads(); RESC(alB);
        finishSM(pB0, pB1, alB, l_reg, pa0, pa1, pa2, pa3); SBAR(); pv_tile<1>(o, vb0, pa0, pa1, pa2, pa3); }
    SBAR(); SEAM_K0();
    if (hi == 0) li_l[r32] = l_reg; asm volatile("s_waitcnt lgkmcnt(0)" ::: "memory");
    float rli[16];
#pragma unroll
    for (int r = 0; r < 16; ++r) rli[r] = __builtin_amdgcn_rcpf(li_l[crow(r, hi)]);
    { const rsrc_t rO = mk_rsrc(cur.O); const int ooff = ((wid * QBLK + 4 * hi) * ALD + r32) * 2;
#pragma unroll
      for (int r = 0; r < 16; ++r) {
#pragma unroll
        for (int d0 = 0; d0 < 4; ++d0) { const float v = o[d0][r] * rli[r];
            const float vn = __shfl_xor(v, 1);
            if ((r32 & 1) == 0) __builtin_amdgcn_raw_buffer_store_b32(cvtpk(v, vn), rO, ooff + d0 * 64, ((r & 3) + 8 * (r >> 2)) * (ALD * 2), 0); } } }
    __syncthreads();
#undef RESC
#undef KBASE
#undef MASKT
#undef SEAM_K0
#undef HALF_STEP
}
#undef QLOAD
#undef VMW
#undef VMWN
#undef SLOAD_H
#undef SWRITE_HK
#undef SWRITE_HV
#undef SWRITE_H
#undef KSWZ
#undef SBAR
}
#define GAS __attribute__((address_space(1)))
#define LAS __attribute__((address_space(3)))
typedef unsigned short bf16;
typedef unsigned v4u __attribute__((ext_vector_type(4)));
typedef float f32x4 __attribute__((ext_vector_type(4)));
typedef short bf16x8 __attribute__((ext_vector_type(8)));
typedef GAS unsigned gu32;
typedef GAS unsigned long long gu64;
#define RLX_AGENT __ATOMIC_RELAXED, __HIP_MEMORY_SCOPE_AGENT
#define LDS_WAIT() asm volatile("s_waitcnt lgkmcnt(0)" ::: "memory")
#define VM_WAIT() asm volatile("s_waitcnt vmcnt(0)" ::: "memory")
__device__ __forceinline__ unsigned long long rt() { return __builtin_amdgcn_s_memrealtime(); }
__device__ __forceinline__ unsigned f2bf(float f) { unsigned u = __builtin_bit_cast(unsigned, f); return (u + 0x7fffu + ((u >> 16) & 1u)) >> 16; }
__device__ __forceinline__ unsigned pk2(float lo, float hi) { return f2bf(lo) | (f2bf(hi) << 16); }
#define XB_TMO      128
#define XB_XCNT(j)  (256  + 64 * (j))
#define XB_XSUB(j)  (1280 + 64 * (j))
#define XB_XGEN(j)  (2304 + 64 * (j))
#define XB_TOP      3328
#define XB_TOPGEN   3392
#define XCD_BAR_WORDS 3456
#define XB_SPIN_CAP (1u << 18)

__device__ __forceinline__ unsigned xb_ld(unsigned* p)              { return __hip_atomic_load(p, __ATOMIC_RELAXED, __HIP_MEMORY_SCOPE_AGENT); }
__device__ __forceinline__ unsigned xb_add(unsigned* p, unsigned v) { return __hip_atomic_fetch_add(p, v, __ATOMIC_RELAXED, __HIP_MEMORY_SCOPE_AGENT); }
__device__ __forceinline__ unsigned xb_xcc_id() { return (unsigned)__builtin_amdgcn_s_getreg((3 << 11) | 20) & 0xFu; }
#define XB_SPIN(cond, bar) do { unsigned _sp = 0; while (cond) { __builtin_amdgcn_s_sleep(1); \
    if ((++_sp & 255u) == 0u) { if (xb_ld(&(bar)[XB_TMO])) break; if (_sp > XB_SPIN_CAP) { atomicAdd(&(bar)[XB_TMO], 1u); break; } } } } while (0)

struct XcdBarrier {
    unsigned* bar; unsigned x;
    volatile LAS unsigned* st;
};

__device__ __forceinline__ XcdBarrier xcd_barrier_post(unsigned* bar, volatile LAS unsigned* st) {
    XcdBarrier b; b.bar = bar; b.x = xb_xcc_id(); b.st = st;
    if (threadIdx.x == 0) (void)xb_add(&bar[XB_XCNT(b.x)], 1u);
    return b;
}
__device__ __forceinline__ void xcd_barrier_complete(unsigned* bar, unsigned x, unsigned& nloc, unsigned& nx) {
    const unsigned G = gridDim.x * gridDim.y * gridDim.z;
    unsigned sum, cnt, mine, sp = 0u;
    for (;;) {
        sum = 0u; cnt = 0u; mine = 0u;
#pragma unroll
        for (unsigned j = 0; j < 16; ++j) { const unsigned c = xb_ld(&bar[XB_XCNT(j)]); sum += c; cnt += (c > 0u) ? 1u : 0u; mine = (j == x) ? c : mine; }
        if (sum == G) break;
        __builtin_amdgcn_s_sleep(1);
        if ((++sp & 255u) == 0u) { if (xb_ld(&bar[XB_TMO])) break; if (sp > XB_SPIN_CAP) { atomicAdd(&bar[XB_TMO], 1u); break; } }
    }
    nloc = mine > 0u ? mine : 1u; nx = cnt > 0u ? cnt : 1u;
}

__device__ __forceinline__ void xcd_barrier(const XcdBarrier& b) {
    asm volatile("s_waitcnt vmcnt(0)" ::: "memory");
    __syncthreads();
    if (threadIdx.x == 0) {
        unsigned* bar = b.bar;
        __builtin_amdgcn_s_waitcnt(0);
        unsigned nloc = b.st[0], nx = b.st[1];
        if (nloc == 0u) { xcd_barrier_complete(bar, b.x, nloc, nx); b.st[0] = nloc; b.st[1] = nx; }
        const unsigned old = xb_add(&bar[XB_XSUB(b.x)], 1u);
        const unsigned gen = old / nloc;
        if (old + 1u == (gen + 1u) * nloc) {
            __builtin_amdgcn_fence(__ATOMIC_RELEASE, "agent");
            asm volatile("s_waitcnt vmcnt(0)" ::: "memory");
            const unsigned og = xb_add(&bar[XB_TOP], 1u);
            const unsigned tg = og / nx;
            if (og + 1u == (tg + 1u) * nx) xb_add(&bar[XB_TOPGEN], 1u);
            else XB_SPIN(xb_ld(&bar[XB_TOPGEN]) == tg, bar);
            __builtin_amdgcn_fence(__ATOMIC_ACQUIRE, "agent");
            xb_add(&bar[XB_XGEN(b.x)], 1u);
            asm volatile("s_waitcnt vmcnt(0)" ::: "memory");
        } else {
            XB_SPIN(xb_ld(&bar[XB_XGEN(b.x)]) == gen, bar);
            __builtin_amdgcn_fence(__ATOMIC_ACQUIRE, "agent");
            asm volatile("s_waitcnt vmcnt(0)" ::: "memory");
        }
    }
    __syncthreads();
}
constexpr int NWAVES = 8;
#ifndef ONE_LAUNCH
#define ONE_LAUNCH 1
#endif
constexpr int BATCH = 4, T = 4096, D = 2048, H = 16, HD = 128;
constexpr int M = BATCH * T;
constexpr int NPA = 8192;
constexpr float EPS = 1e-6f;
constexpr size_t MiB = 1u << 20;
constexpr size_t WS_CTL = 0, CTL_ZERO_BYTES = 1 * MiB;
constexpr size_t WS_WINA = 2 * MiB;
constexpr size_t WS_WOUTA = 66 * MiB;
constexpr size_t WS_WKVQ = 82 * MiB;
constexpr size_t WS_WINB1 = 114 * MiB;
constexpr size_t WS_WOUTB = 130 * MiB;
constexpr size_t WS_XN = 146 * MiB;
constexpr size_t WS_PROJ = 210 * MiB;
constexpr size_t WS_FZ = 466 * MiB;
constexpr size_t WS_F = 467 * MiB;
constexpr size_t WS_END = 468 * MiB;
constexpr size_t SLOT = (size_t)M * D;
constexpr int CW_TMO = 0, CW_CODE = 1;
constexpr int CW_BAR = 4096;
constexpr int RING_OFF = 0, RING_BYTES = 131072;
constexpr int SCRATCH_BYTES = 139264;
constexpr int LDSCTL_OFF = SCRATCH_BYTES, MISC_OFF = LDSCTL_OFF + 320;
constexpr int LDS_BYTES = 147456;
static_assert(MISC_OFF + 128 <= LDS_BYTES, "LDS map");

struct Frame {
    LAS unsigned char* lds;
    volatile LAS unsigned* MISC;
    gu32* ctl;
    int tid, lane, wave;
    int vcu, G;
};
__device__ __forceinline__ void phase_tid(Frame& F) { int t = threadIdx.x; asm volatile("" : "+v"(t)); F.tid = t; F.lane = t & 63; F.wave = __builtin_amdgcn_readfirstlane(t >> 6); }

__device__ __forceinline__ float wave_sum(float v) {
#pragma unroll
    for (int o = 1; o < 64; o <<= 1) v += __shfl_xor(v, o);
    return v;
}
__device__ __forceinline__ float bf2f(unsigned short b) { return __uint_as_float((unsigned)b << 16); }
__device__ __forceinline__ float bflo(unsigned w) { return __uint_as_float(w << 16); }
__device__ __forceinline__ float bfhi(unsigned w) { return __uint_as_float(w & 0xffff0000u); }

__device__ __forceinline__ void p0_transpose_item(const float* W, int ldw, int ncols, const float* nw, bf16* WT, LAS float* scr, int item, int lane) {
    const int nblk = ncols / 32, kb = item / nblk, nb = item % nblk, k0 = 64 * kb, n0 = 32 * nb;
#pragma unroll 8
    for (int i = 0; i < 32; ++i) { const int kk = 2 * i + (lane >> 5); const float s = nw ? nw[k0 + kk] : 1.f; scr[kk * 33 + (lane & 31)] = W[(size_t)(k0 + kk) * ldw + n0 + (lane & 31)] * s; }
    LDS_WAIT(); asm volatile("" ::: "memory");
    const int c = lane & 7;
#pragma unroll
    for (int j = 0; j < 4; ++j) { const int n = (lane >> 3) + 8 * j; const LAS float* s = scr + (8 * c) * 33 + n;
        v4u o; o.x = pk2(s[0 * 33], s[1 * 33]); o.y = pk2(s[2 * 33], s[3 * 33]); o.z = pk2(s[4 * 33], s[5 * 33]); o.w = pk2(s[6 * 33], s[7 * 33]);
        *(GAS v4u*)(WT + (size_t)(n0 + n) * D + k0 + 8 * c) = o; }
    LDS_WAIT(); asm volatile("" ::: "memory");
}
__device__ __forceinline__ void norm_rows(Frame& F, const float* xin, bf16* xn) {
    const int gw = F.vcu * NWAVES + F.wave, NGW = F.G * NWAVES;
    for (int m = gw; m < M; m += NGW) {
        const GAS f32x4* xr = (const GAS f32x4*)(xin + (size_t)m * D) + F.lane;
        f32x4 v[8]; float s = 0.f;
#pragma unroll
        for (int j = 0; j < 8; ++j) { v[j] = xr[64 * j]; s += (v[j].x * v[j].x + v[j].y * v[j].y) + (v[j].z * v[j].z + v[j].w * v[j].w); }
        const float r = 1.0f / sqrtf(wave_sum(s) * (1.f / D) + EPS);
        GAS unsigned long long* o8 = (GAS unsigned long long*)(xn + (size_t)m * D) + F.lane;
#pragma unroll
        for (int j = 0; j < 8; ++j) o8[64 * j] = (unsigned long long)pk2(v[j].x * r, v[j].y * r) | ((unsigned long long)pk2(v[j].z * r, v[j].w * r) << 32);
    }
}
__device__ __forceinline__ void p0_prologue(Frame& F, const float* const* in, unsigned char* ws) {
    LAS float* scr = (LAS float*)(F.lds + RING_OFF + F.wave * 16384);
    const int gw = F.vcu * NWAVES + F.wave, NGW = F.G * NWAVES;
    constexpr int I_INA = 32 * 256, I_SQ = 32 * 64, I_4K = 32 * 128;
    constexpr int NITEMS = 2 * I_INA + 2 * I_SQ + 3 * I_4K + 2 * I_SQ;
    for (int it = gw; it < NITEMS; it += NGW) {
        int r = it;
        if (r < 2 * I_INA) { const int l = r / I_INA; r -= l * I_INA; p0_transpose_item(in[2] + (size_t)l * D * NPA, NPA, NPA, in[1] + l * D, (bf16*)(ws + WS_WINA) + (size_t)l * NPA * D, scr, r, F.lane); continue; } r -= 2 * I_INA;
        if (r < 2 * I_SQ) { const int l = r / I_SQ; r -= l * I_SQ; p0_transpose_item(in[5] + (size_t)l * D * D, D, D, nullptr, (bf16*)(ws + WS_WOUTA) + (size_t)l * D * D, scr, r, F.lane); continue; } r -= 2 * I_SQ;
        if (r < I_4K) { p0_transpose_item(in[7], 2 * D + H, 2 * D, in[6], (bf16*)(ws + WS_WKVQ), scr, r, F.lane); continue; } r -= I_4K;
        if (r < I_4K) { p0_transpose_item(in[11], 2 * D, 2 * D, in[10], (bf16*)(ws + WS_WKVQ) + (size_t)2 * D * D, scr, r, F.lane); continue; } r -= I_4K;
        if (r < I_4K) { p0_transpose_item(in[11] + (size_t)D * 2 * D, 2 * D, 2 * D, in[10] + D, (bf16*)(ws + WS_WINB1), scr, r, F.lane); continue; } r -= I_4K;
        { const int l = r / I_SQ; r -= l * I_SQ; p0_transpose_item(in[14] + (size_t)l * D * D, D, D, nullptr, (bf16*)(ws + WS_WOUTB) + (size_t)l * D * D, scr, r, F.lane); }
    }
    norm_rows(F, in[0], (bf16*)(ws + WS_XN));
}
__device__ __forceinline__ float sum16(float v) { v += __shfl_xor(v, 1); v += __shfl_xor(v, 2); v += __shfl_xor(v, 4); v += __shfl_xor(v, 8); return v; }
__device__ __forceinline__ void headnorm_rows(Frame& F, bf16* X, const float* w) {
    const int gw = F.vcu * NWAVES + F.wave, NGW = F.G * NWAVES;
    for (int m = gw; m < M; m += NGW) {
        GAS v4u* xr = (GAS v4u*)(X + (size_t)m * D) + F.lane;
#pragma unroll
        for (int j = 0; j < 4; ++j) {
            const v4u x = xr[64 * j]; float f[8] = {bflo(x.x), bfhi(x.x), bflo(x.y), bfhi(x.y), bflo(x.z), bfhi(x.z), bflo(x.w), bfhi(x.w)};
            float s = 0.f;
#pragma unroll
            for (int e = 0; e < 8; ++e) s += f[e] * f[e];
            const float r = 1.0f / sqrtf(sum16(s) * (1.f / HD) + EPS);
            const int d0 = (8 * F.lane) & 127;
            const f32x4 w0 = *(const f32x4*)(w + d0), w1 = *(const f32x4*)(w + d0 + 4);
            v4u o; o.x = pk2(f[0] * r * w0.x, f[1] * r * w0.y); o.y = pk2(f[2] * r * w0.z, f[3] * r * w0.w); o.z = pk2(f[4] * r * w1.x, f[5] * r * w1.y); o.w = pk2(f[6] * r * w1.z, f[7] * r * w1.w);
            xr[64 * j] = o;
        }
    }
}
__device__ __forceinline__ float silu_f(float g) { return g / (1.f + __expf(-g)); }
__device__ __forceinline__ void gatenorm_rows(Frame& F, bf16* O, const bf16* G, const float* w) {
    const int gw = F.vcu * NWAVES + F.wave, NGW = F.G * NWAVES;
    for (int m = gw; m < M; m += NGW) {
        GAS v4u* xr = (GAS v4u*)(O + (size_t)m * D) + F.lane; const GAS v4u* gr = (const GAS v4u*)(G + (size_t)m * D) + F.lane;
#pragma unroll
        for (int j = 0; j < 4; ++j) {
            const v4u x = xr[64 * j], g = gr[64 * j];
            float f[8] = {bflo(x.x), bfhi(x.x), bflo(x.y), bfhi(x.y), bflo(x.z), bfhi(x.z), bflo(x.w), bfhi(x.w)};
            const float q[8] = {bflo(g.x), bfhi(g.x), bflo(g.y), bfhi(g.y), bflo(g.z), bfhi(g.z), bflo(g.w), bfhi(g.w)};
            float s = 0.f;
#pragma unroll
            for (int e = 0; e < 8; ++e) s += f[e] * f[e];
            const float r = 1.0f / sqrtf(sum16(s) * (1.f / HD) + EPS);
            const int c0 = 8 * (F.lane + 64 * j);
            const f32x4 w0 = *(const f32x4*)(w + c0), w1 = *(const f32x4*)(w + c0 + 4);
            const float ww[8] = {w0.x, w0.y, w0.z, w0.w, w1.x, w1.y, w1.z, w1.w};
#pragma unroll
            for (int e = 0; e < 8; ++e) f[e] = f[e] * r * ww[e] * silu_f(q[e]);
            v4u o; o.x = pk2(f[0], f[1]); o.y = pk2(f[2], f[3]); o.z = pk2(f[4], f[5]); o.w = pk2(f[6], f[7]);
            xr[64 * j] = o;
        }
    }
}
__device__ __forceinline__ void recur_naive(Frame& F, const bf16* Qp, const bf16* Zp, const bf16* Vp, bf16* Op, const float* lbl, int layer) {
    LAS float* sq = (LAS float*)(F.lds); LAS float* sk = sq + 2048; LAS float* sf = sk + 2048; LAS float* sv = sf + 2048; LAS float* part = sv + 2048;
    const int tid = F.tid, dv = tid & 127, kq = tid >> 7, ts = tid >> 5, d4 = (tid & 31) * 4;
    for (int u = blockIdx.x; u < BATCH * H; u += F.G) {
        const int b = u / H, h = u % H;
        float lb[4];
#pragma unroll
        for (int e = 0; e < 4; ++e) { const int c = h * HD + d4 + e; const float l0 = lbl[c], l1 = lbl[D + c]; lb[e] = layer == 0 ? 0.f : 1.f / (1.f + __expf(l0 - l1)); }
        float S[32];
#pragma unroll
        for (int i = 0; i < 32; ++i) S[i] = 0.f;
        for (int tb = 0; tb < T; tb += 16) {
            const size_t off = (size_t)(b * T + tb + ts) * D + h * HD + d4;
            const uint2 q2 = *(const uint2*)(Qp + off), z2 = *(const uint2*)(Zp + off), v2 = *(const uint2*)(Vp + off);
            const float qf[4] = {bflo(q2.x), bfhi(q2.x), bflo(q2.y), bfhi(q2.y)}, zf[4] = {bflo(z2.x), bfhi(z2.x), bflo(z2.y), bfhi(z2.y)}, vf[4] = {bflo(v2.x), bfhi(v2.x), bflo(v2.y), bfhi(v2.y)};
#pragma unroll
            for (int e = 0; e < 4; ++e) {
                const float z = zf[e], ez = __expf(-fabsf(z)), inv = 1.f / (1.f + ez);
                const float sig = z >= 0.f ? inv : ez * inv, nsig = z >= 0.f ? ez * inv : inv;
                sq[ts * 128 + d4 + e] = qf[e]; sk[ts * 128 + d4 + e] = (1.f - lb[e]) * nsig; sf[ts * 128 + d4 + e] = lb[e] + (1.f - lb[e]) * sig; sv[ts * 128 + d4 + e] = vf[e];
            }
            __syncthreads();
#pragma unroll 1
            for (int tt = 0; tt < 16; ++tt) {
                const float vv = sv[tt * 128 + dv]; float p = 0.f;
#pragma unroll
                for (int i4 = 0; i4 < 8; ++i4) {
                    const f32x4 f4 = *(const LAS f32x4*)(sf + tt * 128 + kq * 32 + 4 * i4), k4 = *(const LAS f32x4*)(sk + tt * 128 + kq * 32 + 4 * i4), q4 = *(const LAS f32x4*)(sq + tt * 128 + kq * 32 + 4 * i4);
#pragma unroll
                    for (int e = 0; e < 4; ++e) { S[4 * i4 + e] = f4[e] * S[4 * i4 + e] + k4[e] * vv; p += q4[e] * S[4 * i4 + e]; }
                }
                part[(kq * 16 + tt) * 128 + dv] = p;
            }
            __syncthreads();
            float o4[4];
#pragma unroll
            for (int e = 0; e < 4; ++e) o4[e] = (part[(0 * 16 + ts) * 128 + d4 + e] + part[(1 * 16 + ts) * 128 + d4 + e]) + (part[(2 * 16 + ts) * 128 + d4 + e] + part[(3 * 16 + ts) * 128 + d4 + e]);
            uint2 o2; o2.x = pk2(o4[0], o4[1]); o2.y = pk2(o4[2], o4[3]);
            *(uint2*)(Op + off) = o2;
        }
        __syncthreads();
    }
}
__device__ __forceinline__ void fz_rows(Frame& F, const bf16* xn, const float* kvw, const float* kvnw, const float* fbias, float* fzls) {
    LAS float* wf = (LAS float*)(F.lds);
    for (int idx = F.tid; idx < D * 16; idx += NWAVES * 64) { const int k = idx >> 4, j = idx & 15; wf[k * 16 + (k >> 3) * 4 + j] = kvw[(size_t)k * (2 * D + H) + 2 * D + j] * kvnw[k]; }
    __syncthreads();
    const int gw = F.vcu * NWAVES + F.wave, NGW = F.G * NWAVES;
    for (int m = gw; m < M; m += NGW) {
        const GAS v4u* xr = (const GAS v4u*)(xn + (size_t)m * D) + F.lane;
        float acc[16];
#pragma unroll
        for (int j = 0; j < 16; ++j) acc[j] = 0.f;
#pragma unroll 1
        for (int jj = 0; jj < 4; ++jj) {
            const v4u x = xr[64 * jj]; const float f[8] = {bflo(x.x), bfhi(x.x), bflo(x.y), bfhi(x.y), bflo(x.z), bfhi(x.z), bflo(x.w), bfhi(x.w)};
            const int c = F.lane + 64 * jj;
#pragma unroll 2
            for (int e = 0; e < 8; ++e) { const LAS f32x4* wr = (const LAS f32x4*)(wf + (8 * c + e) * 16 + c * 4);
#pragma unroll
                for (int q = 0; q < 4; ++q) { const f32x4 w4 = wr[q]; acc[4 * q + 0] += f[e] * w4.x; acc[4 * q + 1] += f[e] * w4.y; acc[4 * q + 2] += f[e] * w4.z; acc[4 * q + 3] += f[e] * w4.w; } }
        }
        float mine = 0.f;
#pragma unroll
        for (int j = 0; j < 16; ++j) { const float s = wave_sum(acc[j]); if (F.lane == j) mine = s; }
        if (F.lane < 16) { const float z = mine + fbias[F.lane]; fzls[(size_t)m * 16 + F.lane] = fminf(z, 0.f) - log1pf(__expf(-fabsf(z))); }
    }
    __syncthreads();
}
__device__ __forceinline__ void fscan(Frame& F, const float* fzls, float* Fo) {
    LAS float* wt = (LAS float*)(F.lds);
    for (int u = blockIdx.x; u < BATCH * H; u += F.G) {
        const int b = u / H, h = u % H, t0 = F.tid * 8;
        float v[8];
#pragma unroll
        for (int e = 0; e < 8; ++e) v[e] = fzls[(size_t)(b * T + t0 + e) * 16 + h];
#pragma unroll
        for (int e = 1; e < 8; ++e) v[e] += v[e - 1];
        float incl = v[7];
#pragma unroll
        for (int o = 1; o < 64; o <<= 1) { const float n = __shfl_up(incl, o); if (F.lane >= o) incl += n; }
        if (F.lane == 63) wt[F.wave] = incl;
        __syncthreads();
        float base = incl - v[7];
        for (int w = 0; w < F.wave; ++w) base += wt[w];
#pragma unroll
        for (int e = 0; e < 8; ++e) Fo[(size_t)u * T + t0 + e] = -(v[e] + base) * fox::INVS;
        __syncthreads();
    }
}
__device__ __forceinline__ fox::BlockRef attn_ref(int L, int pass, const bf16* Q, const bf16* K, const bf16* V, bf16* O, const float* Fc) {
    const int bh = L >> 3, x = L & 7, qb = pass ? 15 - x : x, b = bh / H, h = bh % H;
    fox::BlockRef r; const size_t base = (size_t)b * T * D + h * HD;
    r.Q = (const fox::bf16*)Q + base + (size_t)qb * 256 * D; r.O = (fox::bf16*)O + base + (size_t)qb * 256 * D; r.K = (const fox::bf16*)K + base; r.V = (const fox::bf16*)V + base;
    r.F = Fc + (size_t)bh * T; r.P0 = qb * 256; return r;
}
__device__ __forceinline__ void attn_phase(Frame& F, char* lds, const bf16* Q, const bf16* K, const bf16* V, bf16* O, const float* Fc) {
    constexpr int total = BATCH * H * 8; const int stride = F.G;
    int L = F.vcu; if (L >= total) return;
    int pass = 0;
    fox::BlockRef cur = attn_ref(L, 0, Q, K, V, O, Fc);
    fox::Seam S;
    fox::causal_prime(cur, lds, S);
    for (;;) {
        const bool more_pass = pass == 0, more_item = L + stride < total, last = !more_pass && !more_item;
        int passn = pass + 1, Ln = L;
        if (!more_pass) { passn = 0; Ln = more_item ? L + stride : L; }
        const fox::BlockRef nxt = last ? cur : attn_ref(Ln, passn, Q, K, V, O, Fc);
        fox::causal_block(cur, nxt, lds, S);
        if (last) break;
        cur = nxt; pass = passn; L = Ln;
    }
}

constexpr int NPHASE = 29;
__host__ __device__ constexpr bool phase_live(int id) {
    if (id == 0) return true;
    const int L = (id - 1) / 7, s = (id - 1) % 7;
    if (s == 1) return L >= 2;
    if (s == 2) return L == 2;
    if (s == 6) return L < 3;
    return true;
}
struct Args { const float* in[15]; float* out; unsigned char* ws; int ph_lo, ph_hi; };
__global__ void __launch_bounds__(NWAVES * 64, 2) fwd_kernel(Args args) {
    extern __shared__ __attribute__((aligned(16))) unsigned char lds[];
    Frame F;
    F.lds = (LAS unsigned char*)lds;
    F.MISC = (volatile LAS unsigned*)(F.lds + MISC_OFF);
    phase_tid(F);
    F.G = gridDim.x; { const int bx = blockIdx.x; F.vcu = (F.G % 8 == 0) ? (bx % 8) * (F.G / 8) + bx / 8 : bx; }
    unsigned char* ws = args.ws;
    F.ctl = (gu32*)(ws + WS_CTL);
    for (int u = F.tid; u < (LDS_BYTES - LDSCTL_OFF) / 4; u += NWAVES * 64) ((LAS unsigned*)(F.lds + LDSCTL_OFF))[u] = 0u;
    __syncthreads();
#if ONE_LAUNCH
    XcdBarrier bar = xcd_barrier_post((unsigned*)(F.ctl + CW_BAR), F.MISC + 8);
#define GRID_BAR() xcd_barrier(bar)
#else
#define GRID_BAR() do {} while (0)
#endif
    const int lo = args.ph_lo, hi = args.ph_hi;
#define IN(k) (lo <= (k) && (k) < hi)
#define SEAM(k) do { if ((k) + 1 < hi) GRID_BAR(); } while (0)
    const float* const* in = args.in;
    bf16* XN = (bf16*)(ws + WS_XN); bf16* PROJ = (bf16*)(ws + WS_PROJ);
    float* FZ = (float*)(ws + WS_FZ); float* FC = (float*)(ws + WS_F);

    #ifndef NO_P0
    if (IN(0)) { phase_tid(F); p0_prologue(F, in, ws); SEAM(0); }
#endif

#pragma unroll 1
    for (int L = 0; L < 4; ++L) {
        const int pb = 1 + 7 * L; const bool isA = L < 2; const int j = L & 1;
        if (IN(pb + 0)) {
            const bf16* Bt = isA ? (const bf16*)(ws + WS_WINA) + (size_t)j * NPA * D : (L == 2 ? (const bf16*)(ws + WS_WKVQ) : (const bf16*)(ws + WS_WINB1));
            const int N = (L == 3) ? 2 * D : NPA;
            bf16* outp = (L == 3) ? PROJ + 2 * SLOT : PROJ;
            pg8::Gemm g{XN, Bt, M, N, D}; pg8::StaticOrder S; S.init(M, N, F.G, (int)blockIdx.x);
            pg8::EpiBf16<0> E{outp, D, nullptr, D, SLOT, 1.f};
#ifndef NO_G1
            pg8::gemm_phase<pg8::EpiBf16<0>, pg8::StaticOrder, true, true>(F.lds + RING_OFF, g, S, E);
#endif
            SEAM(pb + 0);
        }
        if (IN(pb + 1) && !isA) { phase_tid(F);
#ifndef NO_FZ
            if (L == 2) { fz_rows(F, XN, in[7], in[6], in[8], FZ); headnorm_rows(F, PROJ, in[9]); }
#endif
            headnorm_rows(F, PROJ + 2 * SLOT, in[12] + j * HD);
            SEAM(pb + 1);
        }
        if (IN(pb + 2) && L == 2) { phase_tid(F); fscan(F, FZ, FC); SEAM(pb + 2); }
        if (IN(pb + 3)) { phase_tid(F);
#ifndef NO_REC
            if (isA) recur_naive(F, PROJ, PROJ + SLOT, PROJ + 2 * SLOT, XN, in[3], L);
#endif
#ifndef NO_ATT
            if (!isA) attn_phase(F, (char*)lds + RING_OFF, PROJ + 2 * SLOT, PROJ, PROJ + SLOT, XN, FC);
#endif
            SEAM(pb + 3);
        }
        if (IN(pb + 4)) { phase_tid(F); gatenorm_rows(F, XN, PROJ + 3 * SLOT, (isA ? in[4] : in[13]) + j * D); SEAM(pb + 4); }
        if (IN(pb + 5)) {
            const bf16* Bt = (const bf16*)(ws + (isA ? WS_WOUTA : WS_WOUTB)) + (size_t)j * D * D;
            pg8::Gemm g{XN, Bt, M, D, D}; pg8::StaticOrder S; S.init(M, D, F.G, (int)blockIdx.x);
            pg8::EpiRes E{L == 0 ? in[0] : args.out, args.out, D};
#ifndef NO_G2
            pg8::gemm_phase<pg8::EpiRes, pg8::StaticOrder, true, true>(F.lds + RING_OFF, g, S, E);
#endif
            SEAM(pb + 5);
        }
        if (IN(pb + 6) && L < 3) { phase_tid(F); norm_rows(F, args.out, XN); SEAM(pb + 6); }
    }
#undef IN
#undef SEAM
}

extern "C" void kernel_launch(void* const* d_in, const int* in_sizes, int n_in, void* d_out, int out_size, void* d_ws, size_t ws_size, hipStream_t stream) {
    static int grid = 0;
    if (grid == 0) {
        if (n_in != 15 || in_sizes[0] != M * D || out_size != M * D || ws_size < WS_END) { fprintf(stderr, "kernel_launch: unexpected shapes (n_in %d, in0 %d, out %d, ws %zu)\n", n_in, n_in > 0 ? in_sizes[0] : -1, out_size, ws_size); grid = -1; return; }
        int dev = 0, cus = 0;
        if (hipGetDevice(&dev) != hipSuccess || hipDeviceGetAttribute(&cus, hipDeviceAttributeMultiprocessorCount, dev) != hipSuccess) { grid = -1; return; }
        if (hipFuncSetAttribute((const void*)fwd_kernel, hipFuncAttributeMaxDynamicSharedMemorySize, LDS_BYTES) != hipSuccess) { fprintf(stderr, "kernel_launch: hipFuncSetAttribute failed\n"); grid = -1; return; }
        int per_cu = 0;
        if (hipOccupancyMaxActiveBlocksPerMultiprocessor(&per_cu, (const void*)fwd_kernel, NWAVES * 64, LDS_BYTES) != hipSuccess || per_cu < 1) fprintf(stderr, "kernel_launch: occupancy query says %d\n", per_cu);
        (void)hipGetLastError();
        grid = cus;
    }
    if (grid < 0) return;
    (void)hipMemsetAsync((char*)d_ws + WS_CTL, 0, CTL_ZERO_BYTES, stream);
    Args a{};
    for (int i = 0; i < 15; ++i) a.in[i] = (const float*)d_in[i];
    a.out = (float*)d_out; a.ws = (unsigned char*)d_ws;
#if ONE_LAUNCH
    a.ph_lo = 0; a.ph_hi = NPHASE;
    hipLaunchKernelGGL(fwd_kernel, dim3(grid), dim3(NWAVES * 64), LDS_BYTES, stream, a);
#else
    for (int p = 0; p < NPHASE; ++p) { if (!phase_live(p)) continue; a.ph_lo = p; a.ph_hi = p + 1; hipLaunchKernelGGL(fwd_kernel, dim3(grid), dim3(NWAVES * 64), LDS_BYTES, stream, a); }
#endif
}
```

```cpp
#include <hip/hip_runtime.h>
#include <hip/hip_bf16.h>
#include <cstdio>
#include <cstdint>
#include <cmath>
namespace pg8 {
#define PG8_LAS __attribute__((address_space(3)))
typedef unsigned short bf16_t;
typedef short bf16x8 __attribute__((ext_vector_type(8)));
typedef float f32x4 __attribute__((ext_vector_type(4)));
typedef unsigned u32x4 __attribute__((ext_vector_type(4)));
constexpr int BM = 256, BK = 64, HALF = 128, HTB = HALF * BK * 2  , STAGE_BYTES = 8 * HTB, NXCD = 8, WGM = 8;

__host__ __device__ __forceinline__ int lds_byte(int r, int c) { const int st = (r >> 4) * 2 + (c >> 5), rr = r & 15, cc = c & 31, ob = rr * 64 + cc * 2; return st * 1024 + (ob ^ (((ob >> 9) & 1) << 5)); }
__host__ __device__ __forceinline__ void stage_rc(int b, int& R, int& C) { const int st = b / 1024, sb = b % 1024, swz = sb ^ (((sb >> 9) & 1) << 5); R = (st >> 1) * 16 + swz / 64; C = (st & 1) * 32 + (swz % 64) / 2; }
__host__ __device__ __forceinline__ int perm32(int rho) { const int n = rho >> 4, i = rho & 15; return 8 * (i >> 2) + 4 * n + (i & 3); }

struct Unit { int pm, pn; };
struct Gemm { const bf16_t* A; const bf16_t* Bt; int M, N, K; };

struct StaticOrder {
    int nM, nN, nwg, G, c;
    __host__ __device__ void init(int M, int N, int G_, int c_) { nM = M / BM; nN = N / BM; nwg = nM * nN; G = G_; c = c_; }
    __host__ __device__ bool next(int i, Unit& u) const {
        const long L = (long)i * G + c; if (L >= nwg) return false;
        int wgid = (int)L; { const int q = nwg / NXCD, r = nwg % NXCD, xcd = wgid % NXCD, off = wgid / NXCD; wgid = (xcd < r ? xcd * (q + 1) : r * (q + 1) + (xcd - r) * q) + off; }
        const int nig = WGM * nN, gid = wgid / nig, fm = gid * WGM, gsz = (nM - fm) < WGM ? (nM - fm) : WGM;
        u.pm = fm + ((wgid % nig) % gsz); u.pn = (wgid % nig) / gsz; return true;
    }
    __device__ __forceinline__ void a_ready(const Unit&) const {}
    __device__ __forceinline__ void done(const Unit&) const {}
};

__device__ __forceinline__ unsigned cvt_pk_bf16(float lo, float hi) { unsigned r; asm volatile("v_cvt_pk_bf16_f32 %0, %1, %2" : "=v"(r) : "v"(lo), "v"(hi)); return r; }
typedef float f32x2 __attribute__((ext_vector_type(2)));
__device__ __forceinline__ f32x2 gelu_pk(f32x2 v) {
    const f32x2 av = __builtin_elementwise_abs(v), d = av * 0.2316418882f + 1.0f;
    f32x2 t; t.x = __builtin_amdgcn_rcpf(d.x); t.y = __builtin_amdgcn_rcpf(d.y);
    f32x2 q = t * 0.5307027145f + (-0.7265760135f); q = q * t + 0.7107068705f; q = q * t + (-0.142248368f); q = q * t + 0.127414796f; q = q * t;
    const f32x2 s = (v * v) * (-0.72134752044f);
    f32x2 e; e.x = __builtin_amdgcn_exp2f(s.x); e.y = __builtin_amdgcn_exp2f(s.y);
    const f32x2 m = v * (q * e), r = v - m;
    f32x2 o; o.x = v.x < 0.f ? m.x : r.x; o.y = v.y < 0.f ? m.y : r.y; return o;
}

template <int ACT  > struct EpiBf16 {
    static constexpr bool PERM = true, AFTER_DRAIN = false; static_assert(ACT == 0 || ACT == 1, "EpiBf16: ACT is 0 (none) or 1 (gelu_pk)");
    bf16_t* O; int ldc; const float* bias; int split_cols; size_t split_stride; float scale0;
    __device__ __forceinline__ void operator()(const f32x4 (&acc)[2][2][4][2], const Unit& u, int wr, int wc, int fr, int fq) const {
        const int row0 = u.pm * BM + wr * 64 + fr; int colt = u.pn * BM; bf16_t* base = O;
        float sc = 1.f; if (split_cols) { const int t = colt / split_cols; base += (size_t)t * split_stride; colt -= t * split_cols; if (t == 0) sc = scale0; }
        const int col0 = colt + wc * 32 + 8 * fq, bcol0 = u.pn * BM + wc * 32 + 8 * fq;
        f32x4 bv[2][2];
#pragma unroll
        for (int bj = 0; bj < 2; ++bj)
#pragma unroll
            for (int n = 0; n < 2; ++n) bv[bj][n] = bias ? *(const f32x4*)(bias + bcol0 + bj * HALF + 4 * n) : (f32x4){0.f, 0.f, 0.f, 0.f};
#pragma unroll
        for (int ai = 0; ai < 2; ++ai)
#pragma unroll
            for (int m = 0; m < 4; ++m) { bf16_t* rowp = base + (size_t)(row0 + ai * HALF + m * 16) * ldc + col0;
#pragma unroll
                for (int bj = 0; bj < 2; ++bj) { f32x4 v0 = acc[ai][bj][m][0] + bv[bj][0], v1 = acc[ai][bj][m][1] + bv[bj][1];
                    if (ACT == 1) { f32x2 a = gelu_pk((f32x2){v0[0], v0[1]}), b = gelu_pk((f32x2){v0[2], v0[3]}), c = gelu_pk((f32x2){v1[0], v1[1]}), d = gelu_pk((f32x2){v1[2], v1[3]});
                        v0 = (f32x4){a.x, a.y, b.x, b.y}; v1 = (f32x4){c.x, c.y, d.x, d.y}; }
                    v0 = v0 * sc; v1 = v1 * sc; u32x4 w; w.x = cvt_pk_bf16(v0[0], v0[1]); w.y = cvt_pk_bf16(v0[2], v0[3]); w.z = cvt_pk_bf16(v1[0], v1[1]); w.w = cvt_pk_bf16(v1[2], v1[3]);
                    *(u32x4*)(rowp + bj * HALF) = w; } }
    }
};
struct EpiRes {
    static constexpr bool PERM = false, AFTER_DRAIN = false;
    const float* res; float* out; int ldc;
    __device__ __forceinline__ void operator()(const f32x4 (&acc)[2][2][4][2], const Unit& u, int wr, int wc, int fr, int fq) const {
        const int row0 = u.pm * BM + wr * 64 + fr, col0 = u.pn * BM + wc * 32 + 4 * fq;
#pragma unroll
        for (int ai = 0; ai < 2; ++ai)
#pragma unroll
            for (int m = 0; m < 4; ++m) { const size_t off = (size_t)(row0 + ai * HALF + m * 16) * ldc + col0;
                f32x4 r[2][2];
#pragma unroll
                for (int bj = 0; bj < 2; ++bj)
#pragma unroll
                    for (int n = 0; n < 2; ++n) r[bj][n] = *(const f32x4*)(res + off + bj * HALF + n * 16);
#pragma unroll
                for (int bj = 0; bj < 2; ++bj)
#pragma unroll
                    for (int n = 0; n < 2; ++n) *(f32x4*)(out + off + bj * HALF + n * 16) = r[bj][n] + acc[ai][bj][m][n]; }
    }
};
template <class Epi, class Sched, bool ALIGN_EPI = false, bool SP2 = false>
__device__ __forceinline__ void gemm_phase(PG8_LAS unsigned char* lds, const Gemm g, const Sched& S, const Epi& E) {
    int tid_ = threadIdx.x; asm volatile("" : "+v"(tid_));
    const int tid = tid_, wid = __builtin_amdgcn_readfirstlane(tid >> 6), lane = tid & 63, wr = wid >> 2, wc = wid & 3, fr = lane & 15, fq = lane >> 4;
    const int K = g.K, nt = K / BK;
    unsigned voffA[2], voffB[2];
#pragma unroll
    for (int i = 0; i < 2; ++i) { int R, C; stage_rc(tid * 16 + i * 8192, R, C); const int Rb = Epi::PERM ? ((R & ~31) + perm32(R & 31)) : R;
        voffA[i] = (unsigned)(R * K + C) * 2u; voffB[i] = (unsigned)(Rb * K + C) * 2u; }
    const size_t kstep = (size_t)(BK * 2);
    const size_t hstep = (size_t)HALF * K * 2;
    const size_t tstep = 2 * hstep;
    const unsigned ldsw = (unsigned)wid * 1024u;
    const int aoff = lds_byte(wr * 64 + fr, fq * 8), boff = lds_byte(wc * 32 + fr, fq * 8);
#define PG8_SA(b, h) (((b) * 2 + (h)) * HTB)
#define PG8_SB(b, h) ((4 + (b) * 2 + (h)) * HTB)
#define PG8_STAGE(bufoff, gbase, voff) do { _Pragma("unroll") for (int _i = 0; _i < 2; ++_i) \
        __builtin_amdgcn_global_load_lds((const unsigned*)((const char*)(gbase) + (voff)[_i]), (PG8_LAS unsigned*)(lds + (bufoff) + ldsw + _i * 8192), 16, 0, 0); } while (0)
#define PG8_LDA(dst, b, h) do { _Pragma("unroll") for (int m = 0; m < 4; ++m) _Pragma("unroll") for (int k = 0; k < 2; ++k) dst[m][k] = *(const PG8_LAS bf16x8*)(lds + PG8_SA(b, h) + aoff + m * 2048 + k * 1024); } while (0)
#define PG8_LDB(dst, b, h) do { _Pragma("unroll") for (int n = 0; n < 2; ++n) _Pragma("unroll") for (int k = 0; k < 2; ++k) dst[n][k] = *(const PG8_LAS bf16x8*)(lds + PG8_SB(b, h) + boff + n * 2048 + k * 1024); } while (0)
#define PG8_MMA(ai, bj, At, Bt) do { __builtin_amdgcn_s_setprio(1); _Pragma("unroll") for (int m = 0; m < 4; ++m) _Pragma("unroll") for (int n = 0; n < 2; ++n) _Pragma("unroll") for (int k = 0; k < 2; ++k) \
        acc[ai][bj][m][n] = __builtin_amdgcn_mfma_f32_16x16x32_bf16(Bt[n][k], At[m][k], acc[ai][bj][m][n], 0, 0, 0); __builtin_amdgcn_s_setprio(0); } while (0)
#define PG8_WAIT_V(n) asm volatile("s_waitcnt vmcnt(" #n ")" ::: "memory")
#define PG8_WAIT_L(n) asm volatile("s_waitcnt lgkmcnt(" #n ")" ::: "memory")
#define PG8_BAR __builtin_amdgcn_s_barrier()
#define PG8_SCHED __builtin_amdgcn_sched_barrier(0)
    Unit cur, nxt; int ui = 0;
    if (!S.next(0, cur)) return;
    f32x4 acc[2][2][4][2];
#pragma unroll
    for (int a = 0; a < 2; ++a)
#pragma unroll
        for (int b = 0; b < 2; ++b)
#pragma unroll
            for (int m = 0; m < 4; ++m)
#pragma unroll
                for (int n = 0; n < 2; ++n) acc[a][b][m][n] = (f32x4){0.f, 0.f, 0.f, 0.f};
    bf16x8 At[4][2], B0[2][2], B1[2][2];
    const char* cA = (const char*)g.A + (size_t)cur.pm * tstep; const char* cB = (const char*)g.Bt + (size_t)cur.pn * tstep;
    S.a_ready(cur);
    if constexpr (SP2) {
        PG8_STAGE(PG8_SB(0, 0), cB, voffB); PG8_STAGE(PG8_SB(0, 1), cB + hstep, voffB); PG8_STAGE(PG8_SA(0, 0), cA, voffA); PG8_STAGE(PG8_SA(0, 1), cA + hstep, voffA);
        if (wr == 1) PG8_BAR;
        PG8_WAIT_V(2); PG8_BAR;
        PG8_STAGE(PG8_SB(1, 0), cB + kstep, voffB); PG8_STAGE(PG8_SA(1, 0), cA + kstep, voffA); PG8_STAGE(PG8_SB(1, 1), cB + hstep + kstep, voffB);
        PG8_WAIT_V(6); PG8_BAR;
    } else {
        PG8_STAGE(PG8_SB(0, 0), cB, voffB); PG8_STAGE(PG8_SA(0, 0), cA, voffA); PG8_STAGE(PG8_SB(0, 1), cB + hstep, voffB); PG8_STAGE(PG8_SA(0, 1), cA + hstep, voffA);
        if (wr == 1) PG8_BAR;
        PG8_WAIT_V(4); PG8_BAR;
        PG8_STAGE(PG8_SB(1, 0), cB + kstep, voffB); PG8_STAGE(PG8_SA(1, 0), cA + kstep, voffA); PG8_STAGE(PG8_SB(1, 1), cB + hstep + kstep, voffB);
        PG8_WAIT_V(6); PG8_BAR;
    }
    for (;;) {
        const bool has_next = S.next(ui + 1, nxt);
        const char* nA = has_next ? (const char*)g.A + (size_t)nxt.pm * tstep : cA; const char* nB = has_next ? (const char*)g.Bt + (size_t)nxt.pn * tstep : cB;
        for (int t = 0; t < nt; t += 2) {
            const bool last = (t == nt - 2);
            const char* a1 = cA + (size_t)(t + 1) * kstep;
            const char* a2 = last ? nA : cA + (size_t)(t + 2) * kstep; const char* b2 = last ? nB : cB + (size_t)(t + 2) * kstep;
            const char* a3 = a2 + kstep; const char* b3 = b2 + kstep;
            if (last && has_next) S.a_ready(nxt);
            if constexpr (SP2) {
            PG8_LDB(B0, 0, 0); PG8_LDB(B1, 0, 1); PG8_SCHED; PG8_LDA(At, 0, 0); PG8_STAGE(PG8_SA(1, 1), a1 + hstep, voffA);
            PG8_WAIT_V(8); PG8_WAIT_L(0); PG8_BAR; PG8_MMA(0, 0, At, B0); PG8_MMA(0, 1, At, B1); PG8_BAR; PG8_SCHED;
            PG8_LDA(At, 0, 1); PG8_STAGE(PG8_SB(0, 0), b2, voffB); PG8_STAGE(PG8_SB(0, 1), b2 + hstep, voffB); PG8_STAGE(PG8_SA(0, 0), a2, voffA);
            PG8_WAIT_V(8); PG8_WAIT_L(0); PG8_BAR; PG8_MMA(1, 0, At, B0); PG8_MMA(1, 1, At, B1); PG8_BAR; PG8_SCHED;
            PG8_LDB(B0, 1, 0); PG8_LDB(B1, 1, 1); PG8_SCHED; PG8_LDA(At, 1, 0); PG8_STAGE(PG8_SA(0, 1), a2 + hstep, voffA);
            PG8_WAIT_V(8); PG8_WAIT_L(0); PG8_BAR; PG8_MMA(0, 0, At, B0); PG8_MMA(0, 1, At, B1); PG8_BAR; PG8_SCHED;
            PG8_LDA(At, 1, 1); PG8_STAGE(PG8_SB(1, 0), b3, voffB); PG8_STAGE(PG8_SB(1, 1), b3 + hstep, voffB); PG8_STAGE(PG8_SA(1, 0), a3, voffA);
            PG8_WAIT_V(8); PG8_WAIT_L(0); PG8_BAR; PG8_MMA(1, 0, At, B0); PG8_MMA(1, 1, At, B1); PG8_BAR; PG8_SCHED;
            } else {
            PG8_LDB(B0, 0, 0); PG8_SCHED; PG8_LDA(At, 0, 0); PG8_STAGE(PG8_SA(1, 1), a1 + hstep, voffA);
            PG8_WAIT_L(8); PG8_BAR; PG8_WAIT_L(0); PG8_MMA(0, 0, At, B0); PG8_BAR; PG8_SCHED;
            PG8_LDB(B1, 0, 1); PG8_STAGE(PG8_SB(0, 0), b2, voffB);
            PG8_BAR; PG8_WAIT_L(0); PG8_MMA(0, 1, At, B1); PG8_BAR;
            PG8_LDA(At, 0, 1); PG8_STAGE(PG8_SA(0, 0), a2, voffA);
            PG8_BAR; PG8_WAIT_L(0); PG8_MMA(1, 0, At, B0); PG8_BAR; PG8_SCHED;
            PG8_STAGE(PG8_SB(0, 1), b2 + hstep, voffB);
            PG8_WAIT_V(6); PG8_BAR; PG8_MMA(1, 1, At, B1); PG8_BAR;
            PG8_LDB(B0, 1, 0); PG8_SCHED; PG8_LDA(At, 1, 0); PG8_STAGE(PG8_SA(0, 1), a2 + hstep, voffA);
            PG8_WAIT_L(8); PG8_BAR; PG8_WAIT_L(0); PG8_MMA(0, 0, At, B0); PG8_BAR; PG8_SCHED;
            PG8_LDB(B1, 1, 1); PG8_STAGE(PG8_SB(1, 0), b3, voffB);
            PG8_BAR; PG8_WAIT_L(0); PG8_MMA(0, 1, At, B1); PG8_BAR;
            PG8_LDA(At, 1, 1); PG8_STAGE(PG8_SA(1, 0), a3, voffA);
            PG8_BAR; PG8_WAIT_L(0); PG8_MMA(1, 0, At, B0); PG8_BAR; PG8_SCHED;
            PG8_STAGE(PG8_SB(1, 1), b3 + hstep, voffB);
            PG8_WAIT_V(6); PG8_BAR; PG8_MMA(1, 1, At, B1); PG8_BAR;
            }
        }
        if constexpr (ALIGN_EPI) { if (wr == 0) PG8_BAR; }
        if constexpr (!Epi::AFTER_DRAIN) { E(acc, cur, wr, wc, fr, fq); S.done(cur); }
        if (!has_next) break;
#pragma unroll
        for (int a = 0; a < 2; ++a)
#pragma unroll
            for (int b = 0; b < 2; ++b)
#pragma unroll
                for (int m = 0; m < 4; ++m)
#pragma unroll
                    for (int n = 0; n < 2; ++n) acc[a][b][m][n] = (f32x4){0.f, 0.f, 0.f, 0.f};
        cur = nxt; cA = nA; cB = nB; ++ui;
        if constexpr (ALIGN_EPI) { if (wr == 1) PG8_BAR; }
    }
    PG8_WAIT_V(0);
    if constexpr (!ALIGN_EPI) { if (wr == 0) PG8_BAR; }
    PG8_BAR;
    if constexpr (Epi::AFTER_DRAIN) { E.fused(acc, cur, wr, wc, fr, fq, lds, wid, lane); S.done(cur); }
#undef PG8_SA
#undef PG8_SB
#undef PG8_STAGE
#undef PG8_LDA
#undef PG8_LDB
#undef PG8_MMA
#undef PG8_WAIT_V
#undef PG8_WAIT_L
#undef PG8_BAR
#undef PG8_SCHED
}
}
namespace fox {
constexpr int ALD = 2048;
constexpr int AD = 128;
constexpr float SCALE = 0.08838834764831845f;
constexpr float INVS = 11.313708498984761f;
constexpr float THR = 8.f;
constexpr int NW = 8, QBLK = 32, KVBLK = 64, QB = NW * QBLK;
constexpr int SHM_V = KVBLK * AD * 2, SHM_K = KVBLK * AD * 2;
constexpr int LDS_F = 2 * SHM_V + 2 * SHM_K + NW * 64 * 4;
constexpr int LDS_BYTES = LDS_F + 2 * 256;

using bf16 = __hip_bfloat16;
typedef short bf16x8 __attribute__((ext_vector_type(8)));
typedef short s16x4 __attribute__((ext_vector_type(4)));
typedef float f32x16 __attribute__((ext_vector_type(16)));
typedef float f32x4 __attribute__((ext_vector_type(4)));
typedef unsigned u32x4 __attribute__((ext_vector_type(4)));

#define KSWZ(row, colB) ((row) * 256 + ((colB) ^ (((row) & 7) << 4)))
#define SBAR() __builtin_amdgcn_sched_barrier(0)
__device__ __forceinline__ int v_st(int k, int c) { const int kk = (k & ~0xC) | ((k & 4) << 1) | ((k & 8) >> 1); return ((kk >> 3) * 4 + (c >> 5)) * 512 + ((kk & 7) * 32 + (c & 31)) * 2; }
__device__ __forceinline__ int v_rd_base(int lane) { return ((lane & 3) << 3) | (((lane >> 2) & 3) << 6) | (((lane >> 4) & 1) << 5) | (((lane >> 5) & 1) << 8); }
constexpr int v_rd_off(int d0, int ks, int half) { return d0 * 512 + ks * 4096 + half * 2048; }
__device__ __forceinline__ int crow(int r, int hi) { return (r & 3) + 8 * (r >> 2) + 4 * hi; }
__device__ __forceinline__ unsigned cvtpk(float lo, float hi) {
    unsigned r; asm volatile("v_cvt_pk_bf16_f32 %0, %1, %2" : "=v"(r) : "v"(lo), "v"(hi)); return r;
}
typedef __amdgpu_buffer_rsrc_t rsrc_t;
__device__ __forceinline__ rsrc_t mk_rsrc(const void* p) { return __builtin_amdgcn_make_buffer_rsrc((void*)p, (short)0, 0x7ffffff0, 0x00020000); }
__device__ __forceinline__ bf16x8 ldb8(rsrc_t r, int voff, int soff) { return __builtin_bit_cast(bf16x8, __builtin_amdgcn_raw_buffer_load_b128(r, voff, soff, 0)); }
__device__ __forceinline__ f32x4 ldf4(rsrc_t r, int voff, int soff) { return __builtin_bit_cast(f32x4, __builtin_amdgcn_raw_buffer_load_b128(r, voff, soff, 0)); }
__device__ __forceinline__ void mask_tile(f32x16& p0, f32x16& p1, int dq, unsigned W) {
    const float NEG = -__builtin_inff();
#pragma unroll
    for (int r = 0; r < 16; ++r) {
        const int c = (r & 3) + 8 * (r >> 2);
        if ((unsigned)(dq - c) >= W) p0[r] = NEG;
        if ((unsigned)(dq - c - 32) >= W) p1[r] = NEG;
    }
}
__device__ __forceinline__ void partialSM(f32x16& p0, f32x16& p1, float& m_reg, float& mn, float& alpha) {
    float pmax = p0[0]; for (int r = 1; r < 16; ++r) pmax = fmaxf(pmax, p0[r]); for (int r = 0; r < 16; ++r) pmax = fmaxf(pmax, p1[r]);
    { auto rr = __builtin_amdgcn_permlane32_swap(__float_as_uint(pmax), __float_as_uint(pmax), false, false);
      pmax = fmaxf(__uint_as_float(rr[0]), __uint_as_float(rr[1])); }
    constexpr float C2 = 1.4426950408889634f * SCALE;
    if (__builtin_expect(__all((pmax - m_reg) * SCALE <= THR), 1)) { mn = m_reg; alpha = 1.f; }
    else { mn = fmaxf(m_reg, pmax); alpha = __builtin_amdgcn_exp2f((m_reg - mn) * C2); m_reg = mn; }
    const float mnL = -mn * C2;
    for (int r = 0; r < 16; ++r) p0[r] = fmaf(p0[r], C2, mnL); for (int r = 0; r < 16; ++r) p1[r] = fmaf(p1[r], C2, mnL);
    for (int r = 0; r < 16; ++r) p0[r] = __builtin_amdgcn_exp2f(p0[r]);
}
__device__ __forceinline__ void finishSM(f32x16& p0, f32x16& p1, float alpha, float& l_reg, bf16x8& pa0, bf16x8& pa1, bf16x8& pa2, bf16x8& pa3) {
    for (int r = 0; r < 16; ++r) p1[r] = __builtin_amdgcn_exp2f(p1[r]);
    float ps = 0; for (int r = 0; r < 16; ++r) ps += p0[r]; for (int r = 0; r < 16; ++r) ps += p1[r];
    { auto rr = __builtin_amdgcn_permlane32_swap(__float_as_uint(ps), __float_as_uint(ps), false, false);
      ps = __uint_as_float(rr[0]) + __uint_as_float(rr[1]); }
    l_reg = l_reg * alpha + ps;
#define PK4(P, B_, OUT) do { unsigned a0 = cvtpk(P[B_+0], P[B_+1]), a1 = cvtpk(P[B_+2], P[B_+3]);                          \
        unsigned b0 = cvtpk(P[B_+4], P[B_+5]), b1 = cvtpk(P[B_+6], P[B_+7]);                                             \
        auto r0 = __builtin_amdgcn_permlane32_swap(a0, b0, false, false); auto r1 = __builtin_amdgcn_permlane32_swap(a1, b1, false, false); \
        u32x4 w = {r0[0], r1[0], r0[1], r1[1]}; OUT = *reinterpret_cast<bf16x8*>(&w); } while (0)
    PK4(p0, 0, pa0); PK4(p0, 8, pa1); PK4(p1, 0, pa2); PK4(p1, 8, pa3);
#undef PK4
}
template <int KB>
__device__ __forceinline__ void qkt(f32x16& p0, f32x16& p1, const char* K_lds, const char* F_lds, int r32, int hi, const bf16x8* qr) {
    { const f32x4* fk = reinterpret_cast<const f32x4*>(F_lds + KB * 256);
#pragma unroll
      for (int g = 0; g < 4; ++g) { const f32x4 a = fk[2 * g + hi], b = fk[8 + 2 * g + hi];
#pragma unroll
          for (int e = 0; e < 4; ++e) { p0[4 * g + e] = a[e]; p1[4 * g + e] = b[e]; } } }
    const char* kb[4];
#pragma unroll
    for (int dd = 0; dd < 4; ++dd) kb[dd] = K_lds + KB * SHM_K + KSWZ(r32, (dd * 16 + hi * 8) * 2);
#pragma unroll
    for (int d0 = 0; d0 < 8; ++d0) { const char* a = kb[d0 & 3] + (d0 >> 2) * 128;
        bf16x8 b0 = *reinterpret_cast<const bf16x8*>(a);
        bf16x8 b1 = *reinterpret_cast<const bf16x8*>(a + 32 * 256);
        p0 = __builtin_amdgcn_mfma_f32_32x32x16_bf16(b0, qr[d0], p0, 0, 0, 0);
        p1 = __builtin_amdgcn_mfma_f32_32x32x16_bf16(b1, qr[d0], p1, 0, 0, 0); }
}
template <int VB>
__device__ __forceinline__ void pv_tile(f32x16* o, int vb0, bf16x8 pa0, bf16x8 pa1, bf16x8 pa2, bf16x8 pa3) {
#define TRRD(dst, off) asm volatile("ds_read_b64_tr_b16 %0, %1 offset:%2" : "=&v"(dst) : "v"(vb0), "i"(off) : "memory")
#define PV_D0(d0) do { s16x4 l0, l1, l2, l3, h0, h1, h2, h3; constexpr int b_ = VB * SHM_V + v_rd_off(d0, 0, 0);     \
        TRRD(l0, b_); TRRD(h0, b_ + 2048); TRRD(l1, b_ + 4096); TRRD(h1, b_ + 6144); TRRD(l2, b_ + 8192); TRRD(h2, b_ + 10240); TRRD(l3, b_ + 12288); TRRD(h3, b_ + 14336); \
        asm volatile("s_waitcnt lgkmcnt(0)" ::: "memory"); SBAR();                 \
        o[d0] = __builtin_amdgcn_mfma_f32_32x32x16_bf16(pa0, (bf16x8){l0[0], l0[1], l0[2], l0[3], h0[0], h0[1], h0[2], h0[3]}, o[d0], 0, 0, 0);   \
        o[d0] = __builtin_amdgcn_mfma_f32_32x32x16_bf16(pa1, (bf16x8){l1[0], l1[1], l1[2], l1[3], h1[0], h1[1], h1[2], h1[3]}, o[d0], 0, 0, 0);   \
        o[d0] = __builtin_amdgcn_mfma_f32_32x32x16_bf16(pa2, (bf16x8){l2[0], l2[1], l2[2], l2[3], h2[0], h2[1], h2[2], h2[3]}, o[d0], 0, 0, 0);   \
        o[d0] = __builtin_amdgcn_mfma_f32_32x32x16_bf16(pa3, (bf16x8){l3[0], l3[1], l3[2], l3[3], h3[0], h3[1], h3[2], h3[3]}, o[d0], 0, 0, 0); } while (0)
    PV_D0(0); PV_D0(1); PV_D0(2); PV_D0(3);
#undef PV_D0
#undef TRRD
}

struct BlockRef { const bf16* Q; const bf16* K; const bf16* V; bf16* O; const float* F; int P0; };
struct Seam {
    bf16x8 qr[8];
    bf16x8 st_v0, st_v1, st_k0, st_k1; f32x4 st_f;
};
#define VMW() asm volatile("s_waitcnt vmcnt(0)" ::: "memory")
#define VMWN(n) asm volatile("s_waitcnt vmcnt(%0)" :: "i"(n) : "memory")
#define SLOAD_H(rK_, rV_, rF_, k0) do { const int so_ = (k0) * (ALD * 2);                                                    \
                         S.st_v0 = ldb8(rV_, kvoff, so_); S.st_v1 = ldb8(rV_, kvoff, so_ + 32 * ALD * 2);                    \
                         S.st_k0 = ldb8(rK_, kvoff, so_); S.st_k1 = ldb8(rK_, kvoff, so_ + 32 * ALD * 2);                    \
                         if (tid < 16) S.st_f = ldf4(rF_, tid * 16, (k0) * 4); } while (0)
#define QLOAD(rQ_) do { _Pragma("unroll") for (int d0 = 0; d0 < 8; ++d0) S.qr[d0] = ldb8(rQ_, qoff + d0 * 32, 0); } while (0)
#define SWRITE_HK(bf) do { *(bf16x8*)(K_lds + (bf) * SHM_K + kws) = S.st_k0; *(bf16x8*)(K_lds + (bf) * SHM_K + kws + 32 * 256) = S.st_k1; \
                           if (tid < 16) *(f32x4*)(F_lds + (bf) * 256 + tid * 16) = S.st_f; } while (0)
#define SWRITE_HV(bf) do { *(bf16x8*)(V_lds + (bf) * SHM_V + vst0) = S.st_v0; *(bf16x8*)(V_lds + (bf) * SHM_V + vst1) = S.st_v1; } while (0)
#define SWRITE_H(bf) do { SWRITE_HV(bf); SWRITE_HK(bf); } while (0)
__device__ __forceinline__ void causal_prime(const BlockRef& cur, char* lds, Seam& S) {
    int tid_ = threadIdx.x; asm volatile("" : "+v"(tid_));
    const int tid = tid_, wid = __builtin_amdgcn_readfirstlane(tid >> 6), lane = tid & 63, r32 = lane & 31, hi = lane >> 5;
    const int sr = tid >> 4, sc = (tid & 15) * 8, kws = KSWZ(sr, sc * 2); char* K_lds = lds + 2 * SHM_V; char* F_lds = lds + LDS_F;
    const int kvoff = (sr * ALD + sc) * 2, qoff = ((wid * QBLK + r32) * ALD + hi * 8) * 2;
    const rsrc_t rQ = mk_rsrc(cur.Q), rK = mk_rsrc(cur.K), rV = mk_rsrc(cur.V), rF = mk_rsrc(cur.F);
    QLOAD(rQ);
    SLOAD_H(rK, rV, rF, 0); VMW(); SWRITE_HK(0);
    __syncthreads();
}
__device__ __forceinline__ void causal_block(const BlockRef& cur, const BlockRef& nxt, char* lds, Seam& S) {
    int tid_ = threadIdx.x; asm volatile("" : "+v"(tid_));
    const int tid = tid_, wid = __builtin_amdgcn_readfirstlane(tid >> 6), lane = tid & 63, r32 = lane & 31, hi = lane >> 5;
    constexpr int W = 1 << 30;
    const int NT = (cur.P0 + QB - 1) / KVBLK + 1;
    const int qlo = cur.P0 + wid * QBLK, qm = qlo + r32 - 4 * hi;
    char* V_lds = lds; char* K_lds = lds + 2 * SHM_V; char* F_lds = lds + LDS_F;
    float* ws = (float*)(lds + 2 * SHM_V + 2 * SHM_K) + wid * 64; float* li_l = ws, * al_l = ws + 32;
    float m_reg = -1e30f, l_reg = 0; f32x16 o[4] = {};
    const int sr = tid >> 4, sc = (tid & 15) * 8, vst0 = v_st(sr, sc), vst1 = v_st(32 + sr, sc), kws = KSWZ(sr, sc * 2);
    const int vb0 = (int)(uintptr_t)V_lds + v_rd_base(lane);
    const int kvoff = (sr * ALD + sc) * 2, qoff = ((wid * QBLK + r32) * ALD + hi * 8) * 2;
    const rsrc_t Kh = mk_rsrc(cur.K), Vh = mk_rsrc(cur.V), Fh = mk_rsrc(cur.F);
#define RESC(a) do { if (__any((a) < 1.f)) { if (hi == 0) al_l[r32] = (a); asm volatile("s_waitcnt lgkmcnt(0)" ::: "memory");              \
                     for (int d_ = 0; d_ < 4; ++d_) for (int r = 0; r < 16; ++r) o[d_][r] *= al_l[crow(r, hi)]; } } while (0)
#define KBASE(t) ((t) * KVBLK)
#define MASKT(P0_, P1_, t) do { const int kb_ = KBASE(t); if (kb_ + KVBLK - 1 > qlo) mask_tile(P0_, P1_, qm - kb_, (unsigned)W); } while (0)
    constexpr int NQL = 8;
#define SEAM_K0() do { VMWN(NQL); SWRITE_HK(0); SBAR(); } while (0)
    f32x16 pA0, pA1, pB0, pB1; float mnA, mnB, alA, alB; bf16x8 pa0, pa1, pa2, pa3;
    SWRITE_HV(0); SBAR();
    if (NT > 1) { SLOAD_H(Kh, Vh, Fh, KBASE(1)); }
    SBAR(); qkt<0>(pA0, pA1, K_lds, F_lds, r32, hi, S.qr);
    MASKT(pA0, pA1, 0); partialSM(pA0, pA1, m_reg, mnA, alA);
    if (NT > 1) { VMW(); SWRITE_H(1); }
    __syncthreads();
#define HALF_STEP(PX0, PX1, mnX, alX, PY0, PY1, alY, t, KB, VB, SB) do {                                                      \
        SBAR(); qkt<KB>(PX0, PX1, K_lds, F_lds, r32, hi, S.qr);                                                               \
        finishSM(PY0, PY1, alY, l_reg, pa0, pa1, pa2, pa3); SBAR();                                                           \
        if ((t) + 1 < NT) { SLOAD_H(Kh, Vh, Fh, KBASE((t) + 1)); SBAR(); }                                                    \
        pv_tile<VB>(o, vb0, pa0, pa1, pa2, pa3); MASKT(PX0, PX1, (t)); partialSM(PX0, PX1, m_reg, mnX, alX);                  \
        __syncthreads();                                                                                                      \
        if ((t) + 1 < NT) { VMW(); SWRITE_H(SB); }                                                                            \
        RESC(alX); __syncthreads(); } while (0)
    for (int t = 1; t + 1 < NT; t += 2) {
        HALF_STEP(pB0, pB1, mnB, alB, pA0, pA1, alA, t, 1, 0, 0);
        HALF_STEP(pA0, pA1, mnA, alA, pB0, pB1, alB, t + 1, 0, 1, 1);
    }
    const bool even = (NT & 1) == 0;
    if (even) { SBAR(); qkt<1>(pB0, pB1, K_lds, F_lds, r32, hi, S.qr); SBAR(); }
    { const rsrc_t nK = mk_rsrc(nxt.K), nV = mk_rsrc(nxt.V), nF = mk_rsrc(nxt.F), nQ = mk_rsrc(nxt.Q);
      SLOAD_H(nK, nV, nF, 0); SBAR();
      QLOAD(nQ); }
    SBAR();
    finishSM(pA0, pA1, alA, l_reg, pa0, pa1, pa2, pa3); SBAR();
    pv_tile<0>(o, vb0, pa0, pa1, pa2, pa3);
    if (even) { MASKT(pB0, pB1, NT - 1); partialSM(pB0, pB1, m_reg, mnB, alB); __syncthreads(); RESC(alB);
        finishSM(pB0, pB1, alB, l_reg, pa0, pa1, pa2, pa3); SBAR(); pv_tile<1>(o, vb0, pa0, pa1, pa2, pa3); }
    SBAR(); SEAM_K0();
    if (hi == 0) li_l[r32] = l_reg; asm volatile("s_waitcnt lgkmcnt(0)" ::: "memory");
    float rli[16];
#pragma unroll
    for (int r = 0; r < 16; ++r) rli[r] = __builtin_amdgcn_rcpf(li_l[crow(r, hi)]);
    { const rsrc_t rO = mk_rsrc(cur.O); const int ooff = ((wid * QBLK + 4 * hi) * ALD + r32) * 2;
#pragma unroll
      for (int r = 0; r < 16; ++r) {
#pragma unroll
        for (int d0 = 0; d0 < 4; ++d0) { const float v = o[d0][r] * rli[r];
            const float vn = __shfl_xor(v, 1);
            if ((r32 & 1) == 0) __builtin_amdgcn_raw_buffer_store_b32(cvtpk(v, vn), rO, ooff + d0 * 64, ((r & 3) + 8 * (r >> 2)) * (ALD * 2), 0); } } }
    __syncthreads();
#undef RESC
#undef KBASE
#undef MASKT
#undef SEAM_K0
#undef HALF_STEP
}
#undef QLOAD
#undef VMW
#undef VMWN
#undef SLOAD_H
#undef SWRITE_HK
#undef SWRITE_HV
#undef SWRITE_H
#undef KSWZ
#undef SBAR
}
namespace rec {
typedef short bf16x8 __attribute__((ext_vector_type(8)));
typedef short bf16x4 __attribute__((ext_vector_type(4)));
typedef float f32x4 __attribute__((ext_vector_type(4)));
typedef float f32x2 __attribute__((ext_vector_type(2)));
typedef __bf16 bf16x2_t __attribute__((ext_vector_type(2)));
typedef unsigned u32x4 __attribute__((ext_vector_type(4)));
typedef unsigned u32x2 __attribute__((ext_vector_type(2)));
#define REC_LAS __attribute__((address_space(3)))
constexpr int RT = 4096, RD = 2048, NSEG = 4, SEG = RT / NSEG, NCH = SEG / 64;
constexpr int QP = 272, TP = 144;
constexpr int OFF_KB = 160 * QP, OFF_KHT = OFF_KB + 64 * QP, OFF_VT = OFF_KHT + 128 * TP, OFF_AM = OFF_VT + 128 * TP, OFF_TOT = OFF_AM + 64 * TP, OFF_DL = OFF_TOT + 8 * 128 * 4, LDS_END = OFF_DL + 512;
static_assert(LDS_END <= 131072, "recurrence LDS map");
__device__ __forceinline__ constexpr int qv_off(int j) { return (64 * j - 8 * j * (j - 1)) * QP; }
__device__ __forceinline__ unsigned cvt2(float lo, float hi) { f32x2 v = {lo, hi}; bf16x2_t b = __builtin_convertvector(v, bf16x2_t); return __builtin_bit_cast(unsigned, b); }
__device__ __forceinline__ float ex2(float x) { return __builtin_amdgcn_exp2f(x); }
__device__ __forceinline__ float lo_f(unsigned w) { return __uint_as_float(w << 16); }
__device__ __forceinline__ float hi_f(unsigned w) { return __uint_as_float(w & 0xffff0000u); }

template <bool OUT>
__device__ __forceinline__ void run(REC_LAS unsigned char* lds, int G, const unsigned short* Qp, const unsigned short* Zp, const unsigned short* Vp, unsigned short* Op,
                                    const float* lbl, int layer, float* Ug, float* Dg) {
    int tid_ = threadIdx.x; asm volatile("" : "+v"(tid_));
    const int tid = tid_, lane = tid & 63, wv = __builtin_amdgcn_readfirstlane(tid >> 6), fr = lane & 15, fg = lane >> 4;
    constexpr int NU = OUT ? 64 * NSEG : 64 * (NSEG - 1);
    if (OUT) { if (tid < 256) { const int blk = tid >> 7, r = (tid >> 3) & 15, c = tid & 7;
            *(REC_LAS unsigned*)(lds + OFF_AM + (32 * blk + r) * TP + (32 * blk + 16) * 2 + c * 4) = 0u; } }
    for (int u = blockIdx.x; u < NU; u += G) {
        const int bh = OUT ? u / NSEG : u / (NSEG - 1), seg = OUT ? u % NSEG : u % (NSEG - 1), b = bh >> 4, h = bh & 15;
        float lb[2];
#pragma unroll
        for (int dd = 0; dd < 2; ++dd) { const int c = h * 128 + 2 * lane + dd; lb[dd] = layer == 0 ? 0.f : 1.f / (1.f + __expf(lbl[c] - lbl[RD + c])); }
        f32x4 st[8];
#pragma unroll
        for (int kt = 0; kt < 8; ++kt) st[kt] = (f32x4){0.f, 0.f, 0.f, 0.f};
        if (OUT) {
            for (int s2 = 0; s2 < seg; ++s2) {
                const float* U = Ug + ((size_t)(bh * (NSEG - 1) + s2) << 14); const float* Dv = Dg + (bh * (NSEG - 1) + s2) * 128;
#pragma unroll
                for (int kt = 0; kt < 8; ++kt) { const f32x4 dvv = *(const f32x4*)(Dv + 16 * kt + 4 * fg);
#pragma unroll
                    for (int e = 0; e < 4; ++e) st[kt][e] = dvv[e] * st[kt][e] + U[(16 * kt + 4 * fg + e) * 128 + 16 * wv + fr]; }
            }
        }
        float dsum[2] = {0.f, 0.f};
        const size_t row0 = (size_t)(b * RT + seg * SEG) * RD + h * 128;
        unsigned nq[8], nz[8], nv[8];
#pragma unroll
        for (int e = 0; e < 8; ++e) { const size_t o = row0 + (size_t)(8 * wv + e) * RD + 2 * lane; nq[e] = *(const unsigned*)(Qp + o); nz[e] = *(const unsigned*)(Zp + o); nv[e] = *(const unsigned*)(Vp + o); }
#pragma unroll 1
        for (int c = 0; c < NCH; ++c) {
            unsigned cq[8], cz[8], cv[8];
#pragma unroll
            for (int e = 0; e < 8; ++e) { cq[e] = nq[e]; cz[e] = nz[e]; cv[e] = nv[e]; }
            if (c + 1 < NCH) {
#pragma unroll
                for (int e = 0; e < 8; ++e) { const size_t o = row0 + (size_t)(64 * (c + 1) + 8 * wv + e) * RD + 2 * lane; nq[e] = *(const unsigned*)(Qp + o); nz[e] = *(const unsigned*)(Zp + o); nv[e] = *(const unsigned*)(Vp + o); }
            }
            float kf[8][2], cs[8][2];
#pragma unroll
            for (int e = 0; e < 8; ++e) {
#pragma unroll
                for (int dd = 0; dd < 2; ++dd) {
                    const float z = dd ? hi_f(cz[e]) : lo_f(cz[e]);
                    const float ez = ex2(-1.4426950408889634f * fabsf(z)), inv = __builtin_amdgcn_rcpf(1.f + ez);
                    const float sig = z >= 0.f ? inv : ez * inv, nsig = z >= 0.f ? ez * inv : inv;
                    const float f = lb[dd] + (1.f - lb[dd]) * sig;
                    kf[e][dd] = (1.f - lb[dd]) * nsig;
                    const float gl = __builtin_amdgcn_logf(f);
                    cs[e][dd] = e ? cs[e - 1][dd] + gl : gl;
                }
            }
            *(REC_LAS f32x2*)(lds + OFF_TOT + (wv * 128 + 2 * lane) * 4) = (f32x2){cs[7][0], cs[7][1]};
            __syncthreads();
            float P[9][2];
            P[0][0] = 0.f; P[0][1] = 0.f;
#pragma unroll
            for (int w = 0; w < 8; ++w) { const f32x2 t2 = *(const REC_LAS f32x2*)(lds + OFF_TOT + (w * 128 + 2 * lane) * 4); P[w + 1][0] = P[w][0] + t2[0]; P[w + 1][1] = P[w][1] + t2[1]; }
            float base[2], bl[2], Bj[4][2];
#pragma unroll
            for (int dd = 0; dd < 2; ++dd) { bl[dd] = P[8][dd]; float bs = 0.f;
#pragma unroll
                for (int w = 0; w < 8; ++w) bs = (w == wv) ? P[w][dd] : bs;
                base[dd] = bs;
#pragma unroll
                for (int j = 0; j < 4; ++j) Bj[j][dd] = P[2 * j][dd]; }
            const int jb = wv >> 1;
            float Bown[2];
#pragma unroll
            for (int dd = 0; dd < 2; ++dd) { float bo = 0.f;
#pragma unroll
                for (int j = 0; j < 4; ++j) bo = (j == jb) ? Bj[j][dd] : bo;
                Bown[dd] = bo; }
            unsigned khw[2][4], vtw[2][4];
#pragma unroll
            for (int e = 0; e < 8; ++e) {
                const int t = 8 * wv + e;
                float bt[2], qv[2];
#pragma unroll
                for (int dd = 0; dd < 2; ++dd) { bt[dd] = base[dd] + cs[e][dd]; qv[dd] = dd ? hi_f(cq[e]) : lo_f(cq[e]); }
                if (OUT) {
#pragma unroll
                    for (int j = 0; j < 4; ++j) if (j <= jb)
                        *(REC_LAS unsigned*)(lds + qv_off(j) + (t - 16 * j) * QP + lane * 4) = cvt2(qv[0] * ex2(bt[0] - Bj[j][0]), qv[1] * ex2(bt[1] - Bj[j][1]));
                    *(REC_LAS unsigned*)(lds + OFF_KB + t * QP + lane * 4) = cvt2(kf[e][0] * ex2(fminf(Bown[0] - bt[0], 120.f)), kf[e][1] * ex2(fminf(Bown[1] - bt[1], 120.f)));
                }
                const float kh0 = kf[e][0] * ex2(bl[0] - bt[0]), kh1 = kf[e][1] * ex2(bl[1] - bt[1]);
                const float v0 = lo_f(cv[e]), v1 = hi_f(cv[e]);
                if (e & 1) { khw[0][e >> 1] = cvt2(__uint_as_float(khw[0][e >> 1]), kh0); khw[1][e >> 1] = cvt2(__uint_as_float(khw[1][e >> 1]), kh1);
                             vtw[0][e >> 1] = (vtw[0][e >> 1] >> 16) | (cv[e] << 16); vtw[1][e >> 1] = (vtw[1][e >> 1] >> 16) | (cv[e] & 0xffff0000u); (void)v0; (void)v1; }
                else { khw[0][e >> 1] = __float_as_uint(kh0); khw[1][e >> 1] = __float_as_uint(kh1); vtw[0][e >> 1] = cv[e] << 16; vtw[1][e >> 1] = cv[e] & 0xffff0000u; }
            }
#pragma unroll
            for (int dd = 0; dd < 2; ++dd) {
                *(REC_LAS u32x4*)(lds + OFF_KHT + (2 * lane + dd) * TP + wv * 16) = (u32x4){khw[dd][0], khw[dd][1], khw[dd][2], khw[dd][3]};
                *(REC_LAS u32x4*)(lds + OFF_VT + (2 * lane + dd) * TP + wv * 16) = (u32x4){vtw[dd][0], vtw[dd][1], vtw[dd][2], vtw[dd][3]};
            }
            if (wv == 0) *(REC_LAS f32x2*)(lds + OFF_DL + 2 * lane * 4) = (f32x2){ex2(bl[0]), ex2(bl[1])};
            dsum[0] += bl[0]; dsum[1] += bl[1];
            __syncthreads();
            if (OUT) {
#pragma unroll 1
                for (int blk = wv; blk < 10; blk += 8) {
                    const int i = blk < 1 ? 0 : blk < 3 ? 1 : blk < 6 ? 2 : 3, j = blk - (i * (i + 1)) / 2;
                    f32x4 a = {0.f, 0.f, 0.f, 0.f};
                    const REC_LAS unsigned char* ka = lds + OFF_KB + (16 * j + fr) * QP + fg * 16;
                    const REC_LAS unsigned char* qa = lds + qv_off(j) + (16 * (i - j) + fr) * QP + fg * 16;
#pragma unroll
                    for (int kk = 0; kk < 4; ++kk) a = __builtin_amdgcn_mfma_f32_16x16x32_bf16(*(const REC_LAS bf16x8*)(ka + kk * 64), *(const REC_LAS bf16x8*)(qa + kk * 64), a, 0, 0, 0);
                    if (i == j) {
#pragma unroll
                        for (int e = 0; e < 4; ++e) a[e] = (4 * fg + e <= fr) ? a[e] : 0.f; }
                    u32x2 w2; w2.x = cvt2(a[0], a[1]); w2.y = cvt2(a[2], a[3]);
                    *(REC_LAS u32x2*)(lds + OFF_AM + (16 * i + fr) * TP + (16 * j + 4 * fg) * 2) = w2;
                }
                __syncthreads();
            }
            bf16x8 vb[2];
#pragma unroll
            for (int kk = 0; kk < 2; ++kk) vb[kk] = *(const REC_LAS bf16x8*)(lds + OFF_VT + (16 * wv + fr) * TP + kk * 64 + fg * 16);
            if (OUT) {
                bf16x8 sb[4];
#pragma unroll
                for (int k4 = 0; k4 < 4; ++k4) { u32x4 w4; w4.x = cvt2(st[2 * k4][0], st[2 * k4][1]); w4.y = cvt2(st[2 * k4][2], st[2 * k4][3]); w4.z = cvt2(st[2 * k4 + 1][0], st[2 * k4 + 1][1]); w4.w = cvt2(st[2 * k4 + 1][2], st[2 * k4 + 1][3]);
                    sb[k4] = __builtin_bit_cast(bf16x8, w4); }
                unsigned short* orow = Op + row0 + (size_t)(64 * c + 4 * fg) * RD + 16 * wv + fr;
#pragma unroll
                for (int mt = 0; mt < 4; ++mt) {
                    f32x4 acc = {0.f, 0.f, 0.f, 0.f};
#pragma unroll
                    for (int kk = 0; kk < 2; ++kk) if (kk <= (mt >> 1))
                        acc = __builtin_amdgcn_mfma_f32_16x16x32_bf16(*(const REC_LAS bf16x8*)(lds + OFF_AM + (16 * mt + fr) * TP + kk * 64 + fg * 16), vb[kk], acc, 0, 0, 0);
#pragma unroll
                    for (int k4 = 0; k4 < 4; ++k4) {
                        const REC_LAS unsigned char* qa = lds + (16 * mt + fr) * QP + k4 * 64 + fg * 8;
                        const u32x2 lo2 = *(const REC_LAS u32x2*)qa, hi2 = *(const REC_LAS u32x2*)(qa + 32);
                        const u32x4 w4 = {lo2.x, lo2.y, hi2.x, hi2.y};
                        acc = __builtin_amdgcn_mfma_f32_16x16x32_bf16(__builtin_bit_cast(bf16x8, w4), sb[k4], acc, 0, 0, 0);
                    }
#pragma unroll
                    for (int e = 0; e < 4; ++e) orow[(size_t)(16 * mt + e) * RD] = (unsigned short)(cvt2(acc[e], 0.f) & 0xffffu);
                }
            }
#pragma unroll
            for (int kt = 0; kt < 8; ++kt) {
                const f32x4 dl4 = *(const REC_LAS f32x4*)(lds + OFF_DL + (16 * kt + 4 * fg) * 4);
                st[kt] = st[kt] * dl4;
#pragma unroll
                for (int kk = 0; kk < 2; ++kk)
                    st[kt] = __builtin_amdgcn_mfma_f32_16x16x32_bf16(*(const REC_LAS bf16x8*)(lds + OFF_KHT + (16 * kt + fr) * TP + kk * 64 + fg * 16), vb[kk], st[kt], 0, 0, 0);
            }
        }
        if (!OUT) {
            float* U = Ug + ((size_t)u << 14);
#pragma unroll
            for (int kt = 0; kt < 8; ++kt)
#pragma unroll
                for (int e = 0; e < 4; ++e) U[(16 * kt + 4 * fg + e) * 128 + 16 * wv + fr] = st[kt][e];
            if (wv == 0) *(f32x2*)(Dg + u * 128 + 2 * lane) = (f32x2){ex2(dsum[0]), ex2(dsum[1])};
        }
        __syncthreads();
    }
}
#undef REC_LAS
}
#define GAS __attribute__((address_space(1)))
#define LAS __attribute__((address_space(3)))
typedef unsigned short bf16;
typedef unsigned v4u __attribute__((ext_vector_type(4)));
typedef float f32x4 __attribute__((ext_vector_type(4)));
typedef short bf16x8 __attribute__((ext_vector_type(8)));
typedef GAS unsigned gu32;
typedef GAS unsigned long long gu64;
#define RLX_AGENT __ATOMIC_RELAXED, __HIP_MEMORY_SCOPE_AGENT
#define LDS_WAIT() asm volatile("s_waitcnt lgkmcnt(0)" ::: "memory")
#define VM_WAIT() asm volatile("s_waitcnt vmcnt(0)" ::: "memory")
__device__ __forceinline__ unsigned long long rt() { return __builtin_amdgcn_s_memrealtime(); }
__device__ __forceinline__ unsigned f2bf(float f) { unsigned u = __builtin_bit_cast(unsigned, f); return (u + 0x7fffu + ((u >> 16) & 1u)) >> 16; }
__device__ __forceinline__ unsigned pk2(float lo, float hi) { return f2bf(lo) | (f2bf(hi) << 16); }
#define XB_TMO      128
#define XB_XCNT(j)  (256  + 64 * (j))
#define XB_XSUB(j)  (1280 + 64 * (j))
#define XB_XGEN(j)  (2304 + 64 * (j))
#define XB_TOP      3328
#define XB_TOPGEN   3392
#define XCD_BAR_WORDS 3456
#define XB_SPIN_CAP (1u << 18)

__device__ __forceinline__ unsigned xb_ld(unsigned* p)              { return __hip_atomic_load(p, __ATOMIC_RELAXED, __HIP_MEMORY_SCOPE_AGENT); }
__device__ __forceinline__ unsigned xb_add(unsigned* p, unsigned v) { return __hip_atomic_fetch_add(p, v, __ATOMIC_RELAXED, __HIP_MEMORY_SCOPE_AGENT); }
__device__ __forceinline__ unsigned xb_xcc_id() { return (unsigned)__builtin_amdgcn_s_getreg((3 << 11) | 20) & 0xFu; }
#define XB_SPIN(cond, bar) do { unsigned _sp = 0; while (cond) { __builtin_amdgcn_s_sleep(1); \
    if ((++_sp & 255u) == 0u) { if (xb_ld(&(bar)[XB_TMO])) break; if (_sp > XB_SPIN_CAP) { atomicAdd(&(bar)[XB_TMO], 1u); break; } } } } while (0)

struct XcdBarrier {
    unsigned* bar; unsigned x;
    volatile LAS unsigned* st;
};

__device__ __forceinline__ XcdBarrier xcd_barrier_post(unsigned* bar, volatile LAS unsigned* st) {
    XcdBarrier b; b.bar = bar; b.x = xb_xcc_id(); b.st = st;
    if (threadIdx.x == 0) (void)xb_add(&bar[XB_XCNT(b.x)], 1u);
    return b;
}
__device__ __forceinline__ void xcd_barrier_complete(unsigned* bar, unsigned x, unsigned& nloc, unsigned& nx) {
    const unsigned G = gridDim.x * gridDim.y * gridDim.z;
    unsigned sum, cnt, mine, sp = 0u;
    for (;;) {
        sum = 0u; cnt = 0u; mine = 0u;
#pragma unroll
        for (unsigned j = 0; j < 16; ++j) { const unsigned c = xb_ld(&bar[XB_XCNT(j)]); sum += c; cnt += (c > 0u) ? 1u : 0u; mine = (j == x) ? c : mine; }
        if (sum == G) break;
        __builtin_amdgcn_s_sleep(1);
        if ((++sp & 255u) == 0u) { if (xb_ld(&bar[XB_TMO])) break; if (sp > XB_SPIN_CAP) { atomicAdd(&bar[XB_TMO], 1u); break; } }
    }
    nloc = mine > 0u ? mine : 1u; nx = cnt > 0u ? cnt : 1u;
}

__device__ __forceinline__ void xcd_barrier(const XcdBarrier& b) {
    asm volatile("s_waitcnt vmcnt(0)" ::: "memory");
    __syncthreads();
    if (threadIdx.x == 0) {
        unsigned* bar = b.bar;
        __builtin_amdgcn_s_waitcnt(0);
        unsigned nloc = b.st[0], nx = b.st[1];
        if (nloc == 0u) { xcd_barrier_complete(bar, b.x, nloc, nx); b.st[0] = nloc; b.st[1] = nx; }
        const unsigned old = xb_add(&bar[XB_XSUB(b.x)], 1u);
        const unsigned gen = old / nloc;
        if (old + 1u == (gen + 1u) * nloc) {
            __builtin_amdgcn_fence(__ATOMIC_RELEASE, "agent");
            asm volatile("s_waitcnt vmcnt(0)" ::: "memory");
            const unsigned og = xb_add(&bar[XB_TOP], 1u);
            const unsigned tg = og / nx;
            if (og + 1u == (tg + 1u) * nx) xb_add(&bar[XB_TOPGEN], 1u);
            else XB_SPIN(xb_ld(&bar[XB_TOPGEN]) == tg, bar);
            __builtin_amdgcn_fence(__ATOMIC_ACQUIRE, "agent");
            xb_add(&bar[XB_XGEN(b.x)], 1u);
            asm volatile("s_waitcnt vmcnt(0)" ::: "memory");
        } else {
            XB_SPIN(xb_ld(&bar[XB_XGEN(b.x)]) == gen, bar);
            __builtin_amdgcn_fence(__ATOMIC_ACQUIRE, "agent");
            asm volatile("s_waitcnt vmcnt(0)" ::: "memory");
        }
    }
    __syncthreads();
}
constexpr int NWAVES = 8;
#ifndef ONE_LAUNCH
#define ONE_LAUNCH 1
#endif
constexpr int BATCH = 4, T = 4096, D = 2048, H = 16, HD = 128;
constexpr int M = BATCH * T;
constexpr int NPA = 8192;
constexpr float EPS = 1e-6f;
constexpr size_t MiB = 1u << 20;
constexpr size_t WS_CTL = 0, CTL_ZERO_BYTES = 1 * MiB;
constexpr size_t WS_WINA = 2 * MiB;
constexpr size_t WS_WOUTA = 66 * MiB;
constexpr size_t WS_WKVQ = 82 * MiB;
constexpr size_t WS_WINB1 = 114 * MiB;
constexpr size_t WS_WOUTB = 130 * MiB;
constexpr size_t WS_XN = 146 * MiB;
constexpr size_t WS_PROJ = 210 * MiB;
constexpr size_t WS_FZ = 466 * MiB;
constexpr size_t WS_F = 467 * MiB;
constexpr size_t WS_U = 468 * MiB;
constexpr size_t WS_DG = 480 * MiB;
constexpr size_t WS_END = 481 * MiB;
constexpr size_t SLOT = (size_t)M * D;
constexpr int CW_TMO = 0, CW_CODE = 1;
constexpr int CW_BAR = 4096;
constexpr int RING_OFF = 0, RING_BYTES = 131072;
constexpr int SCRATCH_BYTES = 139264;
constexpr int LDSCTL_OFF = SCRATCH_BYTES, MISC_OFF = LDSCTL_OFF + 320;
constexpr int LDS_BYTES = 147456;
static_assert(MISC_OFF + 128 <= LDS_BYTES, "LDS map");

struct Frame {
    LAS unsigned char* lds;
    volatile LAS unsigned* MISC;
    gu32* ctl;
    int tid, lane, wave;
    int vcu, G;
};
__device__ __forceinline__ void phase_tid(Frame& F) { int t = threadIdx.x; asm volatile("" : "+v"(t)); F.tid = t; F.lane = t & 63; F.wave = __builtin_amdgcn_readfirstlane(t >> 6); }

__device__ __forceinline__ float wave_sum(float v) {
#pragma unroll
    for (int o = 1; o < 64; o <<= 1) v += __shfl_xor(v, o);
    return v;
}
__device__ __forceinline__ float bf2f(unsigned short b) { return __uint_as_float((unsigned)b << 16); }
__device__ __forceinline__ float bflo(unsigned w) { return __uint_as_float(w << 16); }
__device__ __forceinline__ float bfhi(unsigned w) { return __uint_as_float(w & 0xffff0000u); }

__device__ __forceinline__ void p0_transpose_item(const float* W, int ldw, int ncols, const float* nw, bf16* WT, LAS float* scr, int item, int lane) {
    const int nblk = ncols / 32, kb = item / nblk, nb = item % nblk, k0 = 64 * kb, n0 = 32 * nb;
#pragma unroll 8
    for (int i = 0; i < 32; ++i) { const int kk = 2 * i + (lane >> 5); const float s = nw ? nw[k0 + kk] : 1.f; scr[kk * 33 + (lane & 31)] = W[(size_t)(k0 + kk) * ldw + n0 + (lane & 31)] * s; }
    LDS_WAIT(); asm volatile("" ::: "memory");
    const int c = lane & 7;
#pragma unroll
    for (int j = 0; j < 4; ++j) { const int n = (lane >> 3) + 8 * j; const LAS float* s = scr + (8 * c) * 33 + n;
        v4u o; o.x = pk2(s[0 * 33], s[1 * 33]); o.y = pk2(s[2 * 33], s[3 * 33]); o.z = pk2(s[4 * 33], s[5 * 33]); o.w = pk2(s[6 * 33], s[7 * 33]);
        *(GAS v4u*)(WT + (size_t)(n0 + n) * D + k0 + 8 * c) = o; }
    LDS_WAIT(); asm volatile("" ::: "memory");
}
__device__ __forceinline__ void norm_rows(Frame& F, const float* xin, bf16* xn) {
    const int gw = F.vcu * NWAVES + F.wave, NGW = F.G * NWAVES;
    for (int m = gw; m < M; m += NGW) {
        const GAS f32x4* xr = (const GAS f32x4*)(xin + (size_t)m * D) + F.lane;
        f32x4 v[8]; float s = 0.f;
#pragma unroll
        for (int j = 0; j < 8; ++j) { v[j] = xr[64 * j]; s += (v[j].x * v[j].x + v[j].y * v[j].y) + (v[j].z * v[j].z + v[j].w * v[j].w); }
        const float r = 1.0f / sqrtf(wave_sum(s) * (1.f / D) + EPS);
        GAS unsigned long long* o8 = (GAS unsigned long long*)(xn + (size_t)m * D) + F.lane;
#pragma unroll
        for (int j = 0; j < 8; ++j) o8[64 * j] = (unsigned long long)pk2(v[j].x * r, v[j].y * r) | ((unsigned long long)pk2(v[j].z * r, v[j].w * r) << 32);
    }
}
__device__ __forceinline__ void p0_prologue(Frame& F, const float* const* in, unsigned char* ws) {
    LAS float* scr = (LAS float*)(F.lds + RING_OFF + F.wave * 16384);
    const int gw = F.vcu * NWAVES + F.wave, NGW = F.G * NWAVES;
    constexpr int I_INA = 32 * 256, I_SQ = 32 * 64, I_4K = 32 * 128;
    constexpr int NITEMS = 2 * I_INA + 2 * I_SQ + 3 * I_4K + 2 * I_SQ;
    for (int it = gw; it < NITEMS; it += NGW) {
        int r = it;
        if (r < 2 * I_INA) { const int l = r / I_INA; r -= l * I_INA; p0_transpose_item(in[2] + (size_t)l * D * NPA, NPA, NPA, in[1] + l * D, (bf16*)(ws + WS_WINA) + (size_t)l * NPA * D, scr, r, F.lane); continue; } r -= 2 * I_INA;
        if (r < 2 * I_SQ) { const int l = r / I_SQ; r -= l * I_SQ; p0_transpose_item(in[5] + (size_t)l * D * D, D, D, nullptr, (bf16*)(ws + WS_WOUTA) + (size_t)l * D * D, scr, r, F.lane); continue; } r -= 2 * I_SQ;
        if (r < I_4K) { p0_transpose_item(in[7], 2 * D + H, 2 * D, in[6], (bf16*)(ws + WS_WKVQ), scr, r, F.lane); continue; } r -= I_4K;
        if (r < I_4K) { p0_transpose_item(in[11], 2 * D, 2 * D, in[10], (bf16*)(ws + WS_WKVQ) + (size_t)2 * D * D, scr, r, F.lane); continue; } r -= I_4K;
        if (r < I_4K) { p0_transpose_item(in[11] + (size_t)D * 2 * D, 2 * D, 2 * D, in[10] + D, (bf16*)(ws + WS_WINB1), scr, r, F.lane); continue; } r -= I_4K;
        { const int l = r / I_SQ; r -= l * I_SQ; p0_transpose_item(in[14] + (size_t)l * D * D, D, D, nullptr, (bf16*)(ws + WS_WOUTB) + (size_t)l * D * D, scr, r, F.lane); }
    }
    norm_rows(F, in[0], (bf16*)(ws + WS_XN));
}
__device__ __forceinline__ float sum16(float v) { v += __shfl_xor(v, 1); v += __shfl_xor(v, 2); v += __shfl_xor(v, 4); v += __shfl_xor(v, 8); return v; }
__device__ __forceinline__ void headnorm_rows(Frame& F, bf16* X, const float* w) {
    const int gw = F.vcu * NWAVES + F.wave, NGW = F.G * NWAVES;
    for (int m = gw; m < M; m += NGW) {
        GAS v4u* xr = (GAS v4u*)(X + (size_t)m * D) + F.lane;
#pragma unroll
        for (int j = 0; j < 4; ++j) {
            const v4u x = xr[64 * j]; float f[8] = {bflo(x.x), bfhi(x.x), bflo(x.y), bfhi(x.y), bflo(x.z), bfhi(x.z), bflo(x.w), bfhi(x.w)};
            float s = 0.f;
#pragma unroll
            for (int e = 0; e < 8; ++e) s += f[e] * f[e];
            const float r = 1.0f / sqrtf(sum16(s) * (1.f / HD) + EPS);
            const int d0 = (8 * F.lane) & 127;
            const f32x4 w0 = *(const f32x4*)(w + d0), w1 = *(const f32x4*)(w + d0 + 4);
            v4u o; o.x = pk2(f[0] * r * w0.x, f[1] * r * w0.y); o.y = pk2(f[2] * r * w0.z, f[3] * r * w0.w); o.z = pk2(f[4] * r * w1.x, f[5] * r * w1.y); o.w = pk2(f[6] * r * w1.z, f[7] * r * w1.w);
            xr[64 * j] = o;
        }
    }
}
__device__ __forceinline__ float silu_f(float g) { return g / (1.f + __expf(-g)); }
__device__ __forceinline__ void gatenorm_rows(Frame& F, bf16* O, const bf16* G, const float* w) {
    const int gw = F.vcu * NWAVES + F.wave, NGW = F.G * NWAVES;
    for (int m = gw; m < M; m += NGW) {
        GAS v4u* xr = (GAS v4u*)(O + (size_t)m * D) + F.lane; const GAS v4u* gr = (const GAS v4u*)(G + (size_t)m * D) + F.lane;
#pragma unroll
        for (int j = 0; j < 4; ++j) {
            const v4u x = xr[64 * j], g = gr[64 * j];
            float f[8] = {bflo(x.x), bfhi(x.x), bflo(x.y), bfhi(x.y), bflo(x.z), bfhi(x.z), bflo(x.w), bfhi(x.w)};
            const float q[8] = {bflo(g.x), bfhi(g.x), bflo(g.y), bfhi(g.y), bflo(g.z), bfhi(g.z), bflo(g.w), bfhi(g.w)};
            float s = 0.f;
#pragma unroll
            for (int e = 0; e < 8; ++e) s += f[e] * f[e];
            const float r = 1.0f / sqrtf(sum16(s) * (1.f / HD) + EPS);
            const int c0 = 8 * (F.lane + 64 * j);
            const f32x4 w0 = *(const f32x4*)(w + c0), w1 = *(const f32x4*)(w + c0 + 4);
            const float ww[8] = {w0.x, w0.y, w0.z, w0.w, w1.x, w1.y, w1.z, w1.w};
#pragma unroll
            for (int e = 0; e < 8; ++e) f[e] = f[e] * r * ww[e] * silu_f(q[e]);
            v4u o; o.x = pk2(f[0], f[1]); o.y = pk2(f[2], f[3]); o.z = pk2(f[4], f[5]); o.w = pk2(f[6], f[7]);
            xr[64 * j] = o;
        }
    }
}
__device__ __forceinline__ void fz_rows(Frame& F, const bf16* xn, const float* kvw, const float* kvnw, const float* fbias, float* fzls) {
    LAS float* wf = (LAS float*)(F.lds);
    for (int idx = F.tid; idx < D * 16; idx += NWAVES * 64) { const int k = idx >> 4, j = idx & 15; wf[k * 16 + (k >> 3) * 4 + j] = kvw[(size_t)k * (2 * D + H) + 2 * D + j] * kvnw[k]; }
    __syncthreads();
    const int gw = F.vcu * NWAVES + F.wave, NGW = F.G * NWAVES;
    for (int m = gw; m < M; m += NGW) {
        const GAS v4u* xr = (const GAS v4u*)(xn + (size_t)m * D) + F.lane;
        float acc[16];
#pragma unroll
        for (int j = 0; j < 16; ++j) acc[j] = 0.f;
#pragma unroll 1
        for (int jj = 0; jj < 4; ++jj) {
            const v4u x = xr[64 * jj]; const float f[8] = {bflo(x.x), bfhi(x.x), bflo(x.y), bfhi(x.y), bflo(x.z), bfhi(x.z), bflo(x.w), bfhi(x.w)};
            const int c = F.lane + 64 * jj;
#pragma unroll 2
            for (int e = 0; e < 8; ++e) { const LAS f32x4* wr = (const LAS f32x4*)(wf + (8 * c + e) * 16 + c * 4);
#pragma unroll
                for (int q = 0; q < 4; ++q) { const f32x4 w4 = wr[q]; acc[4 * q + 0] += f[e] * w4.x; acc[4 * q + 1] += f[e] * w4.y; acc[4 * q + 2] += f[e] * w4.z; acc[4 * q + 3] += f[e] * w4.w; } }
        }
        float mine = 0.f;
#pragma unroll
        for (int j = 0; j < 16; ++j) { const float s = wave_sum(acc[j]); if (F.lane == j) mine = s; }
        if (F.lane < 16) { const float z = mine + fbias[F.lane]; fzls[(size_t)m * 16 + F.lane] = fminf(z, 0.f) - log1pf(__expf(-fabsf(z))); }
    }
    __syncthreads();
}
__device__ __forceinline__ void fscan(Frame& F, const float* fzls, float* Fo) {
    LAS float* wt = (LAS float*)(F.lds);
    for (int u = blockIdx.x; u < BATCH * H; u += F.G) {
        const int b = u / H, h = u % H, t0 = F.tid * 8;
        float v[8];
#pragma unroll
        for (int e = 0; e < 8; ++e) v[e] = fzls[(size_t)(b * T + t0 + e) * 16 + h];
#pragma unroll
        for (int e = 1; e < 8; ++e) v[e] += v[e - 1];
        float incl = v[7];
#pragma unroll
        for (int o = 1; o < 64; o <<= 1) { const float n = __shfl_up(incl, o); if (F.lane >= o) incl += n; }
        if (F.lane == 63) wt[F.wave] = incl;
        __syncthreads();
        float base = incl - v[7];
        for (int w = 0; w < F.wave; ++w) base += wt[w];
#pragma unroll
        for (int e = 0; e < 8; ++e) Fo[(size_t)u * T + t0 + e] = -(v[e] + base) * fox::INVS;
        __syncthreads();
    }
}
__device__ __forceinline__ fox::BlockRef attn_ref(int L, int pass, const bf16* Q, const bf16* K, const bf16* V, bf16* O, const float* Fc) {
    const int bh = L >> 3, x = L & 7, qb = pass ? 15 - x : x, b = bh / H, h = bh % H;
    fox::BlockRef r; const size_t base = (size_t)b * T * D + h * HD;
    r.Q = (const fox::bf16*)Q + base + (size_t)qb * 256 * D; r.O = (fox::bf16*)O + base + (size_t)qb * 256 * D; r.K = (const fox::bf16*)K + base; r.V = (const fox::bf16*)V + base;
    r.F = Fc + (size_t)bh * T; r.P0 = qb * 256; return r;
}
__device__ __forceinline__ void attn_phase(Frame& F, char* lds, const bf16* Q, const bf16* K, const bf16* V, bf16* O, const float* Fc) {
    constexpr int total = BATCH * H * 8; const int stride = F.G;
    int L = F.vcu; if (L >= total) return;
    int pass = 0;
    fox::BlockRef cur = attn_ref(L, 0, Q, K, V, O, Fc);
    fox::Seam S;
    fox::causal_prime(cur, lds, S);
    for (;;) {
        const bool more_pass = pass == 0, more_item = L + stride < total, last = !more_pass && !more_item;
        int passn = pass + 1, Ln = L;
        if (!more_pass) { passn = 0; Ln = more_item ? L + stride : L; }
        const fox::BlockRef nxt = last ? cur : attn_ref(Ln, passn, Q, K, V, O, Fc);
        fox::causal_block(cur, nxt, lds, S);
        if (last) break;
        cur = nxt; pass = passn; L = Ln;
    }
}

constexpr int NPHASE = 29;
__host__ __device__ constexpr bool phase_live(int id) {
    if (id == 0) return true;
    const int L = (id - 1) / 7, s = (id - 1) % 7;
    if (s == 1) return L >= 2;
    if (s == 2) return L <= 2;
    if (s == 6) return L < 3;
    return true;
}
struct Args { const float* in[15]; float* out; unsigned char* ws; int ph_lo, ph_hi; };
__global__ void __launch_bounds__(NWAVES * 64, 2) fwd_kernel(Args args) {
    extern __shared__ __attribute__((aligned(16))) unsigned char lds[];
    Frame F;
    F.lds = (LAS unsigned char*)lds;
    F.MISC = (volatile LAS unsigned*)(F.lds + MISC_OFF);
    phase_tid(F);
    F.G = gridDim.x; { const int bx = blockIdx.x; F.vcu = (F.G % 8 == 0) ? (bx % 8) * (F.G / 8) + bx / 8 : bx; }
    unsigned char* ws = args.ws;
    F.ctl = (gu32*)(ws + WS_CTL);
    for (int u = F.tid; u < (LDS_BYTES - LDSCTL_OFF) / 4; u += NWAVES * 64) ((LAS unsigned*)(F.lds + LDSCTL_OFF))[u] = 0u;
    __syncthreads();
#if ONE_LAUNCH
    XcdBarrier bar = xcd_barrier_post((unsigned*)(F.ctl + CW_BAR), F.MISC + 8);
#define GRID_BAR() xcd_barrier(bar)
#else
#define GRID_BAR() do {} while (0)
#endif
    const int lo = args.ph_lo, hi = args.ph_hi;
#define IN(k) (lo <= (k) && (k) < hi)
#define SEAM(k) do { if ((k) + 1 < hi) GRID_BAR(); } while (0)
    const float* const* in = args.in;
    bf16* XN = (bf16*)(ws + WS_XN); bf16* PROJ = (bf16*)(ws + WS_PROJ);
    float* FZ = (float*)(ws + WS_FZ); float* FC = (float*)(ws + WS_F);

    #ifndef NO_P0
    if (IN(0)) { phase_tid(F); p0_prologue(F, in, ws); SEAM(0); }
#endif

#pragma unroll 1
    for (int L = 0; L < 4; ++L) {
        const int pb = 1 + 7 * L; const bool isA = L < 2; const int j = L & 1;
        if (IN(pb + 0)) {
            const bf16* Bt = isA ? (const bf16*)(ws + WS_WINA) + (size_t)j * NPA * D : (L == 2 ? (const bf16*)(ws + WS_WKVQ) : (const bf16*)(ws + WS_WINB1));
            const int N = (L == 3) ? 2 * D : NPA;
            bf16* outp = (L == 3) ? PROJ + 2 * SLOT : PROJ;
            pg8::Gemm g{XN, Bt, M, N, D}; pg8::StaticOrder S; S.init(M, N, F.G, (int)blockIdx.x);
            pg8::EpiBf16<0> E{outp, D, nullptr, D, SLOT, 1.f};
#ifndef NO_G1
            pg8::gemm_phase<pg8::EpiBf16<0>, pg8::StaticOrder, true, true>(F.lds + RING_OFF, g, S, E);
#endif
            SEAM(pb + 0);
        }
        if (IN(pb + 1) && !isA) { phase_tid(F);
#ifndef NO_FZ
            if (L == 2) { fz_rows(F, XN, in[7], in[6], in[8], FZ); headnorm_rows(F, PROJ, in[9]); }
#endif
            headnorm_rows(F, PROJ + 2 * SLOT, in[12] + j * HD);
            SEAM(pb + 1);
        }
        if (IN(pb + 2) && L == 2) { phase_tid(F); fscan(F, FZ, FC); SEAM(pb + 2); }
        if (IN(pb + 2) && isA) {
            rec::run<false>(F.lds + RING_OFF, F.G, PROJ, PROJ + SLOT, PROJ + 2 * SLOT, XN, in[3], L, (float*)(ws + WS_U), (float*)(ws + WS_DG));
            SEAM(pb + 2);
        }
        if (IN(pb + 3)) { phase_tid(F);
#ifndef NO_REC
            if (isA) rec::run<true>(F.lds + RING_OFF, F.G, PROJ, PROJ + SLOT, PROJ + 2 * SLOT, XN, in[3], L, (float*)(ws + WS_U), (float*)(ws + WS_DG));
#endif
#ifndef NO_ATT
            if (!isA) attn_phase(F, (char*)lds + RING_OFF, PROJ + 2 * SLOT, PROJ, PROJ + SLOT, XN, FC);
#endif
            SEAM(pb + 3);
        }
        if (IN(pb + 4)) { phase_tid(F); gatenorm_rows(F, XN, PROJ + 3 * SLOT, (isA ? in[4] : in[13]) + j * D); SEAM(pb + 4); }
        if (IN(pb + 5)) {
            const bf16* Bt = (const bf16*)(ws + (isA ? WS_WOUTA : WS_WOUTB)) + (size_t)j * D * D;
            pg8::Gemm g{XN, Bt, M, D, D}; pg8::StaticOrder S; S.init(M, D, F.G, (int)blockIdx.x);
            pg8::EpiRes E{L == 0 ? in[0] : args.out, args.out, D};
#ifndef NO_G2
            pg8::gemm_phase<pg8::EpiRes, pg8::StaticOrder, true, true>(F.lds + RING_OFF, g, S, E);
#endif
            SEAM(pb + 5);
        }
        if (IN(pb + 6) && L < 3) { phase_tid(F); norm_rows(F, args.out, XN); SEAM(pb + 6); }
    }
#undef IN
#undef SEAM
}

extern "C" void kernel_launch(void* const* d_in, const int* in_sizes, int n_in, void* d_out, int out_size, void* d_ws, size_t ws_size, hipStream_t stream) {
    static int grid = 0;
    if (grid == 0) {
        if (n_in != 15 || in_sizes[0] != M * D || out_size != M * D || ws_size < WS_END) { fprintf(stderr, "kernel_launch: unexpected shapes (n_in %d, in0 %d, out %d, ws %zu)\n", n_in, n_in > 0 ? in_sizes[0] : -1, out_size, ws_size); grid = -1; return; }
        int dev = 0, cus = 0;
        if (hipGetDevice(&dev) != hipSuccess || hipDeviceGetAttribute(&cus, hipDeviceAttributeMultiprocessorCount, dev) != hipSuccess) { grid = -1; return; }
        if (hipFuncSetAttribute((const void*)fwd_kernel, hipFuncAttributeMaxDynamicSharedMemorySize, LDS_BYTES) != hipSuccess) { fprintf(stderr, "kernel_launch: hipFuncSetAttribute failed\n"); grid = -1; return; }
        int per_cu = 0;
        if (hipOccupancyMaxActiveBlocksPerMultiprocessor(&per_cu, (const void*)fwd_kernel, NWAVES * 64, LDS_BYTES) != hipSuccess || per_cu < 1) fprintf(stderr, "kernel_launch: occupancy query says %d\n", per_cu);
        (void)hipGetLastError();
        grid = cus;
    }
    if (grid < 0) return;
    (void)hipMemsetAsync((char*)d_ws + WS_CTL, 0, CTL_ZERO_BYTES, stream);
    Args a{};
    for (int i = 0; i < 15; ++i) a.in[i] = (const float*)d_in[i];
    a.out = (float*)d_out; a.ws = (unsigned char*)d_ws;
#if ONE_LAUNCH
    a.ph_lo = 0; a.ph_hi = NPHASE;
    hipLaunchKernelGGL(fwd_kernel, dim3(grid), dim3(NWAVES * 64), LDS_BYTES, stream, a);
#else
    for (int p = 0; p < NPHASE; ++p) { if (!phase_live(p)) continue; a.ph_lo = p; a.ph_hi = p + 1; hipLaunchKernelGGL(fwd_kernel, dim3(grid), dim3(NWAVES * 64), LDS_BYTES, stream, a); }
#endif
}
```

```cpp
#include <hip/hip_runtime.h>
#include <hip/hip_bf16.h>
#include <cstdio>
#include <cstdint>
#include <cmath>
namespace pg8 {
#define PG8_LAS __attribute__((address_space(3)))
typedef unsigned short bf16_t;
typedef short bf16x8 __attribute__((ext_vector_type(8)));
typedef float f32x4 __attribute__((ext_vector_type(4)));
typedef unsigned u32x4 __attribute__((ext_vector_type(4)));
constexpr int BM = 256, BK = 64, HALF = 128, HTB = HALF * BK * 2  , STAGE_BYTES = 8 * HTB, NXCD = 8, WGM = 8;

__host__ __device__ __forceinline__ int lds_byte(int r, int c) { const int st = (r >> 4) * 2 + (c >> 5), rr = r & 15, cc = c & 31, ob = rr * 64 + cc * 2; return st * 1024 + (ob ^ (((ob >> 9) & 1) << 5)); }
__host__ __device__ __forceinline__ void stage_rc(int b, int& R, int& C) { const int st = b / 1024, sb = b % 1024, swz = sb ^ (((sb >> 9) & 1) << 5); R = (st >> 1) * 16 + swz / 64; C = (st & 1) * 32 + (swz % 64) / 2; }
__host__ __device__ __forceinline__ int perm32(int rho) { const int n = rho >> 4, i = rho & 15; return 8 * (i >> 2) + 4 * n + (i & 3); }

struct Unit { int pm, pn; };
struct Gemm { const bf16_t* A; const bf16_t* Bt; int M, N, K; };

struct StaticOrder {
    int nM, nN, nwg, G, c;
    __host__ __device__ void init(int M, int N, int G_, int c_) { nM = M / BM; nN = N / BM; nwg = nM * nN; G = G_; c = c_; }
    __host__ __device__ bool next(int i, Unit& u) const {
        const long L = (long)i * G + c; if (L >= nwg) return false;
        int wgid = (int)L; { const int q = nwg / NXCD, r = nwg % NXCD, xcd = wgid % NXCD, off = wgid / NXCD; wgid = (xcd < r ? xcd * (q + 1) : r * (q + 1) + (xcd - r) * q) + off; }
        const int nig = WGM * nN, gid = wgid / nig, fm = gid * WGM, gsz = (nM - fm) < WGM ? (nM - fm) : WGM;
        u.pm = fm + ((wgid % nig) % gsz); u.pn = (wgid % nig) / gsz; return true;
    }
    __device__ __forceinline__ void a_ready(const Unit&) const {}
    __device__ __forceinline__ void done(const Unit&) const {}
};

__device__ __forceinline__ unsigned cvt_pk_bf16(float lo, float hi) { unsigned r; asm volatile("v_cvt_pk_bf16_f32 %0, %1, %2" : "=v"(r) : "v"(lo), "v"(hi)); return r; }
typedef float f32x2 __attribute__((ext_vector_type(2)));
__device__ __forceinline__ f32x2 gelu_pk(f32x2 v) {
    const f32x2 av = __builtin_elementwise_abs(v), d = av * 0.2316418882f + 1.0f;
    f32x2 t; t.x = __builtin_amdgcn_rcpf(d.x); t.y = __builtin_amdgcn_rcpf(d.y);
    f32x2 q = t * 0.5307027145f + (-0.7265760135f); q = q * t + 0.7107068705f; q = q * t + (-0.142248368f); q = q * t + 0.127414796f; q = q * t;
    const f32x2 s = (v * v) * (-0.72134752044f);
    f32x2 e; e.x = __builtin_amdgcn_exp2f(s.x); e.y = __builtin_amdgcn_exp2f(s.y);
    const f32x2 m = v * (q * e), r = v - m;
    f32x2 o; o.x = v.x < 0.f ? m.x : r.x; o.y = v.y < 0.f ? m.y : r.y; return o;
}

template <int ACT  > struct EpiBf16 {
    static constexpr bool PERM = true, AFTER_DRAIN = false; static_assert(ACT == 0 || ACT == 1, "EpiBf16: ACT is 0 (none) or 1 (gelu_pk)");
    bf16_t* O; int ldc; const float* bias; int split_cols; size_t split_stride; float scale0;
    __device__ __forceinline__ void operator()(const f32x4 (&acc)[2][2][4][2], const Unit& u, int wr, int wc, int fr, int fq) const {
        const int row0 = u.pm * BM + wr * 64 + fr; int colt = u.pn * BM; bf16_t* base = O;
        float sc = 1.f; if (split_cols) { const int t = colt / split_cols; base += (size_t)t * split_stride; colt -= t * split_cols; if (t == 0) sc = scale0; }
        const int col0 = colt + wc * 32 + 8 * fq, bcol0 = u.pn * BM + wc * 32 + 8 * fq;
        f32x4 bv[2][2];
#pragma unroll
        for (int bj = 0; bj < 2; ++bj)
#pragma unroll
            for (int n = 0; n < 2; ++n) bv[bj][n] = bias ? *(const f32x4*)(bias + bcol0 + bj * HALF + 4 * n) : (f32x4){0.f, 0.f, 0.f, 0.f};
#pragma unroll
        for (int ai = 0; ai < 2; ++ai)
#pragma unroll
            for (int m = 0; m < 4; ++m) { bf16_t* rowp = base + (size_t)(row0 + ai * HALF + m * 16) * ldc + col0;
#pragma unroll
                for (int bj = 0; bj < 2; ++bj) { f32x4 v0 = acc[ai][bj][m][0] + bv[bj][0], v1 = acc[ai][bj][m][1] + bv[bj][1];
                    if (ACT == 1) { f32x2 a = gelu_pk((f32x2){v0[0], v0[1]}), b = gelu_pk((f32x2){v0[2], v0[3]}), c = gelu_pk((f32x2){v1[0], v1[1]}), d = gelu_pk((f32x2){v1[2], v1[3]});
                        v0 = (f32x4){a.x, a.y, b.x, b.y}; v1 = (f32x4){c.x, c.y, d.x, d.y}; }
                    v0 = v0 * sc; v1 = v1 * sc; u32x4 w; w.x = cvt_pk_bf16(v0[0], v0[1]); w.y = cvt_pk_bf16(v0[2], v0[3]); w.z = cvt_pk_bf16(v1[0], v1[1]); w.w = cvt_pk_bf16(v1[2], v1[3]);
                    *(u32x4*)(rowp + bj * HALF) = w; } }
    }
};
struct EpiRes {
    static constexpr bool PERM = false, AFTER_DRAIN = false;
    const float* res; float* out; int ldc;
    __device__ __forceinline__ void operator()(const f32x4 (&acc)[2][2][4][2], const Unit& u, int wr, int wc, int fr, int fq) const {
        const int row0 = u.pm * BM + wr * 64 + fr, col0 = u.pn * BM + wc * 32 + 4 * fq;
#pragma unroll
        for (int ai = 0; ai < 2; ++ai)
#pragma unroll
            for (int m = 0; m < 4; ++m) { const size_t off = (size_t)(row0 + ai * HALF + m * 16) * ldc + col0;
                f32x4 r[2][2];
#pragma unroll
                for (int bj = 0; bj < 2; ++bj)
#pragma unroll
                    for (int n = 0; n < 2; ++n) r[bj][n] = *(const f32x4*)(res + off + bj * HALF + n * 16);
#pragma unroll
                for (int bj = 0; bj < 2; ++bj)
#pragma unroll
                    for (int n = 0; n < 2; ++n) *(f32x4*)(out + off + bj * HALF + n * 16) = r[bj][n] + acc[ai][bj][m][n]; }
    }
};
template <class Epi, class Sched, bool ALIGN_EPI = false, bool SP2 = false>
__device__ __forceinline__ void gemm_phase(PG8_LAS unsigned char* lds, const Gemm g, const Sched& S, const Epi& E) {
    int tid_ = threadIdx.x; asm volatile("" : "+v"(tid_));
    const int tid = tid_, wid = __builtin_amdgcn_readfirstlane(tid >> 6), lane = tid & 63, wr = wid >> 2, wc = wid & 3, fr = lane & 15, fq = lane >> 4;
    const int K = g.K, nt = K / BK;
    unsigned voffA[2], voffB[2];
#pragma unroll
    for (int i = 0; i < 2; ++i) { int R, C; stage_rc(tid * 16 + i * 8192, R, C); const int Rb = Epi::PERM ? ((R & ~31) + perm32(R & 31)) : R;
        voffA[i] = (unsigned)(R * K + C) * 2u; voffB[i] = (unsigned)(Rb * K + C) * 2u; }
    const size_t kstep = (size_t)(BK * 2);
    const size_t hstep = (size_t)HALF * K * 2;
    const size_t tstep = 2 * hstep;
    const unsigned ldsw = (unsigned)wid * 1024u;
    const int aoff = lds_byte(wr * 64 + fr, fq * 8), boff = lds_byte(wc * 32 + fr, fq * 8);
#define PG8_SA(b, h) (((b) * 2 + (h)) * HTB)
#define PG8_SB(b, h) ((4 + (b) * 2 + (h)) * HTB)
#define PG8_STAGE(bufoff, gbase, voff) do { _Pragma("unroll") for (int _i = 0; _i < 2; ++_i) \
        __builtin_amdgcn_global_load_lds((const unsigned*)((const char*)(gbase) + (voff)[_i]), (PG8_LAS unsigned*)(lds + (bufoff) + ldsw + _i * 8192), 16, 0, 0); } while (0)
#define PG8_LDA(dst, b, h) do { _Pragma("unroll") for (int m = 0; m < 4; ++m) _Pragma("unroll") for (int k = 0; k < 2; ++k) dst[m][k] = *(const PG8_LAS bf16x8*)(lds + PG8_SA(b, h) + aoff + m * 2048 + k * 1024); } while (0)
#define PG8_LDB(dst, b, h) do { _Pragma("unroll") for (int n = 0; n < 2; ++n) _Pragma("unroll") for (int k = 0; k < 2; ++k) dst[n][k] = *(const PG8_LAS bf16x8*)(lds + PG8_SB(b, h) + boff + n * 2048 + k * 1024); } while (0)
#define PG8_MMA(ai, bj, At, Bt) do { __builtin_amdgcn_s_setprio(1); _Pragma("unroll") for (int m = 0; m < 4; ++m) _Pragma("unroll") for (int n = 0; n < 2; ++n) _Pragma("unroll") for (int k = 0; k < 2; ++k) \
        acc[ai][bj][m][n] = __builtin_amdgcn_mfma_f32_16x16x32_bf16(Bt[n][k], At[m][k], acc[ai][bj][m][n], 0, 0, 0); __builtin_amdgcn_s_setprio(0); } while (0)
#define PG8_WAIT_V(n) asm volatile("s_waitcnt vmcnt(" #n ")" ::: "memory")
#define PG8_WAIT_L(n) asm volatile("s_waitcnt lgkmcnt(" #n ")" ::: "memory")
#define PG8_BAR __builtin_amdgcn_s_barrier()
#define PG8_SCHED __builtin_amdgcn_sched_barrier(0)
    Unit cur, nxt; int ui = 0;
    if (!S.next(0, cur)) return;
    f32x4 acc[2][2][4][2];
#pragma unroll
    for (int a = 0; a < 2; ++a)
#pragma unroll
        for (int b = 0; b < 2; ++b)
#pragma unroll
            for (int m = 0; m < 4; ++m)
#pragma unroll
                for (int n = 0; n < 2; ++n) acc[a][b][m][n] = (f32x4){0.f, 0.f, 0.f, 0.f};
    bf16x8 At[4][2], B0[2][2], B1[2][2];
    const char* cA = (const char*)g.A + (size_t)cur.pm * tstep; const char* cB = (const char*)g.Bt + (size_t)cur.pn * tstep;
    S.a_ready(cur);
    if constexpr (SP2) {
        PG8_STAGE(PG8_SB(0, 0), cB, voffB); PG8_STAGE(PG8_SB(0, 1), cB + hstep, voffB); PG8_STAGE(PG8_SA(0, 0), cA, voffA); PG8_STAGE(PG8_SA(0, 1), cA + hstep, voffA);
        if (wr == 1) PG8_BAR;
        PG8_WAIT_V(2); PG8_BAR;
        PG8_STAGE(PG8_SB(1, 0), cB + kstep, voffB); PG8_STAGE(PG8_SA(1, 0), cA + kstep, voffA); PG8_STAGE(PG8_SB(1, 1), cB + hstep + kstep, voffB);
        PG8_WAIT_V(6); PG8_BAR;
    } else {
        PG8_STAGE(PG8_SB(0, 0), cB, voffB); PG8_STAGE(PG8_SA(0, 0), cA, voffA); PG8_STAGE(PG8_SB(0, 1), cB + hstep, voffB); PG8_STAGE(PG8_SA(0, 1), cA + hstep, voffA);
        if (wr == 1) PG8_BAR;
        PG8_WAIT_V(4); PG8_BAR;
        PG8_STAGE(PG8_SB(1, 0), cB + kstep, voffB); PG8_STAGE(PG8_SA(1, 0), cA + kstep, voffA); PG8_STAGE(PG8_SB(1, 1), cB + hstep + kstep, voffB);
        PG8_WAIT_V(6); PG8_BAR;
    }
    for (;;) {
        const bool has_next = S.next(ui + 1, nxt);
        const char* nA = has_next ? (const char*)g.A + (size_t)nxt.pm * tstep : cA; const char* nB = has_next ? (const char*)g.Bt + (size_t)nxt.pn * tstep : cB;
        for (int t = 0; t < nt; t += 2) {
            const bool last = (t == nt - 2);
            const char* a1 = cA + (size_t)(t + 1) * kstep;
            const char* a2 = last ? nA : cA + (size_t)(t + 2) * kstep; const char* b2 = last ? nB : cB + (size_t)(t + 2) * kstep;
            const char* a3 = a2 + kstep; const char* b3 = b2 + kstep;
            if (last && has_next) S.a_ready(nxt);
            if constexpr (SP2) {
            PG8_LDB(B0, 0, 0); PG8_LDB(B1, 0, 1); PG8_SCHED; PG8_LDA(At, 0, 0); PG8_STAGE(PG8_SA(1, 1), a1 + hstep, voffA);
            PG8_WAIT_V(8); PG8_WAIT_L(0); PG8_BAR; PG8_MMA(0, 0, At, B0); PG8_MMA(0, 1, At, B1); PG8_BAR; PG8_SCHED;
            PG8_LDA(At, 0, 1); PG8_STAGE(PG8_SB(0, 0), b2, voffB); PG8_STAGE(PG8_SB(0, 1), b2 + hstep, voffB); PG8_STAGE(PG8_SA(0, 0), a2, voffA);
            PG8_WAIT_V(8); PG8_WAIT_L(0); PG8_BAR; PG8_MMA(1, 0, At, B0); PG8_MMA(1, 1, At, B1); PG8_BAR; PG8_SCHED;
            PG8_LDB(B0, 1, 0); PG8_LDB(B1, 1, 1); PG8_SCHED; PG8_LDA(At, 1, 0); PG8_STAGE(PG8_SA(0, 1), a2 + hstep, voffA);
            PG8_WAIT_V(8); PG8_WAIT_L(0); PG8_BAR; PG8_MMA(0, 0, At, B0); PG8_MMA(0, 1, At, B1); PG8_BAR; PG8_SCHED;
            PG8_LDA(At, 1, 1); PG8_STAGE(PG8_SB(1, 0), b3, voffB); PG8_STAGE(PG8_SB(1, 1), b3 + hstep, voffB); PG8_STAGE(PG8_SA(1, 0), a3, voffA);
            PG8_WAIT_V(8); PG8_WAIT_L(0); PG8_BAR; PG8_MMA(1, 0, At, B0); PG8_MMA(1, 1, At, B1); PG8_BAR; PG8_SCHED;
            } else {
            PG8_LDB(B0, 0, 0); PG8_SCHED; PG8_LDA(At, 0, 0); PG8_STAGE(PG8_SA(1, 1), a1 + hstep, voffA);
            PG8_WAIT_L(8); PG8_BAR; PG8_WAIT_L(0); PG8_MMA(0, 0, At, B0); PG8_BAR; PG8_SCHED;
            PG8_LDB(B1, 0, 1); PG8_STAGE(PG8_SB(0, 0), b2, voffB);
            PG8_BAR; PG8_WAIT_L(0); PG8_MMA(0, 1, At, B1); PG8_BAR;
            PG8_LDA(At, 0, 1); PG8_STAGE(PG8_SA(0, 0), a2, voffA);
            PG8_BAR; PG8_WAIT_L(0); PG8_MMA(1, 0, At, B0); PG8_BAR; PG8_SCHED;
            PG8_STAGE(PG8_SB(0, 1), b2 + hstep, voffB);
            PG8_WAIT_V(6); PG8_BAR; PG8_MMA(1, 1, At, B1); PG8_BAR;
            PG8_LDB(B0, 1, 0); PG8_SCHED; PG8_LDA(At, 1, 0); PG8_STAGE(PG8_SA(0, 1), a2 + hstep, voffA);
            PG8_WAIT_L(8); PG8_BAR; PG8_WAIT_L(0); PG8_MMA(0, 0, At, B0); PG8_BAR; PG8_SCHED;
            PG8_LDB(B1, 1, 1); PG8_STAGE(PG8_SB(1, 0), b3, voffB);
            PG8_BAR; PG8_WAIT_L(0); PG8_MMA(0, 1, At, B1); PG8_BAR;
            PG8_LDA(At, 1, 1); PG8_STAGE(PG8_SA(1, 0), a3, voffA);
            PG8_BAR; PG8_WAIT_L(0); PG8_MMA(1, 0, At, B0); PG8_BAR; PG8_SCHED;
            PG8_STAGE(PG8_SB(1, 1), b3 + hstep, voffB);
            PG8_WAIT_V(6); PG8_BAR; PG8_MMA(1, 1, At, B1); PG8_BAR;
            }
        }
        if constexpr (ALIGN_EPI) { if (wr == 0) PG8_BAR; }
        if constexpr (!Epi::AFTER_DRAIN) { E(acc, cur, wr, wc, fr, fq); S.done(cur); }
        if (!has_next) break;
#pragma unroll
        for (int a = 0; a < 2; ++a)
#pragma unroll
            for (int b = 0; b < 2; ++b)
#pragma unroll
                for (int m = 0; m < 4; ++m)
#pragma unroll
                    for (int n = 0; n < 2; ++n) acc[a][b][m][n] = (f32x4){0.f, 0.f, 0.f, 0.f};
        cur = nxt; cA = nA; cB = nB; ++ui;
        if constexpr (ALIGN_EPI) { if (wr == 1) PG8_BAR; }
    }
    PG8_WAIT_V(0);
    if constexpr (!ALIGN_EPI) { if (wr == 0) PG8_BAR; }
    PG8_BAR;
    if constexpr (Epi::AFTER_DRAIN) { E.fused(acc, cur, wr, wc, fr, fq, lds, wid, lane); S.done(cur); }
#undef PG8_SA
#undef PG8_SB
#undef PG8_STAGE
#undef PG8_LDA
#undef PG8_LDB
#undef PG8_MMA
#undef PG8_WAIT_V
#undef PG8_WAIT_L
#undef PG8_BAR
#undef PG8_SCHED
}
}
namespace fox {
constexpr int ALD = 2048;
constexpr int AD = 128;
constexpr float SCALE = 0.08838834764831845f;
constexpr float INVS = 11.313708498984761f;
constexpr float THR = 8.f;
constexpr int NW = 8, QBLK = 32, KVBLK = 64, QB = NW * QBLK;
constexpr int SHM_V = KVBLK * AD * 2, SHM_K = KVBLK * AD * 2;
constexpr int LDS_F = 2 * SHM_V + 2 * SHM_K + NW * 64 * 4;
constexpr int LDS_BYTES = LDS_F + 2 * 256;

using bf16 = __hip_bfloat16;
typedef short bf16x8 __attribute__((ext_vector_type(8)));
typedef short s16x4 __attribute__((ext_vector_type(4)));
typedef float f32x16 __attribute__((ext_vector_type(16)));
typedef float f32x4 __attribute__((ext_vector_type(4)));
typedef unsigned u32x4 __attribute__((ext_vector_type(4)));

#define KSWZ(row, colB) ((row) * 256 + ((colB) ^ (((row) & 7) << 4)))
#define SBAR() __builtin_amdgcn_sched_barrier(0)
__device__ __forceinline__ int v_st(int k, int c) { const int kk = (k & ~0xC) | ((k & 4) << 1) | ((k & 8) >> 1); return ((kk >> 3) * 4 + (c >> 5)) * 512 + ((kk & 7) * 32 + (c & 31)) * 2; }
__device__ __forceinline__ int v_rd_base(int lane) { return ((lane & 3) << 3) | (((lane >> 2) & 3) << 6) | (((lane >> 4) & 1) << 5) | (((lane >> 5) & 1) << 8); }
constexpr int v_rd_off(int d0, int ks, int half) { return d0 * 512 + ks * 4096 + half * 2048; }
__device__ __forceinline__ int crow(int r, int hi) { return (r & 3) + 8 * (r >> 2) + 4 * hi; }
__device__ __forceinline__ unsigned cvtpk(float lo, float hi) {
    unsigned r; asm volatile("v_cvt_pk_bf16_f32 %0, %1, %2" : "=v"(r) : "v"(lo), "v"(hi)); return r;
}
typedef __amdgpu_buffer_rsrc_t rsrc_t;
__device__ __forceinline__ rsrc_t mk_rsrc(const void* p) { return __builtin_amdgcn_make_buffer_rsrc((void*)p, (short)0, 0x7ffffff0, 0x00020000); }
__device__ __forceinline__ bf16x8 ldb8(rsrc_t r, int voff, int soff) { return __builtin_bit_cast(bf16x8, __builtin_amdgcn_raw_buffer_load_b128(r, voff, soff, 0)); }
__device__ __forceinline__ f32x4 ldf4(rsrc_t r, int voff, int soff) { return __builtin_bit_cast(f32x4, __builtin_amdgcn_raw_buffer_load_b128(r, voff, soff, 0)); }
__device__ __forceinline__ void mask_tile(f32x16& p0, f32x16& p1, int dq, unsigned W) {
    const float NEG = -__builtin_inff();
#pragma unroll
    for (int r = 0; r < 16; ++r) {
        const int c = (r & 3) + 8 * (r >> 2);
        if ((unsigned)(dq - c) >= W) p0[r] = NEG;
        if ((unsigned)(dq - c - 32) >= W) p1[r] = NEG;
    }
}
__device__ __forceinline__ void partialSM(f32x16& p0, f32x16& p1, float& m_reg, float& mn, float& alpha) {
    float pmax = p0[0]; for (int r = 1; r < 16; ++r) pmax = fmaxf(pmax, p0[r]); for (int r = 0; r < 16; ++r) pmax = fmaxf(pmax, p1[r]);
    { auto rr = __builtin_amdgcn_permlane32_swap(__float_as_uint(pmax), __float_as_uint(pmax), false, false);
      pmax = fmaxf(__uint_as_float(rr[0]), __uint_as_float(rr[1])); }
    constexpr float C2 = 1.4426950408889634f * SCALE;
    if (__builtin_expect(__all((pmax - m_reg) * SCALE <= THR), 1)) { mn = m_reg; alpha = 1.f; }
    else { mn = fmaxf(m_reg, pmax); alpha = __builtin_amdgcn_exp2f((m_reg - mn) * C2); m_reg = mn; }
    const float mnL = -mn * C2;
    for (int r = 0; r < 16; ++r) p0[r] = fmaf(p0[r], C2, mnL); for (int r = 0; r < 16; ++r) p1[r] = fmaf(p1[r], C2, mnL);
    for (int r = 0; r < 16; ++r) p0[r] = __builtin_amdgcn_exp2f(p0[r]);
}
__device__ __forceinline__ void finishSM(f32x16& p0, f32x16& p1, float alpha, float& l_reg, bf16x8& pa0, bf16x8& pa1, bf16x8& pa2, bf16x8& pa3) {
    for (int r = 0; r < 16; ++r) p1[r] = __builtin_amdgcn_exp2f(p1[r]);
    float ps = 0; for (int r = 0; r < 16; ++r) ps += p0[r]; for (int r = 0; r < 16; ++r) ps += p1[r];
    { auto rr = __builtin_amdgcn_permlane32_swap(__float_as_uint(ps), __float_as_uint(ps), false, false);
      ps = __uint_as_float(rr[0]) + __uint_as_float(rr[1]); }
    l_reg = l_reg * alpha + ps;
#define PK4(P, B_, OUT) do { unsigned a0 = cvtpk(P[B_+0], P[B_+1]), a1 = cvtpk(P[B_+2], P[B_+3]);                          \
        unsigned b0 = cvtpk(P[B_+4], P[B_+5]), b1 = cvtpk(P[B_+6], P[B_+7]);                                             \
        auto r0 = __builtin_amdgcn_permlane32_swap(a0, b0, false, false); auto r1 = __builtin_amdgcn_permlane32_swap(a1, b1, false, false); \
        u32x4 w = {r0[0], r1[0], r0[1], r1[1]}; OUT = *reinterpret_cast<bf16x8*>(&w); } while (0)
    PK4(p0, 0, pa0); PK4(p0, 8, pa1); PK4(p1, 0, pa2); PK4(p1, 8, pa3);
#undef PK4
}
template <int KB>
__device__ __forceinline__ void qkt(f32x16& p0, f32x16& p1, const char* K_lds, const char* F_lds, int r32, int hi, const bf16x8* qr) {
    { const f32x4* fk = reinterpret_cast<const f32x4*>(F_lds + KB * 256);
#pragma unroll
      for (int g = 0; g < 4; ++g) { const f32x4 a = fk[2 * g + hi], b = fk[8 + 2 * g + hi];
#pragma unroll
          for (int e = 0; e < 4; ++e) { p0[4 * g + e] = a[e]; p1[4 * g + e] = b[e]; } } }
    const char* kb[4];
#pragma unroll
    for (int dd = 0; dd < 4; ++dd) kb[dd] = K_lds + KB * SHM_K + KSWZ(r32, (dd * 16 + hi * 8) * 2);
#pragma unroll
    for (int d0 = 0; d0 < 8; ++d0) { const char* a = kb[d0 & 3] + (d0 >> 2) * 128;
        bf16x8 b0 = *reinterpret_cast<const bf16x8*>(a);
        bf16x8 b1 = *reinterpret_cast<const bf16x8*>(a + 32 * 256);
        p0 = __builtin_amdgcn_mfma_f32_32x32x16_bf16(b0, qr[d0], p0, 0, 0, 0);
        p1 = __builtin_amdgcn_mfma_f32_32x32x16_bf16(b1, qr[d0], p1, 0, 0, 0); }
}
template <int VB>
__device__ __forceinline__ void pv_tile(f32x16* o, int vb0, bf16x8 pa0, bf16x8 pa1, bf16x8 pa2, bf16x8 pa3) {
#define TRRD(dst, off) asm volatile("ds_read_b64_tr_b16 %0, %1 offset:%2" : "=&v"(dst) : "v"(vb0), "i"(off) : "memory")
#define PV_D0(d0) do { s16x4 l0, l1, l2, l3, h0, h1, h2, h3; constexpr int b_ = VB * SHM_V + v_rd_off(d0, 0, 0);     \
        TRRD(l0, b_); TRRD(h0, b_ + 2048); TRRD(l1, b_ + 4096); TRRD(h1, b_ + 6144); TRRD(l2, b_ + 8192); TRRD(h2, b_ + 10240); TRRD(l3, b_ + 12288); TRRD(h3, b_ + 14336); \
        asm volatile("s_waitcnt lgkmcnt(0)" ::: "memory"); SBAR();                 \
        o[d0] = __builtin_amdgcn_mfma_f32_32x32x16_bf16(pa0, (bf16x8){l0[0], l0[1], l0[2], l0[3], h0[0], h0[1], h0[2], h0[3]}, o[d0], 0, 0, 0);   \
        o[d0] = __builtin_amdgcn_mfma_f32_32x32x16_bf16(pa1, (bf16x8){l1[0], l1[1], l1[2], l1[3], h1[0], h1[1], h1[2], h1[3]}, o[d0], 0, 0, 0);   \
        o[d0] = __builtin_amdgcn_mfma_f32_32x32x16_bf16(pa2, (bf16x8){l2[0], l2[1], l2[2], l2[3], h2[0], h2[1], h2[2], h2[3]}, o[d0], 0, 0, 0);   \
        o[d0] = __builtin_amdgcn_mfma_f32_32x32x16_bf16(pa3, (bf16x8){l3[0], l3[1], l3[2], l3[3], h3[0], h3[1], h3[2], h3[3]}, o[d0], 0, 0, 0); } while (0)
    PV_D0(0); PV_D0(1); PV_D0(2); PV_D0(3);
#undef PV_D0
#undef TRRD
}

struct BlockRef { const bf16* Q; const bf16* K; const bf16* V; bf16* O; const float* F; int P0; int jlo; };
struct Seam {
    bf16x8 qr[8];
    bf16x8 st_v0, st_v1, st_k0, st_k1; f32x4 st_f;
};
#define VMW() asm volatile("s_waitcnt vmcnt(0)" ::: "memory")
#define VMWN(n) asm volatile("s_waitcnt vmcnt(%0)" :: "i"(n) : "memory")
#define SLOAD_H(rK_, rV_, rF_, k0) do { const int so_ = (k0) * (ALD * 2);                                                    \
                         S.st_v0 = ldb8(rV_, kvoff, so_); S.st_v1 = ldb8(rV_, kvoff, so_ + 32 * ALD * 2);                    \
                         S.st_k0 = ldb8(rK_, kvoff, so_); S.st_k1 = ldb8(rK_, kvoff, so_ + 32 * ALD * 2);                    \
                         if (tid < 16) S.st_f = ldf4(rF_, tid * 16, (k0) * 4); } while (0)
#define QLOAD(rQ_) do { _Pragma("unroll") for (int d0 = 0; d0 < 8; ++d0) S.qr[d0] = ldb8(rQ_, qoff + d0 * 32, 0); } while (0)
#define SWRITE_HK(bf) do { *(bf16x8*)(K_lds + (bf) * SHM_K + kws) = S.st_k0; *(bf16x8*)(K_lds + (bf) * SHM_K + kws + 32 * 256) = S.st_k1; \
                           if (tid < 16) *(f32x4*)(F_lds + (bf) * 256 + tid * 16) = S.st_f; } while (0)
#define SWRITE_HV(bf) do { *(bf16x8*)(V_lds + (bf) * SHM_V + vst0) = S.st_v0; *(bf16x8*)(V_lds + (bf) * SHM_V + vst1) = S.st_v1; } while (0)
#define SWRITE_H(bf) do { SWRITE_HV(bf); SWRITE_HK(bf); } while (0)
__device__ __forceinline__ int fox_jlo(const float* Fn, int P0, float TH) {
    int lane_ = threadIdx.x & 63; asm volatile("" : "+v"(lane_));
    const int ntf = P0 / KVBLK + 4, kt = lane_ < ntf ? lane_ : ntf - 1;
    int zero_ = 0; asm volatile("" : "+v"(zero_));
    const float fe = Fn[kt * KVBLK + KVBLK - 1], fp0 = Fn[P0 + zero_];
    const unsigned long long mk = __ballot(fp0 - fe <= TH);
    return (int)__builtin_ctzll(mk);
}
__device__ __forceinline__ void causal_prime(const BlockRef& cur, char* lds, Seam& S) {
    int tid_ = threadIdx.x; asm volatile("" : "+v"(tid_));
    const int tid = tid_, wid = __builtin_amdgcn_readfirstlane(tid >> 6), lane = tid & 63, r32 = lane & 31, hi = lane >> 5;
    const int sr = tid >> 4, sc = (tid & 15) * 8, kws = KSWZ(sr, sc * 2); char* K_lds = lds + 2 * SHM_V; char* F_lds = lds + LDS_F;
    const int kvoff = (sr * ALD + sc) * 2, qoff = ((wid * QBLK + r32) * ALD + hi * 8) * 2;
    const rsrc_t rQ = mk_rsrc(cur.Q), rK = mk_rsrc(cur.K), rV = mk_rsrc(cur.V), rF = mk_rsrc(cur.F);
    QLOAD(rQ);
    SLOAD_H(rK, rV, rF, cur.jlo * KVBLK); VMW(); SWRITE_HK(0);
    __syncthreads();
}
__device__ __forceinline__ void causal_block(const BlockRef& cur, const BlockRef& nxt, char* lds, Seam& S) {
    int tid_ = threadIdx.x; asm volatile("" : "+v"(tid_));
    const int tid = tid_, wid = __builtin_amdgcn_readfirstlane(tid >> 6), lane = tid & 63, r32 = lane & 31, hi = lane >> 5;
    constexpr int W = 1 << 30;
    const int j_lo = cur.jlo, NT = (cur.P0 + QB - 1) / KVBLK + 1 - j_lo;
    const int qlo = cur.P0 + wid * QBLK, qm = qlo + r32 - 4 * hi;
    char* V_lds = lds; char* K_lds = lds + 2 * SHM_V; char* F_lds = lds + LDS_F;
    float* ws = (float*)(lds + 2 * SHM_V + 2 * SHM_K) + wid * 64; float* li_l = ws, * al_l = ws + 32;
    float m_reg = -1e30f, l_reg = 0; f32x16 o[4] = {};
    const int sr = tid >> 4, sc = (tid & 15) * 8, vst0 = v_st(sr, sc), vst1 = v_st(32 + sr, sc), kws = KSWZ(sr, sc * 2);
    const int vb0 = (int)(uintptr_t)V_lds + v_rd_base(lane);
    const int kvoff = (sr * ALD + sc) * 2, qoff = ((wid * QBLK + r32) * ALD + hi * 8) * 2;
    const rsrc_t Kh = mk_rsrc(cur.K), Vh = mk_rsrc(cur.V), Fh = mk_rsrc(cur.F);
#define RESC(a) do { if (__any((a) < 1.f)) { if (hi == 0) al_l[r32] = (a); asm volatile("s_waitcnt lgkmcnt(0)" ::: "memory");              \
                     for (int d_ = 0; d_ < 4; ++d_) for (int r = 0; r < 16; ++r) o[d_][r] *= al_l[crow(r, hi)]; } } while (0)
#define KBASE(t) ((j_lo + (t)) * KVBLK)
#define MASKT(P0_, P1_, t) do { const int kb_ = KBASE(t); if (kb_ + KVBLK - 1 > qlo) mask_tile(P0_, P1_, qm - kb_, (unsigned)W); } while (0)
    constexpr int NQL = 8;
#define SEAM_K0() do { VMWN(NQL); SWRITE_HK(0); SBAR(); } while (0)
    f32x16 pA0, pA1, pB0, pB1; float mnA, mnB, alA, alB; bf16x8 pa0, pa1, pa2, pa3;
    SWRITE_HV(0); SBAR();
    if (NT > 1) { SLOAD_H(Kh, Vh, Fh, KBASE(1)); }
    SBAR(); qkt<0>(pA0, pA1, K_lds, F_lds, r32, hi, S.qr);
    MASKT(pA0, pA1, 0); partialSM(pA0, pA1, m_reg, mnA, alA);
    if (NT > 1) { VMW(); SWRITE_H(1); }
    __syncthreads();
#define HALF_STEP(PX0, PX1, mnX, alX, PY0, PY1, alY, t, KB, VB, SB) do {                                                      \
        SBAR(); qkt<KB>(PX0, PX1, K_lds, F_lds, r32, hi, S.qr);                                                               \
        finishSM(PY0, PY1, alY, l_reg, pa0, pa1, pa2, pa3); SBAR();                                                           \
        if ((t) + 1 < NT) { SLOAD_H(Kh, Vh, Fh, KBASE((t) + 1)); SBAR(); }                                                    \
        pv_tile<VB>(o, vb0, pa0, pa1, pa2, pa3); MASKT(PX0, PX1, (t)); partialSM(PX0, PX1, m_reg, mnX, alX);                  \
        __syncthreads();                                                                                                      \
        if ((t) + 1 < NT) { VMW(); SWRITE_H(SB); }                                                                            \
        RESC(alX); __syncthreads(); } while (0)
    for (int t = 1; t + 1 < NT; t += 2) {
        HALF_STEP(pB0, pB1, mnB, alB, pA0, pA1, alA, t, 1, 0, 0);
        HALF_STEP(pA0, pA1, mnA, alA, pB0, pB1, alB, t + 1, 0, 1, 1);
    }
    const bool even = (NT & 1) == 0;
    if (even) { SBAR(); qkt<1>(pB0, pB1, K_lds, F_lds, r32, hi, S.qr); SBAR(); }
    { const rsrc_t nK = mk_rsrc(nxt.K), nV = mk_rsrc(nxt.V), nF = mk_rsrc(nxt.F), nQ = mk_rsrc(nxt.Q);
      SLOAD_H(nK, nV, nF, nxt.jlo * KVBLK); SBAR();
      QLOAD(nQ); }
    SBAR();
    finishSM(pA0, pA1, alA, l_reg, pa0, pa1, pa2, pa3); SBAR();
    pv_tile<0>(o, vb0, pa0, pa1, pa2, pa3);
    if (even) { MASKT(pB0, pB1, NT - 1); partialSM(pB0, pB1, m_reg, mnB, alB); __syncthreads(); RESC(alB);
        finishSM(pB0, pB1, alB, l_reg, pa0, pa1, pa2, pa3); SBAR(); pv_tile<1>(o, vb0, pa0, pa1, pa2, pa3); }
    SBAR(); SEAM_K0();
    if (hi == 0) li_l[r32] = l_reg; asm volatile("s_waitcnt lgkmcnt(0)" ::: "memory");
    float rli[16];
#pragma unroll
    for (int r = 0; r < 16; ++r) rli[r] = __builtin_amdgcn_rcpf(li_l[crow(r, hi)]);
    { const rsrc_t rO = mk_rsrc(cur.O); const int ooff = ((wid * QBLK + 4 * hi) * ALD + r32) * 2;
#pragma unroll
      for (int r = 0; r < 16; ++r) {
#pragma unroll
        for (int d0 = 0; d0 < 4; ++d0) { const float v = o[d0][r] * rli[r];
            const float vn = __shfl_xor(v, 1);
            if ((r32 & 1) == 0) __builtin_amdgcn_raw_buffer_store_b32(cvtpk(v, vn), rO, ooff + d0 * 64, ((r & 3) + 8 * (r >> 2)) * (ALD * 2), 0); } } }
    __syncthreads();
#undef RESC
#undef KBASE
#undef MASKT
#undef SEAM_K0
#undef HALF_STEP
}
#undef QLOAD
#undef VMW
#undef VMWN
#undef SLOAD_H
#undef SWRITE_HK
#undef SWRITE_HV
#undef SWRITE_H
#undef KSWZ
#undef SBAR
}
namespace rec {
typedef short bf16x8 __attribute__((ext_vector_type(8)));
typedef short bf16x4 __attribute__((ext_vector_type(4)));
typedef float f32x4 __attribute__((ext_vector_type(4)));
typedef float f32x2 __attribute__((ext_vector_type(2)));
typedef __bf16 bf16x2_t __attribute__((ext_vector_type(2)));
typedef unsigned u32x4 __attribute__((ext_vector_type(4)));
typedef unsigned u32x2 __attribute__((ext_vector_type(2)));
#define REC_LAS __attribute__((address_space(3)))
constexpr int RT = 4096, RD = 2048, NSEG = 4, SEG = RT / NSEG, NCH = SEG / 64;
constexpr int QP = 272, TP = 144;
constexpr int OFF_KB = 160 * QP, OFF_KHT = OFF_KB + 64 * QP, OFF_VT = OFF_KHT + 128 * TP, OFF_AM = OFF_VT + 128 * TP, OFF_TOT = OFF_AM + 64 * TP, OFF_DL = OFF_TOT + 8 * 128 * 4, LDS_END = OFF_DL + 512;
static_assert(LDS_END <= 131072, "recurrence LDS map");
__device__ __forceinline__ constexpr int qv_off(int j) { return (64 * j - 8 * j * (j - 1)) * QP; }
__device__ __forceinline__ unsigned cvt2(float lo, float hi) { f32x2 v = {lo, hi}; bf16x2_t b = __builtin_convertvector(v, bf16x2_t); return __builtin_bit_cast(unsigned, b); }
__device__ __forceinline__ float ex2(float x) { return __builtin_amdgcn_exp2f(x); }
__device__ __forceinline__ float lo_f(unsigned w) { return __uint_as_float(w << 16); }
__device__ __forceinline__ float hi_f(unsigned w) { return __uint_as_float(w & 0xffff0000u); }

template <bool OUT>
__device__ __forceinline__ void run(REC_LAS unsigned char* lds, int G, const unsigned short* Qp, const unsigned short* Zp, const unsigned short* Vp, unsigned short* Op,
                                    const float* lbl, int layer, float* Ug, float* Dg) {
    int tid_ = threadIdx.x; asm volatile("" : "+v"(tid_));
    const int tid = tid_, lane = tid & 63, wv = __builtin_amdgcn_readfirstlane(tid >> 6), fr = lane & 15, fg = lane >> 4;
    constexpr int NU = OUT ? 64 * NSEG : 64 * (NSEG - 1);
    if (OUT) { if (tid < 256) { const int blk = tid >> 7, r = (tid >> 3) & 15, c = tid & 7;
            *(REC_LAS unsigned*)(lds + OFF_AM + (32 * blk + r) * TP + (32 * blk + 16) * 2 + c * 4) = 0u; } }
    for (int u = blockIdx.x; u < NU; u += G) {
        const int bh = OUT ? u / NSEG : u / (NSEG - 1), seg = OUT ? u % NSEG : u % (NSEG - 1), b = bh >> 4, h = bh & 15;
        float lb[2];
#pragma unroll
        for (int dd = 0; dd < 2; ++dd) { const int c = h * 128 + 2 * lane + dd; lb[dd] = layer == 0 ? 0.f : 1.f / (1.f + __expf(lbl[c] - lbl[RD + c])); }
        f32x4 st[8];
#pragma unroll
        for (int kt = 0; kt < 8; ++kt) st[kt] = (f32x4){0.f, 0.f, 0.f, 0.f};
        if (OUT) {
            for (int s2 = 0; s2 < seg; ++s2) {
                const float* U = Ug + ((size_t)(bh * (NSEG - 1) + s2) << 14); const float* Dv = Dg + (bh * (NSEG - 1) + s2) * 128;
#pragma unroll
                for (int kt = 0; kt < 8; ++kt) { const f32x4 dvv = *(const f32x4*)(Dv + 16 * kt + 4 * fg);
#pragma unroll
                    for (int e = 0; e < 4; ++e) st[kt][e] = dvv[e] * st[kt][e] + U[(16 * kt + 4 * fg + e) * 128 + 16 * wv + fr]; }
            }
        }
        float dsum[2] = {0.f, 0.f};
        const size_t row0 = (size_t)(b * RT + seg * SEG) * RD + h * 128;
        unsigned nq[8], nz[8], nv[8];
#pragma unroll
        for (int e = 0; e < 8; ++e) { const size_t o = row0 + (size_t)(8 * wv + e) * RD + 2 * lane; nq[e] = *(const unsigned*)(Qp + o); nz[e] = *(const unsigned*)(Zp + o); nv[e] = *(const unsigned*)(Vp + o); }
#pragma unroll 1
        for (int c = 0; c < NCH; ++c) {
            unsigned cq[8], cz[8], cv[8];
#pragma unroll
            for (int e = 0; e < 8; ++e) { cq[e] = nq[e]; cz[e] = nz[e]; cv[e] = nv[e]; }
            if (c + 1 < NCH) {
#pragma unroll
                for (int e = 0; e < 8; ++e) { const size_t o = row0 + (size_t)(64 * (c + 1) + 8 * wv + e) * RD + 2 * lane; nq[e] = *(const unsigned*)(Qp + o); nz[e] = *(const unsigned*)(Zp + o); nv[e] = *(const unsigned*)(Vp + o); }
            }
            float kf[8][2], cs[8][2];
#pragma unroll
            for (int e = 0; e < 8; ++e) {
#pragma unroll
                for (int dd = 0; dd < 2; ++dd) {
                    const float z = dd ? hi_f(cz[e]) : lo_f(cz[e]);
                    const float ez = ex2(-1.4426950408889634f * fabsf(z)), inv = __builtin_amdgcn_rcpf(1.f + ez);
                    const float sig = z >= 0.f ? inv : ez * inv, nsig = z >= 0.f ? ez * inv : inv;
                    const float f = lb[dd] + (1.f - lb[dd]) * sig;
                    kf[e][dd] = (1.f - lb[dd]) * nsig;
                    const float gl = __builtin_amdgcn_logf(f);
                    cs[e][dd] = e ? cs[e - 1][dd] + gl : gl;
                }
            }
            *(REC_LAS f32x2*)(lds + OFF_TOT + (wv * 128 + 2 * lane) * 4) = (f32x2){cs[7][0], cs[7][1]};
            __syncthreads();
            float P[9][2];
            P[0][0] = 0.f; P[0][1] = 0.f;
#pragma unroll
            for (int w = 0; w < 8; ++w) { const f32x2 t2 = *(const REC_LAS f32x2*)(lds + OFF_TOT + (w * 128 + 2 * lane) * 4); P[w + 1][0] = P[w][0] + t2[0]; P[w + 1][1] = P[w][1] + t2[1]; }
            float base[2], bl[2], Bj[4][2];
#pragma unroll
            for (int dd = 0; dd < 2; ++dd) { bl[dd] = P[8][dd]; float bs = 0.f;
#pragma unroll
                for (int w = 0; w < 8; ++w) bs = (w == wv) ? P[w][dd] : bs;
                base[dd] = bs;
#pragma unroll
                for (int j = 0; j < 4; ++j) Bj[j][dd] = P[2 * j][dd]; }
            const int jb = wv >> 1;
            float Bown[2];
#pragma unroll
            for (int dd = 0; dd < 2; ++dd) { float bo = 0.f;
#pragma unroll
                for (int j = 0; j < 4; ++j) bo = (j == jb) ? Bj[j][dd] : bo;
                Bown[dd] = bo; }
            unsigned khw[2][4], vtw[2][4];
#pragma unroll
            for (int e = 0; e < 8; ++e) {
                const int t = 8 * wv + e;
                float bt[2], qv[2];
#pragma unroll
                for (int dd = 0; dd < 2; ++dd) { bt[dd] = base[dd] + cs[e][dd]; qv[dd] = dd ? hi_f(cq[e]) : lo_f(cq[e]); }
                if (OUT) {
#pragma unroll
                    for (int j = 0; j < 4; ++j) if (j <= jb)
                        *(REC_LAS unsigned*)(lds + qv_off(j) + (t - 16 * j) * QP + lane * 4) = cvt2(qv[0] * ex2(bt[0] - Bj[j][0]), qv[1] * ex2(bt[1] - Bj[j][1]));
                    *(REC_LAS unsigned*)(lds + OFF_KB + t * QP + lane * 4) = cvt2(kf[e][0] * ex2(fminf(Bown[0] - bt[0], 120.f)), kf[e][1] * ex2(fminf(Bown[1] - bt[1], 120.f)));
                }
                const float kh0 = kf[e][0] * ex2(bl[0] - bt[0]), kh1 = kf[e][1] * ex2(bl[1] - bt[1]);
                const float v0 = lo_f(cv[e]), v1 = hi_f(cv[e]);
                if (e & 1) { khw[0][e >> 1] = cvt2(__uint_as_float(khw[0][e >> 1]), kh0); khw[1][e >> 1] = cvt2(__uint_as_float(khw[1][e >> 1]), kh1);
                             vtw[0][e >> 1] = (vtw[0][e >> 1] >> 16) | (cv[e] << 16); vtw[1][e >> 1] = (vtw[1][e >> 1] >> 16) | (cv[e] & 0xffff0000u); (void)v0; (void)v1; }
                else { khw[0][e >> 1] = __float_as_uint(kh0); khw[1][e >> 1] = __float_as_uint(kh1); vtw[0][e >> 1] = cv[e] << 16; vtw[1][e >> 1] = cv[e] & 0xffff0000u; }
            }
#pragma unroll
            for (int dd = 0; dd < 2; ++dd) {
                *(REC_LAS u32x4*)(lds + OFF_KHT + (2 * lane + dd) * TP + wv * 16) = (u32x4){khw[dd][0], khw[dd][1], khw[dd][2], khw[dd][3]};
                *(REC_LAS u32x4*)(lds + OFF_VT + (2 * lane + dd) * TP + wv * 16) = (u32x4){vtw[dd][0], vtw[dd][1], vtw[dd][2], vtw[dd][3]};
            }
            if (wv == 0) *(REC_LAS f32x2*)(lds + OFF_DL + 2 * lane * 4) = (f32x2){ex2(bl[0]), ex2(bl[1])};
            dsum[0] += bl[0]; dsum[1] += bl[1];
            __syncthreads();
            if (OUT) {
#pragma unroll 1
                for (int blk = wv; blk < 10; blk += 8) {
                    const int i = blk < 1 ? 0 : blk < 3 ? 1 : blk < 6 ? 2 : 3, j = blk - (i * (i + 1)) / 2;
                    f32x4 a = {0.f, 0.f, 0.f, 0.f};
                    const REC_LAS unsigned char* ka = lds + OFF_KB + (16 * j + fr) * QP + fg * 16;
                    const REC_LAS unsigned char* qa = lds + qv_off(j) + (16 * (i - j) + fr) * QP + fg * 16;
#pragma unroll
                    for (int kk = 0; kk < 4; ++kk) a = __builtin_amdgcn_mfma_f32_16x16x32_bf16(*(const REC_LAS bf16x8*)(ka + kk * 64), *(const REC_LAS bf16x8*)(qa + kk * 64), a, 0, 0, 0);
                    if (i == j) {
#pragma unroll
                        for (int e = 0; e < 4; ++e) a[e] = (4 * fg + e <= fr) ? a[e] : 0.f; }
                    u32x2 w2; w2.x = cvt2(a[0], a[1]); w2.y = cvt2(a[2], a[3]);
                    *(REC_LAS u32x2*)(lds + OFF_AM + (16 * i + fr) * TP + (16 * j + 4 * fg) * 2) = w2;
                }
                __syncthreads();
            }
            bf16x8 vb[2];
#pragma unroll
            for (int kk = 0; kk < 2; ++kk) vb[kk] = *(const REC_LAS bf16x8*)(lds + OFF_VT + (16 * wv + fr) * TP + kk * 64 + fg * 16);
            if (OUT) {
                bf16x8 sb[4];
#pragma unroll
                for (int k4 = 0; k4 < 4; ++k4) { u32x4 w4; w4.x = cvt2(st[2 * k4][0], st[2 * k4][1]); w4.y = cvt2(st[2 * k4][2], st[2 * k4][3]); w4.z = cvt2(st[2 * k4 + 1][0], st[2 * k4 + 1][1]); w4.w = cvt2(st[2 * k4 + 1][2], st[2 * k4 + 1][3]);
                    sb[k4] = __builtin_bit_cast(bf16x8, w4); }
                unsigned short* orow = Op + row0 + (size_t)(64 * c + 4 * fg) * RD + 16 * wv + fr;
#pragma unroll
                for (int mt = 0; mt < 4; ++mt) {
                    f32x4 acc = {0.f, 0.f, 0.f, 0.f};
#pragma unroll
                    for (int kk = 0; kk < 2; ++kk) if (kk <= (mt >> 1))
                        acc = __builtin_amdgcn_mfma_f32_16x16x32_bf16(*(const REC_LAS bf16x8*)(lds + OFF_AM + (16 * mt + fr) * TP + kk * 64 + fg * 16), vb[kk], acc, 0, 0, 0);
#pragma unroll
                    for (int k4 = 0; k4 < 4; ++k4) {
                        const REC_LAS unsigned char* qa = lds + (16 * mt + fr) * QP + k4 * 64 + fg * 8;
                        const u32x2 lo2 = *(const REC_LAS u32x2*)qa, hi2 = *(const REC_LAS u32x2*)(qa + 32);
                        const u32x4 w4 = {lo2.x, lo2.y, hi2.x, hi2.y};
                        acc = __builtin_amdgcn_mfma_f32_16x16x32_bf16(__builtin_bit_cast(bf16x8, w4), sb[k4], acc, 0, 0, 0);
                    }
#pragma unroll
                    for (int e = 0; e < 4; ++e) orow[(size_t)(16 * mt + e) * RD] = (unsigned short)(cvt2(acc[e], 0.f) & 0xffffu);
                }
            }
#pragma unroll
            for (int kt = 0; kt < 8; ++kt) {
                const f32x4 dl4 = *(const REC_LAS f32x4*)(lds + OFF_DL + (16 * kt + 4 * fg) * 4);
                st[kt] = st[kt] * dl4;
#pragma unroll
                for (int kk = 0; kk < 2; ++kk)
                    st[kt] = __builtin_amdgcn_mfma_f32_16x16x32_bf16(*(const REC_LAS bf16x8*)(lds + OFF_KHT + (16 * kt + fr) * TP + kk * 64 + fg * 16), vb[kk], st[kt], 0, 0, 0);
            }
        }
        if (!OUT) {
            float* U = Ug + ((size_t)u << 14);
#pragma unroll
            for (int kt = 0; kt < 8; ++kt)
#pragma unroll
                for (int e = 0; e < 4; ++e) U[(16 * kt + 4 * fg + e) * 128 + 16 * wv + fr] = st[kt][e];
            if (wv == 0) *(f32x2*)(Dg + u * 128 + 2 * lane) = (f32x2){ex2(dsum[0]), ex2(dsum[1])};
        }
        __syncthreads();
    }
}
#undef REC_LAS
}
#define GAS __attribute__((address_space(1)))
#define LAS __attribute__((address_space(3)))
typedef unsigned short bf16;
typedef unsigned v4u __attribute__((ext_vector_type(4)));
typedef float f32x4 __attribute__((ext_vector_type(4)));
typedef short bf16x8 __attribute__((ext_vector_type(8)));
typedef GAS unsigned gu32;
typedef GAS unsigned long long gu64;
#define RLX_AGENT __ATOMIC_RELAXED, __HIP_MEMORY_SCOPE_AGENT
#define LDS_WAIT() asm volatile("s_waitcnt lgkmcnt(0)" ::: "memory")
#define VM_WAIT() asm volatile("s_waitcnt vmcnt(0)" ::: "memory")
__device__ __forceinline__ unsigned long long rt() { return __builtin_amdgcn_s_memrealtime(); }
__device__ __forceinline__ unsigned f2bf(float f) { unsigned u = __builtin_bit_cast(unsigned, f); return (u + 0x7fffu + ((u >> 16) & 1u)) >> 16; }
__device__ __forceinline__ unsigned pk2(float lo, float hi) { return f2bf(lo) | (f2bf(hi) << 16); }
#define XB_TMO      128
#define XB_XCNT(j)  (256  + 64 * (j))
#define XB_XSUB(j)  (1280 + 64 * (j))
#define XB_XGEN(j)  (2304 + 64 * (j))
#define XB_TOP      3328
#define XB_TOPGEN   3392
#define XCD_BAR_WORDS 3456
#define XB_SPIN_CAP (1u << 18)

__device__ __forceinline__ unsigned xb_ld(unsigned* p)              { return __hip_atomic_load(p, __ATOMIC_RELAXED, __HIP_MEMORY_SCOPE_AGENT); }
__device__ __forceinline__ unsigned xb_add(unsigned* p, unsigned v) { return __hip_atomic_fetch_add(p, v, __ATOMIC_RELAXED, __HIP_MEMORY_SCOPE_AGENT); }
__device__ __forceinline__ unsigned xb_xcc_id() { return (unsigned)__builtin_amdgcn_s_getreg((3 << 11) | 20) & 0xFu; }
#define XB_SPIN(cond, bar) do { unsigned _sp = 0; while (cond) { __builtin_amdgcn_s_sleep(1); \
    if ((++_sp & 255u) == 0u) { if (xb_ld(&(bar)[XB_TMO])) break; if (_sp > XB_SPIN_CAP) { atomicAdd(&(bar)[XB_TMO], 1u); break; } } } } while (0)

struct XcdBarrier {
    unsigned* bar; unsigned x;
    volatile LAS unsigned* st;
};

__device__ __forceinline__ XcdBarrier xcd_barrier_post(unsigned* bar, volatile LAS unsigned* st) {
    XcdBarrier b; b.bar = bar; b.x = xb_xcc_id(); b.st = st;
    if (threadIdx.x == 0) (void)xb_add(&bar[XB_XCNT(b.x)], 1u);
    return b;
}
__device__ __forceinline__ void xcd_barrier_complete(unsigned* bar, unsigned x, unsigned& nloc, unsigned& nx) {
    const unsigned G = gridDim.x * gridDim.y * gridDim.z;
    unsigned sum, cnt, mine, sp = 0u;
    for (;;) {
        sum = 0u; cnt = 0u; mine = 0u;
#pragma unroll
        for (unsigned j = 0; j < 16; ++j) { const unsigned c = xb_ld(&bar[XB_XCNT(j)]); sum += c; cnt += (c > 0u) ? 1u : 0u; mine = (j == x) ? c : mine; }
        if (sum == G) break;
        __builtin_amdgcn_s_sleep(1);
        if ((++sp & 255u) == 0u) { if (xb_ld(&bar[XB_TMO])) break; if (sp > XB_SPIN_CAP) { atomicAdd(&bar[XB_TMO], 1u); break; } }
    }
    nloc = mine > 0u ? mine : 1u; nx = cnt > 0u ? cnt : 1u;
}

__device__ __forceinline__ void xcd_barrier(const XcdBarrier& b) {
    asm volatile("s_waitcnt vmcnt(0)" ::: "memory");
    __syncthreads();
    if (threadIdx.x == 0) {
        unsigned* bar = b.bar;
        __builtin_amdgcn_s_waitcnt(0);
        unsigned nloc = b.st[0], nx = b.st[1];
        if (nloc == 0u) { xcd_barrier_complete(bar, b.x, nloc, nx); b.st[0] = nloc; b.st[1] = nx; }
        const unsigned old = xb_add(&bar[XB_XSUB(b.x)], 1u);
        const unsigned gen = old / nloc;
        if (old + 1u == (gen + 1u) * nloc) {
            __builtin_amdgcn_fence(__ATOMIC_RELEASE, "agent");
            asm volatile("s_waitcnt vmcnt(0)" ::: "memory");
            const unsigned og = xb_add(&bar[XB_TOP], 1u);
            const unsigned tg = og / nx;
            if (og + 1u == (tg + 1u) * nx) xb_add(&bar[XB_TOPGEN], 1u);
            else XB_SPIN(xb_ld(&bar[XB_TOPGEN]) == tg, bar);
            __builtin_amdgcn_fence(__ATOMIC_ACQUIRE, "agent");
            xb_add(&bar[XB_XGEN(b.x)], 1u);
            asm volatile("s_waitcnt vmcnt(0)" ::: "memory");
        } else {
            XB_SPIN(xb_ld(&bar[XB_XGEN(b.x)]) == gen, bar);
            __builtin_amdgcn_fence(__ATOMIC_ACQUIRE, "agent");
            asm volatile("s_waitcnt vmcnt(0)" ::: "memory");
        }
    }
    __syncthreads();
}
constexpr int NWAVES = 8;
#ifndef ONE_LAUNCH
#define ONE_LAUNCH 1
#endif
constexpr int BATCH = 4, T = 4096, D = 2048, H = 16, HD = 128;
constexpr int M = BATCH * T;
constexpr int NPA = 8192;
constexpr float EPS = 1e-6f;
constexpr size_t MiB = 1u << 20;
constexpr size_t WS_CTL = 0, CTL_ZERO_BYTES = 1 * MiB;
constexpr size_t WS_WINA = 2 * MiB;
constexpr size_t WS_WOUTA = 66 * MiB;
constexpr size_t WS_WKVQ = 82 * MiB;
constexpr size_t WS_WINB1 = 114 * MiB;
constexpr size_t WS_WOUTB = 130 * MiB;
constexpr size_t WS_XN = 146 * MiB;
constexpr size_t WS_PROJ = 210 * MiB;
constexpr size_t WS_FZ = 466 * MiB;
constexpr size_t WS_F = 467 * MiB;
constexpr size_t WS_U = 468 * MiB;
constexpr size_t WS_DG = 480 * MiB;
constexpr size_t WS_END = 481 * MiB;
constexpr size_t SLOT = (size_t)M * D;
constexpr int CW_TMO = 0, CW_CODE = 1;
constexpr int CW_BAR = 4096;
constexpr int CW_ATT = 16384;
constexpr int RING_OFF = 0, RING_BYTES = 131072;
constexpr int SCRATCH_BYTES = 139264;
constexpr int LDSCTL_OFF = SCRATCH_BYTES, MISC_OFF = LDSCTL_OFF + 320;
constexpr int LDS_BYTES = 147456;
static_assert(MISC_OFF + 128 <= LDS_BYTES, "LDS map");

struct Frame {
    LAS unsigned char* lds;
    volatile LAS unsigned* MISC;
    gu32* ctl;
    int tid, lane, wave;
    int vcu, G;
};
__device__ __forceinline__ void phase_tid(Frame& F) { int t = threadIdx.x; asm volatile("" : "+v"(t)); F.tid = t; F.lane = t & 63; F.wave = __builtin_amdgcn_readfirstlane(t >> 6); }

__device__ __forceinline__ float wave_sum(float v) {
#pragma unroll
    for (int o = 1; o < 64; o <<= 1) v += __shfl_xor(v, o);
    return v;
}
__device__ __forceinline__ float bf2f(unsigned short b) { return __uint_as_float((unsigned)b << 16); }
__device__ __forceinline__ float bflo(unsigned w) { return __uint_as_float(w << 16); }
__device__ __forceinline__ float bfhi(unsigned w) { return __uint_as_float(w & 0xffff0000u); }

__device__ __forceinline__ void p0_transpose_item(const float* W, int ldw, int ncols, const float* nw, bf16* WT, LAS float* scr, int item, int lane) {
    const int nblk = ncols / 32, kb = item / nblk, nb = item % nblk, k0 = 64 * kb, n0 = 32 * nb;
#pragma unroll 8
    for (int i = 0; i < 32; ++i) { const int kk = 2 * i + (lane >> 5); const float s = nw ? nw[k0 + kk] : 1.f; scr[kk * 33 + (lane & 31)] = W[(size_t)(k0 + kk) * ldw + n0 + (lane & 31)] * s; }
    LDS_WAIT(); asm volatile("" ::: "memory");
    const int c = lane & 7;
#pragma unroll
    for (int j = 0; j < 4; ++j) { const int n = (lane >> 3) + 8 * j; const LAS float* s = scr + (8 * c) * 33 + n;
        v4u o; o.x = pk2(s[0 * 33], s[1 * 33]); o.y = pk2(s[2 * 33], s[3 * 33]); o.z = pk2(s[4 * 33], s[5 * 33]); o.w = pk2(s[6 * 33], s[7 * 33]);
        *(GAS v4u*)(WT + (size_t)(n0 + n) * D + k0 + 8 * c) = o; }
    LDS_WAIT(); asm volatile("" ::: "memory");
}
__device__ __forceinline__ void norm_rows(Frame& F, const float* xin, bf16* xn) {
    const int gw = F.vcu * NWAVES + F.wave, NGW = F.G * NWAVES;
    for (int m = gw; m < M; m += NGW) {
        const GAS f32x4* xr = (const GAS f32x4*)(xin + (size_t)m * D) + F.lane;
        f32x4 v[8]; float s = 0.f;
#pragma unroll
        for (int j = 0; j < 8; ++j) { v[j] = xr[64 * j]; s += (v[j].x * v[j].x + v[j].y * v[j].y) + (v[j].z * v[j].z + v[j].w * v[j].w); }
        const float r = 1.0f / sqrtf(wave_sum(s) * (1.f / D) + EPS);
        GAS unsigned long long* o8 = (GAS unsigned long long*)(xn + (size_t)m * D) + F.lane;
#pragma unroll
        for (int j = 0; j < 8; ++j) o8[64 * j] = (unsigned long long)pk2(v[j].x * r, v[j].y * r) | ((unsigned long long)pk2(v[j].z * r, v[j].w * r) << 32);
    }
}
__device__ __forceinline__ void p0_prologue(Frame& F, const float* const* in, unsigned char* ws) {
    LAS float* scr = (LAS float*)(F.lds + RING_OFF + F.wave * 16384);
    const int gw = F.vcu * NWAVES + F.wave, NGW = F.G * NWAVES;
    constexpr int I_INA = 32 * 256, I_SQ = 32 * 64, I_4K = 32 * 128;
    constexpr int NITEMS = 2 * I_INA + 2 * I_SQ + 3 * I_4K + 2 * I_SQ;
    for (int it = gw; it < NITEMS; it += NGW) {
        int r = it;
        if (r < 2 * I_INA) { const int l = r / I_INA; r -= l * I_INA; p0_transpose_item(in[2] + (size_t)l * D * NPA, NPA, NPA, in[1] + l * D, (bf16*)(ws + WS_WINA) + (size_t)l * NPA * D, scr, r, F.lane); continue; } r -= 2 * I_INA;
        if (r < 2 * I_SQ) { const int l = r / I_SQ; r -= l * I_SQ; p0_transpose_item(in[5] + (size_t)l * D * D, D, D, nullptr, (bf16*)(ws + WS_WOUTA) + (size_t)l * D * D, scr, r, F.lane); continue; } r -= 2 * I_SQ;
        if (r < I_4K) { p0_transpose_item(in[7], 2 * D + H, 2 * D, in[6], (bf16*)(ws + WS_WKVQ), scr, r, F.lane); continue; } r -= I_4K;
        if (r < I_4K) { p0_transpose_item(in[11], 2 * D, 2 * D, in[10], (bf16*)(ws + WS_WKVQ) + (size_t)2 * D * D, scr, r, F.lane); continue; } r -= I_4K;
        if (r < I_4K) { p0_transpose_item(in[11] + (size_t)D * 2 * D, 2 * D, 2 * D, in[10] + D, (bf16*)(ws + WS_WINB1), scr, r, F.lane); continue; } r -= I_4K;
        { const int l = r / I_SQ; r -= l * I_SQ; p0_transpose_item(in[14] + (size_t)l * D * D, D, D, nullptr, (bf16*)(ws + WS_WOUTB) + (size_t)l * D * D, scr, r, F.lane); }
    }
    norm_rows(F, in[0], (bf16*)(ws + WS_XN));
}
__device__ __forceinline__ float sum16(float v) { v += __shfl_xor(v, 1); v += __shfl_xor(v, 2); v += __shfl_xor(v, 4); v += __shfl_xor(v, 8); return v; }
__device__ __forceinline__ void headnorm_rows(Frame& F, bf16* X, const float* w) {
    const int gw = F.vcu * NWAVES + F.wave, NGW = F.G * NWAVES;
    for (int m = gw; m < M; m += NGW) {
        GAS v4u* xr = (GAS v4u*)(X + (size_t)m * D) + F.lane;
#pragma unroll
        for (int j = 0; j < 4; ++j) {
            const v4u x = xr[64 * j]; float f[8] = {bflo(x.x), bfhi(x.x), bflo(x.y), bfhi(x.y), bflo(x.z), bfhi(x.z), bflo(x.w), bfhi(x.w)};
            float s = 0.f;
#pragma unroll
            for (int e = 0; e < 8; ++e) s += f[e] * f[e];
            const float r = 1.0f / sqrtf(sum16(s) * (1.f / HD) + EPS);
            const int d0 = (8 * F.lane) & 127;
            const f32x4 w0 = *(const f32x4*)(w + d0), w1 = *(const f32x4*)(w + d0 + 4);
            v4u o; o.x = pk2(f[0] * r * w0.x, f[1] * r * w0.y); o.y = pk2(f[2] * r * w0.z, f[3] * r * w0.w); o.z = pk2(f[4] * r * w1.x, f[5] * r * w1.y); o.w = pk2(f[6] * r * w1.z, f[7] * r * w1.w);
            xr[64 * j] = o;
        }
    }
}
__device__ __forceinline__ float silu_f(float g) { return g / (1.f + __expf(-g)); }
__device__ __forceinline__ void gatenorm_rows(Frame& F, bf16* O, const bf16* G, const float* w) {
    const int gw = F.vcu * NWAVES + F.wave, NGW = F.G * NWAVES;
    for (int m = gw; m < M; m += NGW) {
        GAS v4u* xr = (GAS v4u*)(O + (size_t)m * D) + F.lane; const GAS v4u* gr = (const GAS v4u*)(G + (size_t)m * D) + F.lane;
#pragma unroll
        for (int j = 0; j < 4; ++j) {
            const v4u x = xr[64 * j], g = gr[64 * j];
            float f[8] = {bflo(x.x), bfhi(x.x), bflo(x.y), bfhi(x.y), bflo(x.z), bfhi(x.z), bflo(x.w), bfhi(x.w)};
            const float q[8] = {bflo(g.x), bfhi(g.x), bflo(g.y), bfhi(g.y), bflo(g.z), bfhi(g.z), bflo(g.w), bfhi(g.w)};
            float s = 0.f;
#pragma unroll
            for (int e = 0; e < 8; ++e) s += f[e] * f[e];
            const float r = 1.0f / sqrtf(sum16(s) * (1.f / HD) + EPS);
            const int c0 = 8 * (F.lane + 64 * j);
            const f32x4 w0 = *(const f32x4*)(w + c0), w1 = *(const f32x4*)(w + c0 + 4);
            const float ww[8] = {w0.x, w0.y, w0.z, w0.w, w1.x, w1.y, w1.z, w1.w};
#pragma unroll
            for (int e = 0; e < 8; ++e) f[e] = f[e] * r * ww[e] * silu_f(q[e]);
            v4u o; o.x = pk2(f[0], f[1]); o.y = pk2(f[2], f[3]); o.z = pk2(f[4], f[5]); o.w = pk2(f[6], f[7]);
            xr[64 * j] = o;
        }
    }
}
__device__ __forceinline__ void fz_rows(Frame& F, const bf16* xn, const float* kvw, const float* kvnw, const float* fbias, float* fzls) {
    LAS float* wf = (LAS float*)(F.lds);
    for (int idx = F.tid; idx < D * 16; idx += NWAVES * 64) { const int k = idx >> 4, j = idx & 15; wf[k * 16 + (k >> 3) * 4 + j] = kvw[(size_t)k * (2 * D + H) + 2 * D + j] * kvnw[k]; }
    __syncthreads();
    const int gw = F.vcu * NWAVES + F.wave, NGW = F.G * NWAVES;
    for (int m = gw; m < M; m += NGW) {
        const GAS v4u* xr = (const GAS v4u*)(xn + (size_t)m * D) + F.lane;
        float acc[16];
#pragma unroll
        for (int j = 0; j < 16; ++j) acc[j] = 0.f;
#pragma unroll 1
        for (int jj = 0; jj < 4; ++jj) {
            const v4u x = xr[64 * jj]; const float f[8] = {bflo(x.x), bfhi(x.x), bflo(x.y), bfhi(x.y), bflo(x.z), bfhi(x.z), bflo(x.w), bfhi(x.w)};
            const int c = F.lane + 64 * jj;
#pragma unroll 2
            for (int e = 0; e < 8; ++e) { const LAS f32x4* wr = (const LAS f32x4*)(wf + (8 * c + e) * 16 + c * 4);
#pragma unroll
                for (int q = 0; q < 4; ++q) { const f32x4 w4 = wr[q]; acc[4 * q + 0] += f[e] * w4.x; acc[4 * q + 1] += f[e] * w4.y; acc[4 * q + 2] += f[e] * w4.z; acc[4 * q + 3] += f[e] * w4.w; } }
        }
        float mine = 0.f;
#pragma unroll
        for (int j = 0; j < 16; ++j) { const float s = wave_sum(acc[j]); if (F.lane == j) mine = s; }
        if (F.lane < 16) { const float z = mine + fbias[F.lane]; fzls[(size_t)m * 16 + F.lane] = fminf(z, 0.f) - log1pf(__expf(-fabsf(z))); }
    }
    __syncthreads();
}
__device__ __forceinline__ void fscan(Frame& F, const float* fzls, float* Fo) {
    LAS float* wt = (LAS float*)(F.lds);
    for (int u = blockIdx.x; u < BATCH * H; u += F.G) {
        const int b = u / H, h = u % H, t0 = F.tid * 8;
        float v[8];
#pragma unroll
        for (int e = 0; e < 8; ++e) v[e] = fzls[(size_t)(b * T + t0 + e) * 16 + h];
#pragma unroll
        for (int e = 1; e < 8; ++e) v[e] += v[e - 1];
        float incl = v[7];
#pragma unroll
        for (int o = 1; o < 64; o <<= 1) { const float n = __shfl_up(incl, o); if (F.lane >= o) incl += n; }
        if (F.lane == 63) wt[F.wave] = incl;
        __syncthreads();
        float base = incl - v[7];
        for (int w = 0; w < F.wave; ++w) base += wt[w];
#pragma unroll
        for (int e = 0; e < 8; ++e) Fo[(size_t)u * T + t0 + e] = -(v[e] + base) * fox::INVS;
        __syncthreads();
    }
}
__device__ __forceinline__ fox::BlockRef attn_ref(int L, const bf16* Q, const bf16* K, const bf16* V, bf16* O, const float* Fc, float TH) {
    const int bh = L & 63, qb = 15 - (L >> 6), b = bh / H, h = bh % H;
    fox::BlockRef r; const size_t base = (size_t)b * T * D + h * HD;
    r.Q = (const fox::bf16*)Q + base + (size_t)qb * 256 * D; r.O = (fox::bf16*)O + base + (size_t)qb * 256 * D; r.K = (const fox::bf16*)K + base; r.V = (const fox::bf16*)V + base;
    r.F = Fc + (size_t)bh * T; r.P0 = qb * 256; r.jlo = fox::fox_jlo(r.F, r.P0, TH); return r;
}
__device__ __forceinline__ float attn_threshold(Frame& F, const float* wq, const float* wk) {
    float a = fmaxf(fabsf(wq[F.lane]), fabsf(wq[F.lane + 64])), c = fmaxf(fabsf(wk[F.lane]), fabsf(wk[F.lane + 64]));
#pragma unroll
    for (int o = 1; o < 64; o <<= 1) { a = fmaxf(a, __shfl_xor(a, o)); c = fmaxf(c, __shfl_xor(c, o)); }
    return 2.f * (128.f * 1.02f * a * c) + 152.f / (1.4426950408889634f * fox::SCALE);
}
__device__ __forceinline__ void attn_phase(Frame& F, char* lds, const bf16* Q, const bf16* K, const bf16* V, bf16* O, const float* Fc, gu32* ctr, float TH) {
    constexpr int total = BATCH * H * 16;
    volatile LAS int* tk = (volatile LAS int*)(F.lds + 69632);
    if (F.tid == 0) { tk[0] = (int)__hip_atomic_fetch_add(ctr, 1u, RLX_AGENT); tk[1] = (int)__hip_atomic_fetch_add(ctr, 1u, RLX_AGENT); }
    __syncthreads();
    int Lc = tk[0], Ln = tk[1];
    if (Lc >= total) return;
    fox::BlockRef cur = attn_ref(Lc, Q, K, V, O, Fc, TH);
    fox::Seam S;
    fox::causal_prime(cur, lds, S);
    for (int i = 0;; ++i) {
        if (F.tid == 0) tk[2 + (i & 1)] = (int)__hip_atomic_fetch_add(ctr, 1u, RLX_AGENT);
        const bool has_next = Ln < total;
        const fox::BlockRef nxt = has_next ? attn_ref(Ln, Q, K, V, O, Fc, TH) : cur;
        fox::causal_block(cur, nxt, lds, S);
        if (!has_next) break;
        const int L2 = tk[2 + (i & 1)];
        cur = nxt; Lc = Ln; Ln = L2;
    }
}

constexpr int NPHASE = 29;
__host__ __device__ constexpr bool phase_live(int id) {
    if (id == 0) return true;
    const int L = (id - 1) / 7, s = (id - 1) % 7;
    if (s == 1) return L >= 2;
    if (s == 2) return L <= 2;
    if (s == 6) return L < 3;
    return true;
}
struct Args { const float* in[15]; float* out; unsigned char* ws; int ph_lo, ph_hi; };
__global__ void __launch_bounds__(NWAVES * 64, 2) fwd_kernel(Args args) {
    extern __shared__ __attribute__((aligned(16))) unsigned char lds[];
    Frame F;
    F.lds = (LAS unsigned char*)lds;
    F.MISC = (volatile LAS unsigned*)(F.lds + MISC_OFF);
    phase_tid(F);
    F.G = gridDim.x; { const int bx = blockIdx.x; F.vcu = (F.G % 8 == 0) ? (bx % 8) * (F.G / 8) + bx / 8 : bx; }
    unsigned char* ws = args.ws;
    F.ctl = (gu32*)(ws + WS_CTL);
    for (int u = F.tid; u < (LDS_BYTES - LDSCTL_OFF) / 4; u += NWAVES * 64) ((LAS unsigned*)(F.lds + LDSCTL_OFF))[u] = 0u;
    __syncthreads();
#if ONE_LAUNCH
    XcdBarrier bar = xcd_barrier_post((unsigned*)(F.ctl + CW_BAR), F.MISC + 8);
#define GRID_BAR() xcd_barrier(bar)
#else
#define GRID_BAR() do {} while (0)
#endif
    const int lo = args.ph_lo, hi = args.ph_hi;
#define IN(k) (lo <= (k) && (k) < hi)
#define SEAM(k) do { if ((k) + 1 < hi) GRID_BAR(); } while (0)
    const float* const* in = args.in;
    bf16* XN = (bf16*)(ws + WS_XN); bf16* PROJ = (bf16*)(ws + WS_PROJ);
    float* FZ = (float*)(ws + WS_FZ); float* FC = (float*)(ws + WS_F);

    #ifndef NO_P0
    if (IN(0)) { phase_tid(F); p0_prologue(F, in, ws); SEAM(0); }
#endif

#pragma unroll 1
    for (int L = 0; L < 4; ++L) {
        const int pb = 1 + 7 * L; const bool isA = L < 2; const int j = L & 1;
        if (IN(pb + 0)) {
            const bf16* Bt = isA ? (const bf16*)(ws + WS_WINA) + (size_t)j * NPA * D : (L == 2 ? (const bf16*)(ws + WS_WKVQ) : (const bf16*)(ws + WS_WINB1));
            const int N = (L == 3) ? 2 * D : NPA;
            bf16* outp = (L == 3) ? PROJ + 2 * SLOT : PROJ;
            pg8::Gemm g{XN, Bt, M, N, D}; pg8::StaticOrder S; S.init(M, N, F.G, (int)blockIdx.x);
            pg8::EpiBf16<0> E{outp, D, nullptr, D, SLOT, 1.f};
#ifndef NO_G1
            pg8::gemm_phase<pg8::EpiBf16<0>, pg8::StaticOrder, true, true>(F.lds + RING_OFF, g, S, E);
#ifdef DUP_GIN
            pg8::gemm_phase<pg8::EpiBf16<0>, pg8::StaticOrder, true, true>(F.lds + RING_OFF, g, S, E);
#endif
#endif
            SEAM(pb + 0);
        }
        if (IN(pb + 1) && !isA) { phase_tid(F);
#ifndef NO_FZ
            if (L == 2) { fz_rows(F, XN, in[7], in[6], in[8], FZ); headnorm_rows(F, PROJ, in[9]); }
#endif
            headnorm_rows(F, PROJ + 2 * SLOT, in[12] + j * HD);
            SEAM(pb + 1);
        }
        if (IN(pb + 2) && L == 2) { phase_tid(F); fscan(F, FZ, FC); SEAM(pb + 2); }
        if (IN(pb + 2) && isA) {
            rec::run<false>(F.lds + RING_OFF, F.G, PROJ, PROJ + SLOT, PROJ + 2 * SLOT, XN, in[3], L, (float*)(ws + WS_U), (float*)(ws + WS_DG));
#ifdef DUP_REC
            rec::run<false>(F.lds + RING_OFF, F.G, PROJ, PROJ + SLOT, PROJ + 2 * SLOT, XN, in[3], L, (float*)(ws + WS_U), (float*)(ws + WS_DG));
#endif
            SEAM(pb + 2);
        }
        if (IN(pb + 3)) { phase_tid(F);
#ifndef NO_REC
            if (isA) rec::run<true>(F.lds + RING_OFF, F.G, PROJ, PROJ + SLOT, PROJ + 2 * SLOT, XN, in[3], L, (float*)(ws + WS_U), (float*)(ws + WS_DG));
#ifdef DUP_REC
            if (isA) rec::run<true>(F.lds + RING_OFF, F.G, PROJ, PROJ + SLOT, PROJ + 2 * SLOT, XN, in[3], L, (float*)(ws + WS_U), (float*)(ws + WS_DG));
#endif
#endif
#ifndef NO_ATT
            if (!isA) attn_phase(F, (char*)lds + RING_OFF, PROJ + 2 * SLOT, PROJ, PROJ + SLOT, XN, FC, F.ctl + CW_ATT + 64 * j, attn_threshold(F, in[12] + j * HD, in[9]));
#ifdef DUP_ATT
            if (!isA) { __syncthreads(); attn_phase(F, (char*)lds + RING_OFF, PROJ + 2 * SLOT, PROJ, PROJ + SLOT, XN, FC, F.ctl + CW_ATT + 64 * (j + 2), attn_threshold(F, in[12] + j * HD, in[9])); }
#endif
#endif
            SEAM(pb + 3);
        }
        if (IN(pb + 4)) { phase_tid(F); gatenorm_rows(F, XN, PROJ + 3 * SLOT, (isA ? in[4] : in[13]) + j * D); SEAM(pb + 4); }
        if (IN(pb + 5)) {
            const bf16* Bt = (const bf16*)(ws + (isA ? WS_WOUTA : WS_WOUTB)) + (size_t)j * D * D;
            pg8::Gemm g{XN, Bt, M, D, D}; pg8::StaticOrder S; S.init(M, D, F.G, (int)blockIdx.x);
            pg8::EpiRes E{L == 0 ? in[0] : args.out, args.out, D};
#ifndef NO_G2
            pg8::gemm_phase<pg8::EpiRes, pg8::StaticOrder, true, true>(F.lds + RING_OFF, g, S, E);
#endif
            SEAM(pb + 5);
        }
        if (IN(pb + 6) && L < 3) { phase_tid(F); norm_rows(F, args.out, XN);
#ifdef DUP_EW
            norm_rows(F, args.out, XN); norm_rows(F, args.out, XN); norm_rows(F, args.out, XN);
#endif
            SEAM(pb + 6); }
    }
#undef IN
#undef SEAM
}

extern "C" void kernel_launch(void* const* d_in, const int* in_sizes, int n_in, void* d_out, int out_size, void* d_ws, size_t ws_size, hipStream_t stream) {
    static int grid = 0;
    if (grid == 0) {
        if (n_in != 15 || in_sizes[0] != M * D || out_size != M * D || ws_size < WS_END) { fprintf(stderr, "kernel_launch: unexpected shapes (n_in %d, in0 %d, out %d, ws %zu)\n", n_in, n_in > 0 ? in_sizes[0] : -1, out_size, ws_size); grid = -1; return; }
        int dev = 0, cus = 0;
        if (hipGetDevice(&dev) != hipSuccess || hipDeviceGetAttribute(&cus, hipDeviceAttributeMultiprocessorCount, dev) != hipSuccess) { grid = -1; return; }
        if (hipFuncSetAttribute((const void*)fwd_kernel, hipFuncAttributeMaxDynamicSharedMemorySize, LDS_BYTES) != hipSuccess) { fprintf(stderr, "kernel_launch: hipFuncSetAttribute failed\n"); grid = -1; return; }
        int per_cu = 0;
        if (hipOccupancyMaxActiveBlocksPerMultiprocessor(&per_cu, (const void*)fwd_kernel, NWAVES * 64, LDS_BYTES) != hipSuccess || per_cu < 1) fprintf(stderr, "kernel_launch: occupancy query says %d\n", per_cu);
        (void)hipGetLastError();
        grid = cus;
    }
    if (grid < 0) return;
    (void)hipMemsetAsync((char*)d_ws + WS_CTL, 0, CTL_ZERO_BYTES, stream);
    Args a{};
    for (int i = 0; i < 15; ++i) a.in[i] = (const float*)d_in[i];
    a.out = (float*)d_out; a.ws = (unsigned char*)d_ws;
#if ONE_LAUNCH
    a.ph_lo = 0; a.ph_hi = NPHASE;
    hipLaunchKernelGGL(fwd_kernel, dim3(grid), dim3(NWAVES * 64), LDS_BYTES, stream, a);
#else
    for (int p = 0; p < NPHASE; ++p) { if (!phase_live(p)) continue; a.ph_lo = p; a.ph_hi = p + 1; hipLaunchKernelGGL(fwd_kernel, dim3(grid), dim3(NWAVES * 64), LDS_BYTES, stream, a); }
#endif
}
```

```cpp
#include <hip/hip_runtime.h>
#include <hip/hip_bf16.h>
#include <cstdio>
#include <cstdint>
#include <cmath>
namespace pg8 {
#define PG8_LAS __attribute__((address_space(3)))
typedef unsigned short bf16_t;
typedef short bf16x8 __attribute__((ext_vector_type(8)));
typedef float f32x4 __attribute__((ext_vector_type(4)));
typedef unsigned u32x4 __attribute__((ext_vector_type(4)));
constexpr int BM = 256, BK = 64, HALF = 128, HTB = HALF * BK * 2  , STAGE_BYTES = 8 * HTB, NXCD = 8, WGM = 8;

__host__ __device__ __forceinline__ int lds_byte(int r, int c) { const int st = (r >> 4) * 2 + (c >> 5), rr = r & 15, cc = c & 31, ob = rr * 64 + cc * 2; return st * 1024 + (ob ^ (((ob >> 9) & 1) << 5)); }
__host__ __device__ __forceinline__ void stage_rc(int b, int& R, int& C) { const int st = b / 1024, sb = b % 1024, swz = sb ^ (((sb >> 9) & 1) << 5); R = (st >> 1) * 16 + swz / 64; C = (st & 1) * 32 + (swz % 64) / 2; }
__host__ __device__ __forceinline__ int perm32(int rho) { const int n = rho >> 4, i = rho & 15; return 8 * (i >> 2) + 4 * n + (i & 3); }

struct Unit { int pm, pn; };
struct Gemm { const bf16_t* A; const bf16_t* Bt; int M, N, K; };

struct StaticOrder {
    int nM, nN, nwg, G, c;
    __host__ __device__ void init(int M, int N, int G_, int c_) { nM = M / BM; nN = N / BM; nwg = nM * nN; G = G_; c = c_; }
    __host__ __device__ bool next(int i, Unit& u) const {
        const long L = (long)i * G + c; if (L >= nwg) return false;
        int wgid = (int)L; { const int q = nwg / NXCD, r = nwg % NXCD, xcd = wgid % NXCD, off = wgid / NXCD; wgid = (xcd < r ? xcd * (q + 1) : r * (q + 1) + (xcd - r) * q) + off; }
        const int nig = WGM * nN, gid = wgid / nig, fm = gid * WGM, gsz = (nM - fm) < WGM ? (nM - fm) : WGM;
        u.pm = fm + ((wgid % nig) % gsz); u.pn = (wgid % nig) / gsz; return true;
    }
    __device__ __forceinline__ void a_ready(const Unit&) const {}
    __device__ __forceinline__ void done(const Unit&) const {}
};

__device__ __forceinline__ unsigned cvt_pk_bf16(float lo, float hi) { unsigned r; asm volatile("v_cvt_pk_bf16_f32 %0, %1, %2" : "=v"(r) : "v"(lo), "v"(hi)); return r; }
typedef float f32x2 __attribute__((ext_vector_type(2)));
__device__ __forceinline__ f32x2 gelu_pk(f32x2 v) {
    const f32x2 av = __builtin_elementwise_abs(v), d = av * 0.2316418882f + 1.0f;
    f32x2 t; t.x = __builtin_amdgcn_rcpf(d.x); t.y = __builtin_amdgcn_rcpf(d.y);
    f32x2 q = t * 0.5307027145f + (-0.7265760135f); q = q * t + 0.7107068705f; q = q * t + (-0.142248368f); q = q * t + 0.127414796f; q = q * t;
    const f32x2 s = (v * v) * (-0.72134752044f);
    f32x2 e; e.x = __builtin_amdgcn_exp2f(s.x); e.y = __builtin_amdgcn_exp2f(s.y);
    const f32x2 m = v * (q * e), r = v - m;
    f32x2 o; o.x = v.x < 0.f ? m.x : r.x; o.y = v.y < 0.f ? m.y : r.y; return o;
}

template <int ACT  > struct EpiBf16 {
    static constexpr bool PERM = true, AFTER_DRAIN = false; static_assert(ACT == 0 || ACT == 1, "EpiBf16: ACT is 0 (none) or 1 (gelu_pk)");
    bf16_t* O; int ldc; const float* bias; int split_cols; size_t split_stride; float scale0;
    __device__ __forceinline__ void operator()(const f32x4 (&acc)[2][2][4][2], const Unit& u, int wr, int wc, int fr, int fq) const {
        const int row0 = u.pm * BM + wr * 64 + fr; int colt = u.pn * BM; bf16_t* base = O;
        float sc = 1.f; if (split_cols) { const int t = colt / split_cols; base += (size_t)t * split_stride; colt -= t * split_cols; if (t == 0) sc = scale0; }
        const int col0 = colt + wc * 32 + 8 * fq, bcol0 = u.pn * BM + wc * 32 + 8 * fq;
        f32x4 bv[2][2];
#pragma unroll
        for (int bj = 0; bj < 2; ++bj)
#pragma unroll
            for (int n = 0; n < 2; ++n) bv[bj][n] = bias ? *(const f32x4*)(bias + bcol0 + bj * HALF + 4 * n) : (f32x4){0.f, 0.f, 0.f, 0.f};
#pragma unroll
        for (int ai = 0; ai < 2; ++ai)
#pragma unroll
            for (int m = 0; m < 4; ++m) { bf16_t* rowp = base + (size_t)(row0 + ai * HALF + m * 16) * ldc + col0;
#pragma unroll
                for (int bj = 0; bj < 2; ++bj) { f32x4 v0 = acc[ai][bj][m][0] + bv[bj][0], v1 = acc[ai][bj][m][1] + bv[bj][1];
                    if (ACT == 1) { f32x2 a = gelu_pk((f32x2){v0[0], v0[1]}), b = gelu_pk((f32x2){v0[2], v0[3]}), c = gelu_pk((f32x2){v1[0], v1[1]}), d = gelu_pk((f32x2){v1[2], v1[3]});
                        v0 = (f32x4){a.x, a.y, b.x, b.y}; v1 = (f32x4){c.x, c.y, d.x, d.y}; }
                    v0 = v0 * sc; v1 = v1 * sc; u32x4 w; w.x = cvt_pk_bf16(v0[0], v0[1]); w.y = cvt_pk_bf16(v0[2], v0[3]); w.z = cvt_pk_bf16(v1[0], v1[1]); w.w = cvt_pk_bf16(v1[2], v1[3]);
                    *(u32x4*)(rowp + bj * HALF) = w; } }
    }
};
struct EpiRes {
    static constexpr bool PERM = false, AFTER_DRAIN = false;
    const float* res; float* out; int ldc;
    __device__ __forceinline__ void operator()(const f32x4 (&acc)[2][2][4][2], const Unit& u, int wr, int wc, int fr, int fq) const {
        const int row0 = u.pm * BM + wr * 64 + fr, col0 = u.pn * BM + wc * 32 + 4 * fq;
#pragma unroll
        for (int ai = 0; ai < 2; ++ai)
#pragma unroll
            for (int m = 0; m < 4; ++m) { const size_t off = (size_t)(row0 + ai * HALF + m * 16) * ldc + col0;
                f32x4 r[2][2];
#pragma unroll
                for (int bj = 0; bj < 2; ++bj)
#pragma unroll
                    for (int n = 0; n < 2; ++n) r[bj][n] = *(const f32x4*)(res + off + bj * HALF + n * 16);
#pragma unroll
                for (int bj = 0; bj < 2; ++bj)
#pragma unroll
                    for (int n = 0; n < 2; ++n) *(f32x4*)(out + off + bj * HALF + n * 16) = r[bj][n] + acc[ai][bj][m][n]; }
    }
};
struct EpiBf16R {
    static constexpr bool PERM = true, AFTER_DRAIN = false;
    bf16_t* O; int ldc; int split_cols; size_t split_stride; const float* ss; float inv_k, eps;
    __device__ __forceinline__ void operator()(const f32x4 (&acc)[2][2][4][2], const Unit& u, int wr, int wc, int fr, int fq) const {
        const int row0 = u.pm * BM + wr * 64 + fr; int colt = u.pn * BM; bf16_t* base = O;
        { const int t = colt / split_cols; base += (size_t)t * split_stride; colt -= t * split_cols; }
        const int col0 = colt + wc * 32 + 8 * fq;
        float rs[2][4];
#pragma unroll
        for (int ai = 0; ai < 2; ++ai)
#pragma unroll
            for (int m = 0; m < 4; ++m) rs[ai][m] = ss[row0 + ai * HALF + m * 16];
#pragma unroll
        for (int ai = 0; ai < 2; ++ai)
#pragma unroll
            for (int m = 0; m < 4; ++m) { bf16_t* rowp = base + (size_t)(row0 + ai * HALF + m * 16) * ldc + col0;
                const float sc = __builtin_amdgcn_rsqf(rs[ai][m] * inv_k + eps);
#pragma unroll
                for (int bj = 0; bj < 2; ++bj) { const f32x4 v0 = acc[ai][bj][m][0] * sc, v1 = acc[ai][bj][m][1] * sc;
                    u32x4 w; w.x = cvt_pk_bf16(v0[0], v0[1]); w.y = cvt_pk_bf16(v0[2], v0[3]); w.z = cvt_pk_bf16(v1[0], v1[1]); w.w = cvt_pk_bf16(v1[2], v1[3]);
                    *(u32x4*)(rowp + bj * HALF) = w; } }
    }
};
struct EpiResX {
    static constexpr bool PERM = false, AFTER_DRAIN = false;
    const float* res; float* out; int ldc; bf16_t* xb; float* ssn;
    __device__ __forceinline__ void operator()(const f32x4 (&acc)[2][2][4][2], const Unit& u, int wr, int wc, int fr, int fq) const {
        typedef unsigned u32x2 __attribute__((ext_vector_type(2)));
        const int row0 = u.pm * BM + wr * 64 + fr, col0 = u.pn * BM + wc * 32 + 4 * fq;
#pragma unroll
        for (int ai = 0; ai < 2; ++ai)
#pragma unroll
            for (int m = 0; m < 4; ++m) { const int row = row0 + ai * HALF + m * 16; const size_t off = (size_t)row * ldc + col0;
                float s = 0.f;
#pragma unroll
                for (int bj = 0; bj < 2; ++bj) { const f32x4 r0 = *(const f32x4*)(res + off + bj * HALF), r1 = *(const f32x4*)(res + off + bj * HALF + 16);
#pragma unroll
                    for (int n = 0; n < 2; ++n) { const f32x4 o = (n ? r1 : r0) + acc[ai][bj][m][n]; *(f32x4*)(out + off + bj * HALF + n * 16) = o;
                        if (xb) { u32x2 w; w.x = cvt_pk_bf16(o[0], o[1]); w.y = cvt_pk_bf16(o[2], o[3]); *(u32x2*)(xb + off + bj * HALF + n * 16) = w;
                                  s += (o[0] * o[0] + o[1] * o[1]) + (o[2] * o[2] + o[3] * o[3]); } } }
                if (xb) { s += __shfl_xor(s, 16); s += __shfl_xor(s, 32); if (fq == 0) atomicAdd(ssn + row, s); } }
    }
};
struct EpiNull {
    static constexpr bool PERM = true, AFTER_DRAIN = false;
    __device__ __forceinline__ void operator()(const f32x4 (&acc)[2][2][4][2], const Unit& u, int wr, int wc, int fr, int fq) const {
#pragma unroll
        for (int ai = 0; ai < 2; ++ai)
#pragma unroll
            for (int bj = 0; bj < 2; ++bj)
#pragma unroll
                for (int m = 0; m < 4; ++m)
#pragma unroll
                    for (int n = 0; n < 2; ++n) asm volatile("" :: "v"(acc[ai][bj][m][n]));
    }
};
struct RepeatOrder {
    int n, c;
    __device__ bool next(int i, Unit& u) const { if (i >= n) return false; u.pm = c & 1; u.pn = 0; return true; }
    __device__ __forceinline__ void a_ready(const Unit&) const {}
    __device__ __forceinline__ void done(const Unit&) const {}
};
template <class Epi, class Sched, bool ALIGN_EPI = false, bool SP2 = false, bool BLK = false>
__device__ __forceinline__ void gemm_phase(PG8_LAS unsigned char* lds, const Gemm g, const Sched& S, const Epi& E) {
    int tid_ = threadIdx.x; asm volatile("" : "+v"(tid_));
    const int tid = tid_, wid = __builtin_amdgcn_readfirstlane(tid >> 6), lane = tid & 63, wr = wid >> 2, wc = wid & 3, fr = lane & 15, fq = lane >> 4;
    const int K = g.K, nt = K / BK;
    unsigned voffA[2], voffB[2];
#pragma unroll
    for (int i = 0; i < 2; ++i) { int R, C; stage_rc(tid * 16 + i * 8192, R, C); const int Rb = Epi::PERM ? ((R & ~31) + perm32(R & 31)) : R;
        voffA[i] = (unsigned)(R * (BLK ? BK : K) + C) * 2u; voffB[i] = (unsigned)(Rb * (BLK ? BK : K) + C) * 2u; }
    const size_t kstepA = BLK ? (size_t)g.M * BK * 2 : (size_t)(BK * 2), kstepB = BLK ? (size_t)g.N * BK * 2 : (size_t)(BK * 2);
    const size_t hstep = BLK ? (size_t)HALF * BK * 2 : (size_t)HALF * K * 2;
    const size_t tstep = 2 * hstep;
    const unsigned ldsw = (unsigned)wid * 1024u;
    const int aoff = lds_byte(wr * 64 + fr, fq * 8), boff = lds_byte(wc * 32 + fr, fq * 8);
#define PG8_SA(b, h) (((b) * 2 + (h)) * HTB)
#define PG8_SB(b, h) ((4 + (b) * 2 + (h)) * HTB)
#define PG8_STAGE(bufoff, gbase, voff) do { _Pragma("unroll") for (int _i = 0; _i < 2; ++_i) \
        __builtin_amdgcn_global_load_lds((const unsigned*)((const char*)(gbase) + (voff)[_i]), (PG8_LAS unsigned*)(lds + (bufoff) + ldsw + _i * 8192), 16, 0, 0); } while (0)
#define PG8_LDA(dst, b, h) do { _Pragma("unroll") for (int m = 0; m < 4; ++m) _Pragma("unroll") for (int k = 0; k < 2; ++k) dst[m][k] = *(const PG8_LAS bf16x8*)(lds + PG8_SA(b, h) + aoff + m * 2048 + k * 1024); } while (0)
#define PG8_LDB(dst, b, h) do { _Pragma("unroll") for (int n = 0; n < 2; ++n) _Pragma("unroll") for (int k = 0; k < 2; ++k) dst[n][k] = *(const PG8_LAS bf16x8*)(lds + PG8_SB(b, h) + boff + n * 2048 + k * 1024); } while (0)
#define PG8_MMA(ai, bj, At, Bt) do { __builtin_amdgcn_s_setprio(1); _Pragma("unroll") for (int m = 0; m < 4; ++m) _Pragma("unroll") for (int n = 0; n < 2; ++n) _Pragma("unroll") for (int k = 0; k < 2; ++k) \
        acc[ai][bj][m][n] = __builtin_amdgcn_mfma_f32_16x16x32_bf16(Bt[n][k], At[m][k], acc[ai][bj][m][n], 0, 0, 0); __builtin_amdgcn_s_setprio(0); } while (0)
#define PG8_WAIT_V(n) asm volatile("s_waitcnt vmcnt(" #n ")" ::: "memory")
#define PG8_WAIT_L(n) asm volatile("s_waitcnt lgkmcnt(" #n ")" ::: "memory")
#define PG8_BAR __builtin_amdgcn_s_barrier()
#define PG8_SCHED __builtin_amdgcn_sched_barrier(0)
    Unit cur, nxt; int ui = 0;
    if (!S.next(0, cur)) return;
    f32x4 acc[2][2][4][2];
#pragma unroll
    for (int a = 0; a < 2; ++a)
#pragma unroll
        for (int b = 0; b < 2; ++b)
#pragma unroll
            for (int m = 0; m < 4; ++m)
#pragma unroll
                for (int n = 0; n < 2; ++n) acc[a][b][m][n] = (f32x4){0.f, 0.f, 0.f, 0.f};
    bf16x8 At[4][2], B0[2][2], B1[2][2];
    const char* cA = (const char*)g.A + (size_t)cur.pm * tstep; const char* cB = (const char*)g.Bt + (size_t)cur.pn * tstep;
    S.a_ready(cur);
    if constexpr (SP2) {
        PG8_STAGE(PG8_SB(0, 0), cB, voffB); PG8_STAGE(PG8_SB(0, 1), cB + hstep, voffB); PG8_STAGE(PG8_SA(0, 0), cA, voffA); PG8_STAGE(PG8_SA(0, 1), cA + hstep, voffA);
        if (wr == 1) PG8_BAR;
        PG8_WAIT_V(2); PG8_BAR;
        PG8_STAGE(PG8_SB(1, 0), cB + kstepB, voffB); PG8_STAGE(PG8_SA(1, 0), cA + kstepA, voffA); PG8_STAGE(PG8_SB(1, 1), cB + hstep + kstepB, voffB);
        PG8_WAIT_V(6); PG8_BAR;
    } else {
        PG8_STAGE(PG8_SB(0, 0), cB, voffB); PG8_STAGE(PG8_SA(0, 0), cA, voffA); PG8_STAGE(PG8_SB(0, 1), cB + hstep, voffB); PG8_STAGE(PG8_SA(0, 1), cA + hstep, voffA);
        if (wr == 1) PG8_BAR;
        PG8_WAIT_V(4); PG8_BAR;
        PG8_STAGE(PG8_SB(1, 0), cB + kstepB, voffB); PG8_STAGE(PG8_SA(1, 0), cA + kstepA, voffA); PG8_STAGE(PG8_SB(1, 1), cB + hstep + kstepB, voffB);
        PG8_WAIT_V(6); PG8_BAR;
    }
    for (;;) {
        const bool has_next = S.next(ui + 1, nxt);
        const char* nA = has_next ? (const char*)g.A + (size_t)nxt.pm * tstep : cA; const char* nB = has_next ? (const char*)g.Bt + (size_t)nxt.pn * tstep : cB;
        for (int t = 0; t < nt; t += 2) {
            const bool last = (t == nt - 2);
            const char* a1 = cA + (size_t)(t + 1) * kstepA;
            const char* a2 = last ? nA : cA + (size_t)(t + 2) * kstepA; const char* b2 = last ? nB : cB + (size_t)(t + 2) * kstepB;
            const char* a3 = a2 + kstepA; const char* b3 = b2 + kstepB;
            if (last && has_next) S.a_ready(nxt);
            if constexpr (SP2) {
            PG8_LDB(B0, 0, 0); PG8_LDB(B1, 0, 1); PG8_SCHED; PG8_LDA(At, 0, 0); PG8_STAGE(PG8_SA(1, 1), a1 + hstep, voffA);
            PG8_WAIT_V(8); PG8_WAIT_L(0); PG8_BAR; PG8_MMA(0, 0, At, B0); PG8_MMA(0, 1, At, B1); PG8_BAR; PG8_SCHED;
            PG8_LDA(At, 0, 1); PG8_STAGE(PG8_SB(0, 0), b2, voffB); PG8_STAGE(PG8_SB(0, 1), b2 + hstep, voffB); PG8_STAGE(PG8_SA(0, 0), a2, voffA);
            PG8_WAIT_V(8); PG8_WAIT_L(0); PG8_BAR; PG8_MMA(1, 0, At, B0); PG8_MMA(1, 1, At, B1); PG8_BAR; PG8_SCHED;
            PG8_LDB(B0, 1, 0); PG8_LDB(B1, 1, 1); PG8_SCHED; PG8_LDA(At, 1, 0); PG8_STAGE(PG8_SA(0, 1), a2 + hstep, voffA);
            PG8_WAIT_V(8); PG8_WAIT_L(0); PG8_BAR; PG8_MMA(0, 0, At, B0); PG8_MMA(0, 1, At, B1); PG8_BAR; PG8_SCHED;
            PG8_LDA(At, 1, 1); PG8_STAGE(PG8_SB(1, 0), b3, voffB); PG8_STAGE(PG8_SB(1, 1), b3 + hstep, voffB); PG8_STAGE(PG8_SA(1, 0), a3, voffA);
            PG8_WAIT_V(8); PG8_WAIT_L(0); PG8_BAR; PG8_MMA(1, 0, At, B0); PG8_MMA(1, 1, At, B1); PG8_BAR; PG8_SCHED;
            } else {
            PG8_LDB(B0, 0, 0); PG8_SCHED; PG8_LDA(At, 0, 0); PG8_STAGE(PG8_SA(1, 1), a1 + hstep, voffA);
            PG8_WAIT_L(8); PG8_BAR; PG8_WAIT_L(0); PG8_MMA(0, 0, At, B0); PG8_BAR; PG8_SCHED;
            PG8_LDB(B1, 0, 1); PG8_STAGE(PG8_SB(0, 0), b2, voffB);
            PG8_BAR; PG8_WAIT_L(0); PG8_MMA(0, 1, At, B1); PG8_BAR;
            PG8_LDA(At, 0, 1); PG8_STAGE(PG8_SA(0, 0), a2, voffA);
            PG8_BAR; PG8_WAIT_L(0); PG8_MMA(1, 0, At, B0); PG8_BAR; PG8_SCHED;
            PG8_STAGE(PG8_SB(0, 1), b2 + hstep, voffB);
            PG8_WAIT_V(6); PG8_BAR; PG8_MMA(1, 1, At, B1); PG8_BAR;
            PG8_LDB(B0, 1, 0); PG8_SCHED; PG8_LDA(At, 1, 0); PG8_STAGE(PG8_SA(0, 1), a2 + hstep, voffA);
            PG8_WAIT_L(8); PG8_BAR; PG8_WAIT_L(0); PG8_MMA(0, 0, At, B0); PG8_BAR; PG8_SCHED;
            PG8_LDB(B1, 1, 1); PG8_STAGE(PG8_SB(1, 0), b3, voffB);
            PG8_BAR; PG8_WAIT_L(0); PG8_MMA(0, 1, At, B1); PG8_BAR;
            PG8_LDA(At, 1, 1); PG8_STAGE(PG8_SA(1, 0), a3, voffA);
            PG8_BAR; PG8_WAIT_L(0); PG8_MMA(1, 0, At, B0); PG8_BAR; PG8_SCHED;
            PG8_STAGE(PG8_SB(1, 1), b3 + hstep, voffB);
            PG8_WAIT_V(6); PG8_BAR; PG8_MMA(1, 1, At, B1); PG8_BAR;
            }
        }
        if constexpr (ALIGN_EPI) { if (wr == 0) PG8_BAR; }
        if constexpr (!Epi::AFTER_DRAIN) { E(acc, cur, wr, wc, fr, fq); S.done(cur); }
        if (!has_next) break;
#pragma unroll
        for (int a = 0; a < 2; ++a)
#pragma unroll
            for (int b = 0; b < 2; ++b)
#pragma unroll
                for (int m = 0; m < 4; ++m)
#pragma unroll
                    for (int n = 0; n < 2; ++n) acc[a][b][m][n] = (f32x4){0.f, 0.f, 0.f, 0.f};
        cur = nxt; cA = nA; cB = nB; ++ui;
        if constexpr (ALIGN_EPI) { if (wr == 1) PG8_BAR; }
    }
    PG8_WAIT_V(0);
    if constexpr (!ALIGN_EPI) { if (wr == 0) PG8_BAR; }
    PG8_BAR;
    if constexpr (Epi::AFTER_DRAIN) { E.fused(acc, cur, wr, wc, fr, fq, lds, wid, lane); S.done(cur); }
#undef PG8_SA
#undef PG8_SB
#undef PG8_STAGE
#undef PG8_LDA
#undef PG8_LDB
#undef PG8_MMA
#undef PG8_WAIT_V
#undef PG8_WAIT_L
#undef PG8_BAR
#undef PG8_SCHED
}
}
namespace fox {
constexpr int ALD = 2048;
constexpr int AD = 128;
constexpr float SCALE = 0.08838834764831845f;
constexpr float INVS = 11.313708498984761f;
constexpr float THR = 8.f;
constexpr int NW = 8, QBLK = 32, KVBLK = 64, QB = NW * QBLK;
constexpr int SHM_V = KVBLK * AD * 2, SHM_K = KVBLK * AD * 2;
constexpr int LDS_F = 2 * SHM_V + 2 * SHM_K + NW * 64 * 4;
constexpr int LDS_BYTES = LDS_F + 2 * 256;
constexpr int SO_PITCH = 264, SO_WAVE = 32 * SO_PITCH, LDS_SO = 71680;
constexpr float NEPS = 1e-6f;

using bf16 = __hip_bfloat16;
typedef short bf16x8 __attribute__((ext_vector_type(8)));
typedef short s16x4 __attribute__((ext_vector_type(4)));
typedef float f32x16 __attribute__((ext_vector_type(16)));
typedef float f32x4 __attribute__((ext_vector_type(4)));
typedef unsigned u32x4 __attribute__((ext_vector_type(4)));

#define KSWZ(row, colB) ((row) * 256 + ((colB) ^ (((row) & 7) << 4)))
#define SBAR() __builtin_amdgcn_sched_barrier(0)
__device__ __forceinline__ int v_st(int k, int c) { const int kk = (k & ~0xC) | ((k & 4) << 1) | ((k & 8) >> 1); return ((kk >> 3) * 4 + (c >> 5)) * 512 + ((kk & 7) * 32 + (c & 31)) * 2; }
__device__ __forceinline__ int v_rd_base(int lane) { return ((lane & 3) << 3) | (((lane >> 2) & 3) << 6) | (((lane >> 4) & 1) << 5) | (((lane >> 5) & 1) << 8); }
constexpr int v_rd_off(int d0, int ks, int half) { return d0 * 512 + ks * 4096 + half * 2048; }
__device__ __forceinline__ int crow(int r, int hi) { return (r & 3) + 8 * (r >> 2) + 4 * hi; }
__device__ __forceinline__ unsigned cvtpk(float lo, float hi) {
    unsigned r; asm volatile("v_cvt_pk_bf16_f32 %0, %1, %2" : "=v"(r) : "v"(lo), "v"(hi)); return r;
}
typedef __amdgpu_buffer_rsrc_t rsrc_t;
__device__ __forceinline__ rsrc_t mk_rsrc(const void* p) { return __builtin_amdgcn_make_buffer_rsrc((void*)p, (short)0, 0x7ffffff0, 0x00020000); }
__device__ __forceinline__ bf16x8 ldb8(rsrc_t r, int voff, int soff) { return __builtin_bit_cast(bf16x8, __builtin_amdgcn_raw_buffer_load_b128(r, voff, soff, 0)); }
__device__ __forceinline__ f32x4 ldf4(rsrc_t r, int voff, int soff) { return __builtin_bit_cast(f32x4, __builtin_amdgcn_raw_buffer_load_b128(r, voff, soff, 0)); }
__device__ __forceinline__ void mask_tile(f32x16& p0, f32x16& p1, int dq, unsigned W) {
    const float NEG = -__builtin_inff();
#pragma unroll
    for (int r = 0; r < 16; ++r) {
        const int c = (r & 3) + 8 * (r >> 2);
        if ((unsigned)(dq - c) >= W) p0[r] = NEG;
        if ((unsigned)(dq - c - 32) >= W) p1[r] = NEG;
    }
}
__device__ __forceinline__ void partialSM(f32x16& p0, f32x16& p1, float& m_reg, float& mn, float& alpha) {
    float pmax = p0[0]; for (int r = 1; r < 16; ++r) pmax = fmaxf(pmax, p0[r]); for (int r = 0; r < 16; ++r) pmax = fmaxf(pmax, p1[r]);
    { auto rr = __builtin_amdgcn_permlane32_swap(__float_as_uint(pmax), __float_as_uint(pmax), false, false);
      pmax = fmaxf(__uint_as_float(rr[0]), __uint_as_float(rr[1])); }
    constexpr float C2 = 1.4426950408889634f * SCALE;
    if (__builtin_expect(__all((pmax - m_reg) * SCALE <= THR), 1)) { mn = m_reg; alpha = 1.f; }
    else { mn = fmaxf(m_reg, pmax); alpha = __builtin_amdgcn_exp2f((m_reg - mn) * C2); m_reg = mn; }
    const float mnL = -mn * C2;
    for (int r = 0; r < 16; ++r) p0[r] = fmaf(p0[r], C2, mnL); for (int r = 0; r < 16; ++r) p1[r] = fmaf(p1[r], C2, mnL);
    for (int r = 0; r < 16; ++r) p0[r] = __builtin_amdgcn_exp2f(p0[r]);
}
__device__ __forceinline__ void finishSM(f32x16& p0, f32x16& p1, float alpha, float& l_reg, bf16x8& pa0, bf16x8& pa1, bf16x8& pa2, bf16x8& pa3) {
    for (int r = 0; r < 16; ++r) p1[r] = __builtin_amdgcn_exp2f(p1[r]);
    float ps = 0; for (int r = 0; r < 16; ++r) ps += p0[r]; for (int r = 0; r < 16; ++r) ps += p1[r];
    { auto rr = __builtin_amdgcn_permlane32_swap(__float_as_uint(ps), __float_as_uint(ps), false, false);
      ps = __uint_as_float(rr[0]) + __uint_as_float(rr[1]); }
    l_reg = l_reg * alpha + ps;
#define PK4(P, B_, OUT) do { unsigned a0 = cvtpk(P[B_+0], P[B_+1]), a1 = cvtpk(P[B_+2], P[B_+3]);                          \
        unsigned b0 = cvtpk(P[B_+4], P[B_+5]), b1 = cvtpk(P[B_+6], P[B_+7]);                                             \
        auto r0 = __builtin_amdgcn_permlane32_swap(a0, b0, false, false); auto r1 = __builtin_amdgcn_permlane32_swap(a1, b1, false, false); \
        u32x4 w = {r0[0], r1[0], r0[1], r1[1]}; OUT = *reinterpret_cast<bf16x8*>(&w); } while (0)
    PK4(p0, 0, pa0); PK4(p0, 8, pa1); PK4(p1, 0, pa2); PK4(p1, 8, pa3);
#undef PK4
}
template <int KB>
__device__ __forceinline__ void qkt(f32x16& p0, f32x16& p1, const char* K_lds, const char* F_lds, int r32, int hi, const bf16x8* qr) {
    { const f32x4* fk = reinterpret_cast<const f32x4*>(F_lds + KB * 256);
#pragma unroll
      for (int g = 0; g < 4; ++g) { const f32x4 a = fk[2 * g + hi], b = fk[8 + 2 * g + hi];
#pragma unroll
          for (int e = 0; e < 4; ++e) { p0[4 * g + e] = a[e]; p1[4 * g + e] = b[e]; } } }
    const char* kb[4];
#pragma unroll
    for (int dd = 0; dd < 4; ++dd) kb[dd] = K_lds + KB * SHM_K + KSWZ(r32, (dd * 16 + hi * 8) * 2);
#pragma unroll
    for (int d0 = 0; d0 < 8; ++d0) { const char* a = kb[d0 & 3] + (d0 >> 2) * 128;
        bf16x8 b0 = *reinterpret_cast<const bf16x8*>(a);
        bf16x8 b1 = *reinterpret_cast<const bf16x8*>(a + 32 * 256);
        p0 = __builtin_amdgcn_mfma_f32_32x32x16_bf16(b0, qr[d0], p0, 0, 0, 0);
        p1 = __builtin_amdgcn_mfma_f32_32x32x16_bf16(b1, qr[d0], p1, 0, 0, 0); }
}
template <int VB>
__device__ __forceinline__ void pv_tile(f32x16* o, int vb0, bf16x8 pa0, bf16x8 pa1, bf16x8 pa2, bf16x8 pa3) {
#define TRRD(dst, off) asm volatile("ds_read_b64_tr_b16 %0, %1 offset:%2" : "=&v"(dst) : "v"(vb0), "i"(off) : "memory")
#define PV_D0(d0) do { s16x4 l0, l1, l2, l3, h0, h1, h2, h3; constexpr int b_ = VB * SHM_V + v_rd_off(d0, 0, 0);     \
        TRRD(l0, b_); TRRD(h0, b_ + 2048); TRRD(l1, b_ + 4096); TRRD(h1, b_ + 6144); TRRD(l2, b_ + 8192); TRRD(h2, b_ + 10240); TRRD(l3, b_ + 12288); TRRD(h3, b_ + 14336); \
        asm volatile("s_waitcnt lgkmcnt(0)" ::: "memory"); SBAR();                 \
        o[d0] = __builtin_amdgcn_mfma_f32_32x32x16_bf16(pa0, (bf16x8){l0[0], l0[1], l0[2], l0[3], h0[0], h0[1], h0[2], h0[3]}, o[d0], 0, 0, 0);   \
        o[d0] = __builtin_amdgcn_mfma_f32_32x32x16_bf16(pa1, (bf16x8){l1[0], l1[1], l1[2], l1[3], h1[0], h1[1], h1[2], h1[3]}, o[d0], 0, 0, 0);   \
        o[d0] = __builtin_amdgcn_mfma_f32_32x32x16_bf16(pa2, (bf16x8){l2[0], l2[1], l2[2], l2[3], h2[0], h2[1], h2[2], h2[3]}, o[d0], 0, 0, 0);   \
        o[d0] = __builtin_amdgcn_mfma_f32_32x32x16_bf16(pa3, (bf16x8){l3[0], l3[1], l3[2], l3[3], h3[0], h3[1], h3[2], h3[3]}, o[d0], 0, 0, 0); } while (0)
    PV_D0(0); PV_D0(1); PV_D0(2); PV_D0(3);
#undef PV_D0
#undef TRRD
}

struct BlockRef { const bf16* Q; const bf16* K; const bf16* V; bf16* O; const float* F; const bf16* G; const float* wo; int P0; int jlo; };
struct Seam {
    bf16x8 qr[8];
    bf16x8 st_v0, st_v1, st_k0, st_k1; f32x4 st_f;
};
#define VMW() asm volatile("s_waitcnt vmcnt(0)" ::: "memory")
#define VMWN(n) asm volatile("s_waitcnt vmcnt(%0)" :: "i"(n) : "memory")
#define SLOAD_H(rK_, rV_, rF_, k0) do { const int so_ = (k0) * (ALD * 2);                                                    \
                         S.st_v0 = ldb8(rV_, kvoff, so_); S.st_v1 = ldb8(rV_, kvoff, so_ + 32 * ALD * 2);                    \
                         S.st_k0 = ldb8(rK_, kvoff, so_); S.st_k1 = ldb8(rK_, kvoff, so_ + 32 * ALD * 2);                    \
                         if (tid < 16) S.st_f = ldf4(rF_, tid * 16, (k0) * 4); } while (0)
#define QLOAD(rQ_) do { _Pragma("unroll") for (int d0 = 0; d0 < 8; ++d0) S.qr[d0] = ldb8(rQ_, qoff + d0 * 32, 0); } while (0)
#define SWRITE_HK(bf) do { *(bf16x8*)(K_lds + (bf) * SHM_K + kws) = S.st_k0; *(bf16x8*)(K_lds + (bf) * SHM_K + kws + 32 * 256) = S.st_k1; \
                           if (tid < 16) *(f32x4*)(F_lds + (bf) * 256 + tid * 16) = S.st_f; } while (0)
#define SWRITE_HV(bf) do { *(bf16x8*)(V_lds + (bf) * SHM_V + vst0) = S.st_v0; *(bf16x8*)(V_lds + (bf) * SHM_V + vst1) = S.st_v1; } while (0)
#define SWRITE_H(bf) do { SWRITE_HV(bf); SWRITE_HK(bf); } while (0)
__device__ __forceinline__ int fox_jlo(const float* Fn, int P0, float TH) {
    int lane_ = threadIdx.x & 63; asm volatile("" : "+v"(lane_));
    const int ntf = P0 / KVBLK + 4, kt = lane_ < ntf ? lane_ : ntf - 1;
    int zero_ = 0; asm volatile("" : "+v"(zero_));
    const float fe = Fn[kt * KVBLK + KVBLK - 1], fp0 = Fn[P0 + zero_];
    const unsigned long long mk = __ballot(fp0 - fe <= TH);
    return (int)__builtin_ctzll(mk);
}
__device__ __forceinline__ void normalize_q(bf16x8* qr, const float* wq, int hi) {
    float ss = 0.f;
#pragma unroll
    for (int d0 = 0; d0 < 8; ++d0) { const u32x4 w = __builtin_bit_cast(u32x4, qr[d0]);
#pragma unroll
        for (int e = 0; e < 4; ++e) { const float a = __uint_as_float(w[e] << 16), b = __uint_as_float(w[e] & 0xffff0000u); ss += a * a + b * b; } }
    { auto rr = __builtin_amdgcn_permlane32_swap(__float_as_uint(ss), __float_as_uint(ss), false, false); ss = __uint_as_float(rr[0]) + __uint_as_float(rr[1]); }
    const float rs = __builtin_amdgcn_rsqf(ss * (1.f / AD) + NEPS);
#pragma unroll
    for (int d0 = 0; d0 < 8; ++d0) { const u32x4 w = __builtin_bit_cast(u32x4, qr[d0]); const f32x4 w0 = *(const f32x4*)(wq + d0 * 16 + hi * 8), w1 = *(const f32x4*)(wq + d0 * 16 + hi * 8 + 4);
        u32x4 o; o[0] = cvtpk(__uint_as_float(w[0] << 16) * rs * w0[0], __uint_as_float(w[0] & 0xffff0000u) * rs * w0[1]); o[1] = cvtpk(__uint_as_float(w[1] << 16) * rs * w0[2], __uint_as_float(w[1] & 0xffff0000u) * rs * w0[3]);
        o[2] = cvtpk(__uint_as_float(w[2] << 16) * rs * w1[0], __uint_as_float(w[2] & 0xffff0000u) * rs * w1[1]); o[3] = cvtpk(__uint_as_float(w[3] << 16) * rs * w1[2], __uint_as_float(w[3] & 0xffff0000u) * rs * w1[3]);
        qr[d0] = __builtin_bit_cast(bf16x8, o); }
}
__device__ __forceinline__ void causal_prime(const BlockRef& cur, char* lds, Seam& S) {
    int tid_ = threadIdx.x; asm volatile("" : "+v"(tid_));
    const int tid = tid_, wid = __builtin_amdgcn_readfirstlane(tid >> 6), lane = tid & 63, r32 = lane & 31, hi = lane >> 5;
    const int sr = tid >> 4, sc = (tid & 15) * 8, kws = KSWZ(sr, sc * 2); char* K_lds = lds + 2 * SHM_V; char* F_lds = lds + LDS_F;
    const int kvoff = (sr * ALD + sc) * 2, qoff = ((wid * QBLK + r32) * ALD + hi * 8) * 2;
    const rsrc_t rQ = mk_rsrc(cur.Q), rK = mk_rsrc(cur.K), rV = mk_rsrc(cur.V), rF = mk_rsrc(cur.F);
    QLOAD(rQ);
    SLOAD_H(rK, rV, rF, cur.jlo * KVBLK); VMW(); SWRITE_HK(0);
    __syncthreads();
}
__device__ __forceinline__ void causal_block(const BlockRef& cur, const BlockRef& nxt, char* lds, Seam& S, const float* wq) {
    int tid_ = threadIdx.x; asm volatile("" : "+v"(tid_));
    const int tid = tid_, wid = __builtin_amdgcn_readfirstlane(tid >> 6), lane = tid & 63, r32 = lane & 31, hi = lane >> 5;
    constexpr int W = 1 << 30;
    const int j_lo = cur.jlo, NT = (cur.P0 + QB - 1) / KVBLK + 1 - j_lo;
    const int qlo = cur.P0 + wid * QBLK, qm = qlo + r32 - 4 * hi;
    char* V_lds = lds; char* K_lds = lds + 2 * SHM_V; char* F_lds = lds + LDS_F;
    float* ws = (float*)(lds + 2 * SHM_V + 2 * SHM_K) + wid * 64; float* li_l = ws, * al_l = ws + 32;
    float m_reg = -1e30f, l_reg = 0; f32x16 o[4] = {};
    const int sr = tid >> 4, sc = (tid & 15) * 8, vst0 = v_st(sr, sc), vst1 = v_st(32 + sr, sc), kws = KSWZ(sr, sc * 2);
    const int vb0 = (int)(uintptr_t)V_lds + v_rd_base(lane);
    const int kvoff = (sr * ALD + sc) * 2, qoff = ((wid * QBLK + r32) * ALD + hi * 8) * 2;
    const rsrc_t Kh = mk_rsrc(cur.K), Vh = mk_rsrc(cur.V), Fh = mk_rsrc(cur.F);
#define RESC(a) do { if (__any((a) < 1.f)) { if (hi == 0) al_l[r32] = (a); asm volatile("s_waitcnt lgkmcnt(0)" ::: "memory");              \
                     for (int d_ = 0; d_ < 4; ++d_) for (int r = 0; r < 16; ++r) o[d_][r] *= al_l[crow(r, hi)]; } } while (0)
#define KBASE(t) ((j_lo + (t)) * KVBLK)
#define MASKT(P0_, P1_, t) do { const int kb_ = KBASE(t); if (kb_ + KVBLK - 1 > qlo) mask_tile(P0_, P1_, qm - kb_, (unsigned)W); } while (0)
    constexpr int NQL = 8;
#define SEAM_K0() do { VMWN(NQL); SWRITE_HK(0); SBAR(); } while (0)
    f32x16 pA0, pA1, pB0, pB1; float mnA, mnB, alA, alB; bf16x8 pa0, pa1, pa2, pa3;
    normalize_q(S.qr, wq, hi);
    SWRITE_HV(0); SBAR();
    if (NT > 1) { SLOAD_H(Kh, Vh, Fh, KBASE(1)); }
    SBAR(); qkt<0>(pA0, pA1, K_lds, F_lds, r32, hi, S.qr);
    MASKT(pA0, pA1, 0); partialSM(pA0, pA1, m_reg, mnA, alA);
    if (NT > 1) { VMW(); SWRITE_H(1); }
    __syncthreads();
#define HALF_STEP(PX0, PX1, mnX, alX, PY0, PY1, alY, t, KB, VB, SB) do {                                                      \
        SBAR(); qkt<KB>(PX0, PX1, K_lds, F_lds, r32, hi, S.qr);                                                               \
        finishSM(PY0, PY1, alY, l_reg, pa0, pa1, pa2, pa3); SBAR();                                                           \
        if ((t) + 1 < NT) { SLOAD_H(Kh, Vh, Fh, KBASE((t) + 1)); SBAR(); }                                                    \
        pv_tile<VB>(o, vb0, pa0, pa1, pa2, pa3); MASKT(PX0, PX1, (t)); partialSM(PX0, PX1, m_reg, mnX, alX);                  \
        __syncthreads();                                                                                                      \
        if ((t) + 1 < NT) { VMW(); SWRITE_H(SB); }                                                                            \
        RESC(alX); __syncthreads(); } while (0)
    for (int t = 1; t + 1 < NT; t += 2) {
        HALF_STEP(pB0, pB1, mnB, alB, pA0, pA1, alA, t, 1, 0, 0);
        HALF_STEP(pA0, pA1, mnA, alA, pB0, pB1, alB, t + 1, 0, 1, 1);
    }
    const bool even = (NT & 1) == 0;
    if (even) { SBAR(); qkt<1>(pB0, pB1, K_lds, F_lds, r32, hi, S.qr); SBAR(); }
    { const rsrc_t nK = mk_rsrc(nxt.K), nV = mk_rsrc(nxt.V), nF = mk_rsrc(nxt.F), nQ = mk_rsrc(nxt.Q);
      SLOAD_H(nK, nV, nF, nxt.jlo * KVBLK); SBAR();
      QLOAD(nQ); }
    SBAR();
    finishSM(pA0, pA1, alA, l_reg, pa0, pa1, pa2, pa3); SBAR();
    pv_tile<0>(o, vb0, pa0, pa1, pa2, pa3);
    if (even) { MASKT(pB0, pB1, NT - 1); partialSM(pB0, pB1, m_reg, mnB, alB); __syncthreads(); RESC(alB);
        finishSM(pB0, pB1, alB, l_reg, pa0, pa1, pa2, pa3); SBAR(); pv_tile<1>(o, vb0, pa0, pa1, pa2, pa3); }
    SBAR(); SEAM_K0();
    { char* so = lds + LDS_SO + wid * SO_WAVE;
      const int erow = lane >> 1, eh = lane & 1, eoff = ((wid * QBLK + erow) * ALD + eh * 64) * 2;
      const rsrc_t rG = mk_rsrc(cur.G), rO = mk_rsrc(cur.O);
      bf16x8 gt[8];
#pragma unroll
      for (int i = 0; i < 8; ++i) gt[i] = ldb8(rG, eoff + i * 16, 0);
      if (hi == 0) li_l[r32] = l_reg; asm volatile("s_waitcnt lgkmcnt(0)" ::: "memory");
#pragma unroll
      for (int r = 0; r < 16; ++r) { const float rl = __builtin_amdgcn_rcpf(li_l[crow(r, hi)]);
#pragma unroll
        for (int d0 = 0; d0 < 4; ++d0) *(unsigned short*)(so + crow(r, hi) * SO_PITCH + (d0 * 32 + r32) * 2) = (unsigned short)(cvtpk(o[d0][r] * rl, 0.f) & 0xffffu); }
      asm volatile("s_waitcnt lgkmcnt(0)" ::: "memory");
      typedef unsigned u32x2 __attribute__((ext_vector_type(2)));
      u32x2 xw[16]; float ssq = 0.f;
#pragma unroll
      for (int i = 0; i < 16; ++i) { xw[i] = *(const u32x2*)(so + erow * SO_PITCH + eh * 128 + i * 8);
#pragma unroll
        for (int e = 0; e < 2; ++e) { const float a = __uint_as_float(xw[i][e] << 16), b = __uint_as_float(xw[i][e] & 0xffff0000u); ssq += a * a + b * b; } }
      ssq += __shfl_xor(ssq, 1);
      const float rs = __builtin_amdgcn_rsqf(ssq * (1.f / AD) + NEPS);
#pragma unroll
      for (int i = 0; i < 8; ++i) { const f32x4 w0 = *(const f32x4*)(cur.wo + eh * 64 + i * 8), w1 = *(const f32x4*)(cur.wo + eh * 64 + i * 8 + 4);
        const u32x4 g = __builtin_bit_cast(u32x4, gt[i]); const float ww[8] = {w0[0], w0[1], w0[2], w0[3], w1[0], w1[1], w1[2], w1[3]};
        u32x4 ow;
#pragma unroll
        for (int e = 0; e < 4; ++e) { const unsigned xv = xw[2 * i + (e >> 1)][e & 1];
            const float x0 = __uint_as_float(xv << 16), x1 = __uint_as_float(xv & 0xffff0000u), g0 = __uint_as_float(g[e] << 16), g1 = __uint_as_float(g[e] & 0xffff0000u);
            const float s0 = g0 * __builtin_amdgcn_rcpf(1.f + __builtin_amdgcn_exp2f(-1.4426950408889634f * g0)), s1 = g1 * __builtin_amdgcn_rcpf(1.f + __builtin_amdgcn_exp2f(-1.4426950408889634f * g1));
            ow[e] = cvtpk(x0 * rs * ww[2 * e] * s0, x1 * rs * ww[2 * e + 1] * s1); }
        __builtin_amdgcn_raw_buffer_store_b128(ow, rO, eoff + i * 16, 0, 0); } }
    __syncthreads();
#undef RESC
#undef KBASE
#undef MASKT
#undef SEAM_K0
#undef HALF_STEP
}
#undef QLOAD
#undef VMW
#undef VMWN
#undef SLOAD_H
#undef SWRITE_HK
#undef SWRITE_HV
#undef SWRITE_H
#undef KSWZ
#undef SBAR
}
namespace rec {
typedef short bf16x8 __attribute__((ext_vector_type(8)));
typedef short bf16x4 __attribute__((ext_vector_type(4)));
typedef float f32x4 __attribute__((ext_vector_type(4)));
typedef float f32x2 __attribute__((ext_vector_type(2)));
typedef __bf16 bf16x2_t __attribute__((ext_vector_type(2)));
typedef unsigned u32x4 __attribute__((ext_vector_type(4)));
typedef unsigned u32x2 __attribute__((ext_vector_type(2)));
#define REC_LAS __attribute__((address_space(3)))
constexpr int RT = 4096, RD = 2048, NSEG = 4, SEG = RT / NSEG, NCH = SEG / 64;
constexpr int QP = 272, TP = 144;
constexpr int OFF_KB = 160 * QP, OFF_KHT = OFF_KB + 64 * QP, OFF_VT = OFF_KHT + 128 * TP, OFF_AM = OFF_VT + 128 * TP, OFF_TOT = OFF_AM + 64 * TP, OFF_DL = OFF_TOT + 8 * 128 * 4, LDS_END = OFF_DL + 512;
static_assert(LDS_END <= 131072, "recurrence LDS map");
__device__ __forceinline__ constexpr int qv_off(int j) { return (64 * j - 8 * j * (j - 1)) * QP; }
__device__ __forceinline__ unsigned cvt2(float lo, float hi) { f32x2 v = {lo, hi}; bf16x2_t b = __builtin_convertvector(v, bf16x2_t); return __builtin_bit_cast(unsigned, b); }
__device__ __forceinline__ float ex2(float x) { return __builtin_amdgcn_exp2f(x); }
__device__ __forceinline__ float lo_f(unsigned w) { return __uint_as_float(w << 16); }
__device__ __forceinline__ float hi_f(unsigned w) { return __uint_as_float(w & 0xffff0000u); }

template <bool OUT>
__device__ __forceinline__ void run(REC_LAS unsigned char* lds, int G, const unsigned short* Qp, const unsigned short* Zp, const unsigned short* Vp, unsigned short* Op,
                                    const float* lbl, int layer, float* Ug, float* Dg) {
    int tid_ = threadIdx.x; asm volatile("" : "+v"(tid_));
    const int tid = tid_, lane = tid & 63, wv = __builtin_amdgcn_readfirstlane(tid >> 6), fr = lane & 15, fg = lane >> 4;
    constexpr int NU = OUT ? 64 * NSEG : 64 * (NSEG - 1);
    if (OUT) { if (tid < 256) { const int blk = tid >> 7, r = (tid >> 3) & 15, c = tid & 7;
            *(REC_LAS unsigned*)(lds + OFF_AM + (32 * blk + r) * TP + (32 * blk + 16) * 2 + c * 4) = 0u; } }
    for (int u = blockIdx.x; u < NU; u += G) {
        const int bh = OUT ? u / NSEG : u / (NSEG - 1), seg = OUT ? u % NSEG : u % (NSEG - 1), b = bh >> 4, h = bh & 15;
        float lb[2];
#pragma unroll
        for (int dd = 0; dd < 2; ++dd) { const int c = h * 128 + 2 * lane + dd; lb[dd] = layer == 0 ? 0.f : 1.f / (1.f + __expf(lbl[c] - lbl[RD + c])); }
        f32x4 st[8];
#pragma unroll
        for (int kt = 0; kt < 8; ++kt) st[kt] = (f32x4){0.f, 0.f, 0.f, 0.f};
        if (OUT) {
            for (int s2 = 0; s2 < seg; ++s2) {
                const float* U = Ug + ((size_t)(bh * (NSEG - 1) + s2) << 14); const float* Dv = Dg + (bh * (NSEG - 1) + s2) * 128;
#pragma unroll
                for (int kt = 0; kt < 8; ++kt) { const f32x4 dvv = *(const f32x4*)(Dv + 16 * kt + 4 * fg);
#pragma unroll
                    for (int e = 0; e < 4; ++e) st[kt][e] = dvv[e] * st[kt][e] + U[(16 * kt + 4 * fg + e) * 128 + 16 * wv + fr]; }
            }
        }
        float dsum[2] = {0.f, 0.f};
        const size_t row0 = (size_t)(b * RT + seg * SEG) * RD + h * 128;
        unsigned nq[8], nz[8], nv[8];
#pragma unroll
        for (int e = 0; e < 8; ++e) { const size_t o = row0 + (size_t)(8 * wv + e) * RD + 2 * lane; nq[e] = *(const unsigned*)(Qp + o); nz[e] = *(const unsigned*)(Zp + o); nv[e] = *(const unsigned*)(Vp + o); }
#pragma unroll 1
        for (int c = 0; c < NCH; ++c) {
            unsigned cq[8], cz[8], cv[8];
#pragma unroll
            for (int e = 0; e < 8; ++e) { cq[e] = nq[e]; cz[e] = nz[e]; cv[e] = nv[e]; }
            if (c + 1 < NCH) {
#pragma unroll
                for (int e = 0; e < 8; ++e) { const size_t o = row0 + (size_t)(64 * (c + 1) + 8 * wv + e) * RD + 2 * lane; nq[e] = *(const unsigned*)(Qp + o); nz[e] = *(const unsigned*)(Zp + o); nv[e] = *(const unsigned*)(Vp + o); }
            }
            float kf[8][2], cs[8][2];
#pragma unroll
            for (int e = 0; e < 8; ++e) {
#pragma unroll
                for (int dd = 0; dd < 2; ++dd) {
                    const float z = dd ? hi_f(cz[e]) : lo_f(cz[e]);
                    const float ez = ex2(-1.4426950408889634f * fabsf(z)), inv = __builtin_amdgcn_rcpf(1.f + ez);
                    const float sig = z >= 0.f ? inv : ez * inv, nsig = z >= 0.f ? ez * inv : inv;
                    const float f = lb[dd] + (1.f - lb[dd]) * sig;
                    kf[e][dd] = (1.f - lb[dd]) * nsig;
                    const float gl = __builtin_amdgcn_logf(f);
                    cs[e][dd] = e ? cs[e - 1][dd] + gl : gl;
                }
            }
            *(REC_LAS f32x2*)(lds + OFF_TOT + (wv * 128 + 2 * lane) * 4) = (f32x2){cs[7][0], cs[7][1]};
            __syncthreads();
            float P[9][2];
            P[0][0] = 0.f; P[0][1] = 0.f;
#pragma unroll
            for (int w = 0; w < 8; ++w) { const f32x2 t2 = *(const REC_LAS f32x2*)(lds + OFF_TOT + (w * 128 + 2 * lane) * 4); P[w + 1][0] = P[w][0] + t2[0]; P[w + 1][1] = P[w][1] + t2[1]; }
            float base[2], bl[2], Bj[4][2];
#pragma unroll
            for (int dd = 0; dd < 2; ++dd) { bl[dd] = P[8][dd]; float bs = 0.f;
#pragma unroll
                for (int w = 0; w < 8; ++w) bs = (w == wv) ? P[w][dd] : bs;
                base[dd] = bs;
#pragma unroll
                for (int j = 0; j < 4; ++j) Bj[j][dd] = P[2 * j][dd]; }
            const int jb = wv >> 1;
            float Bown[2];
#pragma unroll
            for (int dd = 0; dd < 2; ++dd) { float bo = 0.f;
#pragma unroll
                for (int j = 0; j < 4; ++j) bo = (j == jb) ? Bj[j][dd] : bo;
                Bown[dd] = bo; }
            unsigned khw[2][4], vtw[2][4];
#pragma unroll
            for (int e = 0; e < 8; ++e) {
                const int t = 8 * wv + e;
                float bt[2], qv[2];
#pragma unroll
                for (int dd = 0; dd < 2; ++dd) { bt[dd] = base[dd] + cs[e][dd]; qv[dd] = dd ? hi_f(cq[e]) : lo_f(cq[e]); }
                if (OUT) {
#pragma unroll
                    for (int j = 0; j < 4; ++j) if (j <= jb)
                        *(REC_LAS unsigned*)(lds + qv_off(j) + (t - 16 * j) * QP + lane * 4) = cvt2(qv[0] * ex2(bt[0] - Bj[j][0]), qv[1] * ex2(bt[1] - Bj[j][1]));
                    *(REC_LAS unsigned*)(lds + OFF_KB + t * QP + lane * 4) = cvt2(kf[e][0] * ex2(fminf(Bown[0] - bt[0], 120.f)), kf[e][1] * ex2(fminf(Bown[1] - bt[1], 120.f)));
                }
                const float kh0 = kf[e][0] * ex2(bl[0] - bt[0]), kh1 = kf[e][1] * ex2(bl[1] - bt[1]);
                const float v0 = lo_f(cv[e]), v1 = hi_f(cv[e]);
                if (e & 1) { khw[0][e >> 1] = cvt2(__uint_as_float(khw[0][e >> 1]), kh0); khw[1][e >> 1] = cvt2(__uint_as_float(khw[1][e >> 1]), kh1);
                             vtw[0][e >> 1] = (vtw[0][e >> 1] >> 16) | (cv[e] << 16); vtw[1][e >> 1] = (vtw[1][e >> 1] >> 16) | (cv[e] & 0xffff0000u); (void)v0; (void)v1; }
                else { khw[0][e >> 1] = __float_as_uint(kh0); khw[1][e >> 1] = __float_as_uint(kh1); vtw[0][e >> 1] = cv[e] << 16; vtw[1][e >> 1] = cv[e] & 0xffff0000u; }
            }
#pragma unroll
            for (int dd = 0; dd < 2; ++dd) {
                *(REC_LAS u32x4*)(lds + OFF_KHT + (2 * lane + dd) * TP + wv * 16) = (u32x4){khw[dd][0], khw[dd][1], khw[dd][2], khw[dd][3]};
                *(REC_LAS u32x4*)(lds + OFF_VT + (2 * lane + dd) * TP + wv * 16) = (u32x4){vtw[dd][0], vtw[dd][1], vtw[dd][2], vtw[dd][3]};
            }
            if (wv == 0) *(REC_LAS f32x2*)(lds + OFF_DL + 2 * lane * 4) = (f32x2){ex2(bl[0]), ex2(bl[1])};
            dsum[0] += bl[0]; dsum[1] += bl[1];
            __syncthreads();
            if (OUT) {
#pragma unroll 1
                for (int blk = wv; blk < 10; blk += 8) {
                    const int i = blk < 1 ? 0 : blk < 3 ? 1 : blk < 6 ? 2 : 3, j = blk - (i * (i + 1)) / 2;
                    f32x4 a = {0.f, 0.f, 0.f, 0.f};
                    const REC_LAS unsigned char* ka = lds + OFF_KB + (16 * j + fr) * QP + fg * 16;
                    const REC_LAS unsigned char* qa = lds + qv_off(j) + (16 * (i - j) + fr) * QP + fg * 16;
#pragma unroll
                    for (int kk = 0; kk < 4; ++kk) a = __builtin_amdgcn_mfma_f32_16x16x32_bf16(*(const REC_LAS bf16x8*)(ka + kk * 64), *(const REC_LAS bf16x8*)(qa + kk * 64), a, 0, 0, 0);
                    if (i == j) {
#pragma unroll
                        for (int e = 0; e < 4; ++e) a[e] = (4 * fg + e <= fr) ? a[e] : 0.f; }
                    u32x2 w2; w2.x = cvt2(a[0], a[1]); w2.y = cvt2(a[2], a[3]);
                    *(REC_LAS u32x2*)(lds + OFF_AM + (16 * i + fr) * TP + (16 * j + 4 * fg) * 2) = w2;
                }
                __syncthreads();
            }
            bf16x8 vb[2];
#pragma unroll
            for (int kk = 0; kk < 2; ++kk) vb[kk] = *(const REC_LAS bf16x8*)(lds + OFF_VT + (16 * wv + fr) * TP + kk * 64 + fg * 16);
            if (OUT) {
                bf16x8 sb[4];
#pragma unroll
                for (int k4 = 0; k4 < 4; ++k4) { u32x4 w4; w4.x = cvt2(st[2 * k4][0], st[2 * k4][1]); w4.y = cvt2(st[2 * k4][2], st[2 * k4][3]); w4.z = cvt2(st[2 * k4 + 1][0], st[2 * k4 + 1][1]); w4.w = cvt2(st[2 * k4 + 1][2], st[2 * k4 + 1][3]);
                    sb[k4] = __builtin_bit_cast(bf16x8, w4); }
                unsigned short* orow = Op + row0 + (size_t)(64 * c + 4 * fg) * RD + 16 * wv + fr;
#pragma unroll
                for (int mt = 0; mt < 4; ++mt) {
                    f32x4 acc = {0.f, 0.f, 0.f, 0.f};
#pragma unroll
                    for (int kk = 0; kk < 2; ++kk) if (kk <= (mt >> 1))
                        acc = __builtin_amdgcn_mfma_f32_16x16x32_bf16(*(const REC_LAS bf16x8*)(lds + OFF_AM + (16 * mt + fr) * TP + kk * 64 + fg * 16), vb[kk], acc, 0, 0, 0);
#pragma unroll
                    for (int k4 = 0; k4 < 4; ++k4) {
                        const REC_LAS unsigned char* qa = lds + (16 * mt + fr) * QP + k4 * 64 + fg * 8;
                        const u32x2 lo2 = *(const REC_LAS u32x2*)qa, hi2 = *(const REC_LAS u32x2*)(qa + 32);
                        const u32x4 w4 = {lo2.x, lo2.y, hi2.x, hi2.y};
                        acc = __builtin_amdgcn_mfma_f32_16x16x32_bf16(__builtin_bit_cast(bf16x8, w4), sb[k4], acc, 0, 0, 0);
                    }
#pragma unroll
                    for (int e = 0; e < 4; ++e) orow[(size_t)(16 * mt + e) * RD] = (unsigned short)(cvt2(acc[e], 0.f) & 0xffffu);
                }
            }
#pragma unroll
            for (int kt = 0; kt < 8; ++kt) {
                const f32x4 dl4 = *(const REC_LAS f32x4*)(lds + OFF_DL + (16 * kt + 4 * fg) * 4);
                st[kt] = st[kt] * dl4;
#pragma unroll
                for (int kk = 0; kk < 2; ++kk)
                    st[kt] = __builtin_amdgcn_mfma_f32_16x16x32_bf16(*(const REC_LAS bf16x8*)(lds + OFF_KHT + (16 * kt + fr) * TP + kk * 64 + fg * 16), vb[kk], st[kt], 0, 0, 0);
            }
        }
        if (!OUT) {
            float* U = Ug + ((size_t)u << 14);
#pragma unroll
            for (int kt = 0; kt < 8; ++kt)
#pragma unroll
                for (int e = 0; e < 4; ++e) U[(16 * kt + 4 * fg + e) * 128 + 16 * wv + fr] = st[kt][e];
            if (wv == 0) *(f32x2*)(Dg + u * 128 + 2 * lane) = (f32x2){ex2(dsum[0]), ex2(dsum[1])};
        }
        __syncthreads();
    }
}
#undef REC_LAS
}
#define GAS __attribute__((address_space(1)))
#define LAS __attribute__((address_space(3)))
typedef unsigned short bf16;
typedef unsigned v4u __attribute__((ext_vector_type(4)));
typedef float f32x4 __attribute__((ext_vector_type(4)));
typedef short bf16x8 __attribute__((ext_vector_type(8)));
typedef GAS unsigned gu32;
typedef GAS unsigned long long gu64;
#define RLX_AGENT __ATOMIC_RELAXED, __HIP_MEMORY_SCOPE_AGENT
#define LDS_WAIT() asm volatile("s_waitcnt lgkmcnt(0)" ::: "memory")
#define VM_WAIT() asm volatile("s_waitcnt vmcnt(0)" ::: "memory")
__device__ __forceinline__ unsigned long long rt() { return __builtin_amdgcn_s_memrealtime(); }
__device__ __forceinline__ unsigned f2bf(float f) { unsigned u = __builtin_bit_cast(unsigned, f); return (u + 0x7fffu + ((u >> 16) & 1u)) >> 16; }
__device__ __forceinline__ unsigned pk2(float lo, float hi) { return f2bf(lo) | (f2bf(hi) << 16); }
#define XB_TMO      128
#define XB_XCNT(j)  (256  + 64 * (j))
#define XB_XSUB(j)  (1280 + 64 * (j))
#define XB_XGEN(j)  (2304 + 64 * (j))
#define XB_TOP      3328
#define XB_TOPGEN   3392
#define XCD_BAR_WORDS 3456
#define XB_SPIN_CAP (1u << 18)

__device__ __forceinline__ unsigned xb_ld(unsigned* p)              { return __hip_atomic_load(p, __ATOMIC_RELAXED, __HIP_MEMORY_SCOPE_AGENT); }
__device__ __forceinline__ unsigned xb_add(unsigned* p, unsigned v) { return __hip_atomic_fetch_add(p, v, __ATOMIC_RELAXED, __HIP_MEMORY_SCOPE_AGENT); }
__device__ __forceinline__ unsigned xb_xcc_id() { return (unsigned)__builtin_amdgcn_s_getreg((3 << 11) | 20) & 0xFu; }
#define XB_SPIN(cond, bar) do { unsigned _sp = 0; while (cond) { __builtin_amdgcn_s_sleep(1); \
    if ((++_sp & 255u) == 0u) { if (xb_ld(&(bar)[XB_TMO])) break; if (_sp > XB_SPIN_CAP) { atomicAdd(&(bar)[XB_TMO], 1u); break; } } } } while (0)

struct XcdBarrier {
    unsigned* bar; unsigned x;
    volatile LAS unsigned* st;
};

__device__ __forceinline__ XcdBarrier xcd_barrier_post(unsigned* bar, volatile LAS unsigned* st) {
    XcdBarrier b; b.bar = bar; b.x = xb_xcc_id(); b.st = st;
    if (threadIdx.x == 0) (void)xb_add(&bar[XB_XCNT(b.x)], 1u);
    return b;
}
__device__ __forceinline__ void xcd_barrier_complete(unsigned* bar, unsigned x, unsigned& nloc, unsigned& nx) {
    const unsigned G = gridDim.x * gridDim.y * gridDim.z;
    unsigned sum, cnt, mine, sp = 0u;
    for (;;) {
        sum = 0u; cnt = 0u; mine = 0u;
#pragma unroll
        for (unsigned j = 0; j < 16; ++j) { const unsigned c = xb_ld(&bar[XB_XCNT(j)]); sum += c; cnt += (c > 0u) ? 1u : 0u; mine = (j == x) ? c : mine; }
        if (sum == G) break;
        __builtin_amdgcn_s_sleep(1);
        if ((++sp & 255u) == 0u) { if (xb_ld(&bar[XB_TMO])) break; if (sp > XB_SPIN_CAP) { atomicAdd(&bar[XB_TMO], 1u); break; } }
    }
    nloc = mine > 0u ? mine : 1u; nx = cnt > 0u ? cnt : 1u;
}

__device__ __forceinline__ void xcd_barrier(const XcdBarrier& b) {
    asm volatile("s_waitcnt vmcnt(0)" ::: "memory");
    __syncthreads();
    if (threadIdx.x == 0) {
        unsigned* bar = b.bar;
        __builtin_amdgcn_s_waitcnt(0);
        unsigned nloc = b.st[0], nx = b.st[1];
        if (nloc == 0u) { xcd_barrier_complete(bar, b.x, nloc, nx); b.st[0] = nloc; b.st[1] = nx; }
        const unsigned old = xb_add(&bar[XB_XSUB(b.x)], 1u);
        const unsigned gen = old / nloc;
        if (old + 1u == (gen + 1u) * nloc) {
            __builtin_amdgcn_fence(__ATOMIC_RELEASE, "agent");
            asm volatile("s_waitcnt vmcnt(0)" ::: "memory");
            const unsigned og = xb_add(&bar[XB_TOP], 1u);
            const unsigned tg = og / nx;
            if (og + 1u == (tg + 1u) * nx) xb_add(&bar[XB_TOPGEN], 1u);
            else XB_SPIN(xb_ld(&bar[XB_TOPGEN]) == tg, bar);
            __builtin_amdgcn_fence(__ATOMIC_ACQUIRE, "agent");
            xb_add(&bar[XB_XGEN(b.x)], 1u);
            asm volatile("s_waitcnt vmcnt(0)" ::: "memory");
        } else {
            XB_SPIN(xb_ld(&bar[XB_XGEN(b.x)]) == gen, bar);
            __builtin_amdgcn_fence(__ATOMIC_ACQUIRE, "agent");
            asm volatile("s_waitcnt vmcnt(0)" ::: "memory");
        }
    }
    __syncthreads();
}
#define PROBE_MODE 0
constexpr int NWAVES = 8;
#ifndef ONE_LAUNCH
#define ONE_LAUNCH 1
#endif
constexpr int BATCH = 4, T = 4096, D = 2048, H = 16, HD = 128;
constexpr int M = BATCH * T;
constexpr int NPA = 8192;
constexpr float EPS = 1e-6f;
constexpr size_t MiB = 1u << 20;
constexpr size_t WS_CTL = 0, CTL_ZERO_BYTES = 1 * MiB;
constexpr size_t WS_WINA = 2 * MiB;
constexpr size_t WS_WOUTA = 66 * MiB;
constexpr size_t WS_WKVQ = 82 * MiB;
constexpr size_t WS_WINB1 = 114 * MiB;
constexpr size_t WS_WOUTB = 130 * MiB;
constexpr size_t WS_XN = 146 * MiB;
constexpr size_t WS_PROJ = 210 * MiB;
constexpr size_t WS_FZ = 466 * MiB;
constexpr size_t WS_F = 467 * MiB;
constexpr size_t WS_U = 468 * MiB;
constexpr size_t WS_DG = 480 * MiB;
constexpr size_t WS_END = 481 * MiB;
constexpr size_t SLOT = (size_t)M * D;
constexpr int CW_TMO = 0, CW_CODE = 1;
constexpr int CW_BAR = 4096;
constexpr int CW_ATT = 16384;
constexpr int CW_SS = 32768;
constexpr int RING_OFF = 0, RING_BYTES = 131072;
constexpr int SCRATCH_BYTES = 139264;
constexpr int LDSCTL_OFF = SCRATCH_BYTES, MISC_OFF = LDSCTL_OFF + 320;
constexpr int LDS_BYTES = 147456;
static_assert(MISC_OFF + 128 <= LDS_BYTES, "LDS map");

struct Frame {
    LAS unsigned char* lds;
    volatile LAS unsigned* MISC;
    gu32* ctl;
    int tid, lane, wave;
    int vcu, G;
};
__device__ __forceinline__ void phase_tid(Frame& F) { int t = threadIdx.x; asm volatile("" : "+v"(t)); F.tid = t; F.lane = t & 63; F.wave = __builtin_amdgcn_readfirstlane(t >> 6); }

__device__ __forceinline__ float wave_sum(float v) {
#pragma unroll
    for (int o = 1; o < 64; o <<= 1) v += __shfl_xor(v, o);
    return v;
}
__device__ __forceinline__ float bf2f(unsigned short b) { return __uint_as_float((unsigned)b << 16); }
__device__ __forceinline__ float bflo(unsigned w) { return __uint_as_float(w << 16); }
__device__ __forceinline__ float bfhi(unsigned w) { return __uint_as_float(w & 0xffff0000u); }

__device__ __forceinline__ void p0_transpose_item(const float* W, int ldw, int ncols, const float* nw, bf16* WT, LAS float* scr, int item, int lane) {
    const int nblk = ncols / 32, kb = item / nblk, nb = item % nblk, k0 = 64 * kb, n0 = 32 * nb;
#pragma unroll 8
    for (int i = 0; i < 32; ++i) { const int kk = 2 * i + (lane >> 5); const float s = nw ? nw[k0 + kk] : 1.f; scr[kk * 33 + (lane & 31)] = W[(size_t)(k0 + kk) * ldw + n0 + (lane & 31)] * s; }
    LDS_WAIT(); asm volatile("" ::: "memory");
    const int c = lane & 7;
#pragma unroll
    for (int j = 0; j < 4; ++j) { const int n = (lane >> 3) + 8 * j; const LAS float* s = scr + (8 * c) * 33 + n;
        v4u o; o.x = pk2(s[0 * 33], s[1 * 33]); o.y = pk2(s[2 * 33], s[3 * 33]); o.z = pk2(s[4 * 33], s[5 * 33]); o.w = pk2(s[6 * 33], s[7 * 33]);
        *(GAS v4u*)(WT + (size_t)(n0 + n) * D + k0 + 8 * c) = o; }
    LDS_WAIT(); asm volatile("" ::: "memory");
}
__device__ __forceinline__ void xb_rows(Frame& F, const float* xin, bf16* xb, float* ss) {
    const int gw = F.vcu * NWAVES + F.wave, NGW = F.G * NWAVES;
    for (int m = gw; m < M; m += NGW) {
        const GAS f32x4* xr = (const GAS f32x4*)(xin + (size_t)m * D) + F.lane;
        f32x4 v[8]; float s = 0.f;
#pragma unroll
        for (int j = 0; j < 8; ++j) { v[j] = xr[64 * j]; s += (v[j].x * v[j].x + v[j].y * v[j].y) + (v[j].z * v[j].z + v[j].w * v[j].w); }
        s = wave_sum(s);
        GAS unsigned long long* o8 = (GAS unsigned long long*)(xb + (size_t)m * D) + F.lane;
#pragma unroll
        for (int j = 0; j < 8; ++j) o8[64 * j] = (unsigned long long)pk2(v[j].x, v[j].y) | ((unsigned long long)pk2(v[j].z, v[j].w) << 32);
        if (F.lane == 0) ss[m] = s;
    }
}
__device__ __forceinline__ void p0_prologue(Frame& F, const float* const* in, unsigned char* ws) {
    LAS float* scr = (LAS float*)(F.lds + RING_OFF + F.wave * 16384);
    const int gw = F.vcu * NWAVES + F.wave, NGW = F.G * NWAVES;
    constexpr int I_INA = 32 * 256, I_SQ = 32 * 64, I_4K = 32 * 128;
    constexpr int NITEMS = 2 * I_INA + 2 * I_SQ + 3 * I_4K + 2 * I_SQ;
    for (int it = gw; it < NITEMS; it += NGW) {
        int r = it;
        if (r < 2 * I_INA) { const int l = r / I_INA; r -= l * I_INA; p0_transpose_item(in[2] + (size_t)l * D * NPA, NPA, NPA, in[1] + l * D, (bf16*)(ws + WS_WINA) + (size_t)l * NPA * D, scr, r, F.lane); continue; } r -= 2 * I_INA;
        if (r < 2 * I_SQ) { const int l = r / I_SQ; r -= l * I_SQ; p0_transpose_item(in[5] + (size_t)l * D * D, D, D, nullptr, (bf16*)(ws + WS_WOUTA) + (size_t)l * D * D, scr, r, F.lane); continue; } r -= 2 * I_SQ;
        if (r < I_4K) { p0_transpose_item(in[7], 2 * D + H, 2 * D, in[6], (bf16*)(ws + WS_WKVQ), scr, r, F.lane); continue; } r -= I_4K;
        if (r < I_4K) { p0_transpose_item(in[11], 2 * D, 2 * D, in[10], (bf16*)(ws + WS_WKVQ) + (size_t)2 * D * D, scr, r, F.lane); continue; } r -= I_4K;
        if (r < I_4K) { p0_transpose_item(in[11] + (size_t)D * 2 * D, 2 * D, 2 * D, in[10] + D, (bf16*)(ws + WS_WINB1), scr, r, F.lane); continue; } r -= I_4K;
        { const int l = r / I_SQ; r -= l * I_SQ; p0_transpose_item(in[14] + (size_t)l * D * D, D, D, nullptr, (bf16*)(ws + WS_WOUTB) + (size_t)l * D * D, scr, r, F.lane); }
    }
    xb_rows(F, in[0], (bf16*)(ws + WS_XN), (float*)(F.ctl + CW_SS));
}
__device__ __forceinline__ float sum16(float v) { v += __shfl_xor(v, 1); v += __shfl_xor(v, 2); v += __shfl_xor(v, 4); v += __shfl_xor(v, 8); return v; }
__device__ __forceinline__ void headnorm_rows(Frame& F, bf16* X, const float* w) {
    const int gw = F.vcu * NWAVES + F.wave, NGW = F.G * NWAVES;
    for (int m = gw; m < M; m += NGW) {
        GAS v4u* xr = (GAS v4u*)(X + (size_t)m * D) + F.lane;
#pragma unroll
        for (int j = 0; j < 4; ++j) {
            const v4u x = xr[64 * j]; float f[8] = {bflo(x.x), bfhi(x.x), bflo(x.y), bfhi(x.y), bflo(x.z), bfhi(x.z), bflo(x.w), bfhi(x.w)};
            float s = 0.f;
#pragma unroll
            for (int e = 0; e < 8; ++e) s += f[e] * f[e];
            const float r = 1.0f / sqrtf(sum16(s) * (1.f / HD) + EPS);
            const int d0 = (8 * F.lane) & 127;
            const f32x4 w0 = *(const f32x4*)(w + d0), w1 = *(const f32x4*)(w + d0 + 4);
            v4u o; o.x = pk2(f[0] * r * w0.x, f[1] * r * w0.y); o.y = pk2(f[2] * r * w0.z, f[3] * r * w0.w); o.z = pk2(f[4] * r * w1.x, f[5] * r * w1.y); o.w = pk2(f[6] * r * w1.z, f[7] * r * w1.w);
            xr[64 * j] = o;
        }
    }
}
__device__ __forceinline__ float silu_f(float g) { return g / (1.f + __expf(-g)); }
__device__ __forceinline__ void gatenorm_rows(Frame& F, bf16* O, const bf16* G, const float* w) {
    const int gw = F.vcu * NWAVES + F.wave, NGW = F.G * NWAVES;
    for (int m = gw; m < M; m += NGW) {
        GAS v4u* xr = (GAS v4u*)(O + (size_t)m * D) + F.lane; const GAS v4u* gr = (const GAS v4u*)(G + (size_t)m * D) + F.lane;
#pragma unroll
        for (int j = 0; j < 4; ++j) {
            const v4u x = xr[64 * j], g = gr[64 * j];
            float f[8] = {bflo(x.x), bfhi(x.x), bflo(x.y), bfhi(x.y), bflo(x.z), bfhi(x.z), bflo(x.w), bfhi(x.w)};
            const float q[8] = {bflo(g.x), bfhi(g.x), bflo(g.y), bfhi(g.y), bflo(g.z), bfhi(g.z), bflo(g.w), bfhi(g.w)};
            float s = 0.f;
#pragma unroll
            for (int e = 0; e < 8; ++e) s += f[e] * f[e];
            const float r = 1.0f / sqrtf(sum16(s) * (1.f / HD) + EPS);
            const int c0 = 8 * (F.lane + 64 * j);
            const f32x4 w0 = *(const f32x4*)(w + c0), w1 = *(const f32x4*)(w + c0 + 4);
            const float ww[8] = {w0.x, w0.y, w0.z, w0.w, w1.x, w1.y, w1.z, w1.w};
#pragma unroll
            for (int e = 0; e < 8; ++e) f[e] = f[e] * r * ww[e] * silu_f(q[e]);
            v4u o; o.x = pk2(f[0], f[1]); o.y = pk2(f[2], f[3]); o.z = pk2(f[4], f[5]); o.w = pk2(f[6], f[7]);
            xr[64 * j] = o;
        }
    }
}
__device__ __forceinline__ void fz_rows(Frame& F, const bf16* xn, const float* ss, const float* kvw, const float* kvnw, const float* fbias, float* fzls) {
    LAS float* wf = (LAS float*)(F.lds);
    for (int idx = F.tid; idx < D * 16; idx += NWAVES * 64) { const int k = idx >> 4, j = idx & 15; wf[k * 16 + (k >> 3) * 4 + j] = kvw[(size_t)k * (2 * D + H) + 2 * D + j] * kvnw[k]; }
    __syncthreads();
    const int gw = F.vcu * NWAVES + F.wave, NGW = F.G * NWAVES;
    for (int m = gw; m < M; m += NGW) {
        const GAS v4u* xr = (const GAS v4u*)(xn + (size_t)m * D) + F.lane;
        float acc[16];
#pragma unroll
        for (int j = 0; j < 16; ++j) acc[j] = 0.f;
#pragma unroll 1
        for (int jj = 0; jj < 4; ++jj) {
            const v4u x = xr[64 * jj]; const float f[8] = {bflo(x.x), bfhi(x.x), bflo(x.y), bfhi(x.y), bflo(x.z), bfhi(x.z), bflo(x.w), bfhi(x.w)};
            const int c = F.lane + 64 * jj;
#pragma unroll 2
            for (int e = 0; e < 8; ++e) { const LAS f32x4* wr = (const LAS f32x4*)(wf + (8 * c + e) * 16 + c * 4);
#pragma unroll
                for (int q = 0; q < 4; ++q) { const f32x4 w4 = wr[q]; acc[4 * q + 0] += f[e] * w4.x; acc[4 * q + 1] += f[e] * w4.y; acc[4 * q + 2] += f[e] * w4.z; acc[4 * q + 3] += f[e] * w4.w; } }
        }
        float mine = 0.f;
#pragma unroll
        for (int j = 0; j < 16; ++j) { const float s = wave_sum(acc[j]); if (F.lane == j) mine = s; }
        if (F.lane < 16) { const float z = mine * (1.0f / sqrtf(ss[m] * (1.f / D) + EPS)) + fbias[F.lane]; fzls[(size_t)m * 16 + F.lane] = fminf(z, 0.f) - __logf(1.f + __expf(-fabsf(z))); }
    }
    __syncthreads();
}
__device__ __forceinline__ void fscan(Frame& F, const float* fzls, float* Fo) {
    LAS float* wt = (LAS float*)(F.lds);
    for (int u = blockIdx.x; u < BATCH * H; u += F.G) {
        const int b = u / H, h = u % H, t0 = F.tid * 8;
        float v[8];
#pragma unroll
        for (int e = 0; e < 8; ++e) v[e] = fzls[(size_t)(b * T + t0 + e) * 16 + h];
#pragma unroll
        for (int e = 1; e < 8; ++e) v[e] += v[e - 1];
        float incl = v[7];
#pragma unroll
        for (int o = 1; o < 64; o <<= 1) { const float n = __shfl_up(incl, o); if (F.lane >= o) incl += n; }
        if (F.lane == 63) wt[F.wave] = incl;
        __syncthreads();
        float base = incl - v[7];
        for (int w = 0; w < F.wave; ++w) base += wt[w];
#pragma unroll
        for (int e = 0; e < 8; ++e) Fo[(size_t)u * T + t0 + e] = -(v[e] + base) * fox::INVS;
        __syncthreads();
    }
}
__device__ __forceinline__ fox::BlockRef attn_ref(int L, const bf16* Q, const bf16* K, const bf16* V, bf16* O, const bf16* G, const float* wo, const float* Fc, float TH) {
    const int bh = L & 63, qb = 15 - (L >> 6), b = bh / H, h = bh % H;
    fox::BlockRef r; const size_t base = (size_t)b * T * D + h * HD;
    r.Q = (const fox::bf16*)Q + base + (size_t)qb * 256 * D; r.O = (fox::bf16*)O + base + (size_t)qb * 256 * D; r.K = (const fox::bf16*)K + base; r.V = (const fox::bf16*)V + base;
    r.G = (const fox::bf16*)G + base + (size_t)qb * 256 * D; r.wo = wo + h * HD;
    r.F = Fc + (size_t)bh * T; r.P0 = qb * 256; r.jlo = fox::fox_jlo(r.F, r.P0, TH); return r;
}
__device__ __forceinline__ float attn_threshold(Frame& F, const float* wq, const float* wk) {
    float a = fmaxf(fabsf(wq[F.lane]), fabsf(wq[F.lane + 64])), c = fmaxf(fabsf(wk[F.lane]), fabsf(wk[F.lane + 64]));
#pragma unroll
    for (int o = 1; o < 64; o <<= 1) { a = fmaxf(a, __shfl_xor(a, o)); c = fmaxf(c, __shfl_xor(c, o)); }
    return 2.f * (128.f * 1.02f * a * c) + 152.f / (1.4426950408889634f * fox::SCALE);
}
__device__ __forceinline__ void attn_phase(Frame& F, char* lds, const bf16* Q, const bf16* K, const bf16* V, bf16* O, const bf16* G, const float* wo, const float* wq, const float* Fc, gu32* ctr, float TH) {
    constexpr int total = BATCH * H * 16;
    volatile LAS int* tk = (volatile LAS int*)(F.lds + 69632);
    if (F.tid == 0) { tk[0] = (int)__hip_atomic_fetch_add(ctr, 1u, RLX_AGENT); tk[1] = (int)__hip_atomic_fetch_add(ctr, 1u, RLX_AGENT); }
    __syncthreads();
    int Lc = tk[0], Ln = tk[1];
    if (Lc >= total) return;
    fox::BlockRef cur = attn_ref(Lc, Q, K, V, O, G, wo, Fc, TH);
    fox::Seam S;
    fox::causal_prime(cur, lds, S);
    for (int i = 0;; ++i) {
        if (F.tid == 0) tk[2 + (i & 1)] = (int)__hip_atomic_fetch_add(ctr, 1u, RLX_AGENT);
        const bool has_next = Ln < total;
        const fox::BlockRef nxt = has_next ? attn_ref(Ln, Q, K, V, O, G, wo, Fc, TH) : cur;
        fox::causal_block(cur, nxt, lds, S, wq);
        if (!has_next) break;
        const int L2 = tk[2 + (i & 1)];
        cur = nxt; Lc = Ln; Ln = L2;
    }
}

constexpr int NPHASE = 29;
__host__ __device__ constexpr bool phase_live(int id) {
    if (id == 0) return true;
    const int L = (id - 1) / 7, s = (id - 1) % 7;
    if (s == 1) return L == 2;
    if (s == 2) return L <= 2;
    if (s == 6) return false;
    if (s == 4) return L < 2;
    return true;
}
struct Args { const float* in[15]; float* out; unsigned char* ws; int ph_lo, ph_hi; };
__global__ void __launch_bounds__(NWAVES * 64, 2) fwd_kernel(Args args) {
    extern __shared__ __attribute__((aligned(16))) unsigned char lds[];
    Frame F;
    F.lds = (LAS unsigned char*)lds;
    F.MISC = (volatile LAS unsigned*)(F.lds + MISC_OFF);
    phase_tid(F);
    F.G = gridDim.x; { const int bx = blockIdx.x; F.vcu = (F.G % 8 == 0) ? (bx % 8) * (F.G / 8) + bx / 8 : bx; }
    unsigned char* ws = args.ws;
    F.ctl = (gu32*)(ws + WS_CTL);
    for (int u = F.tid; u < (LDS_BYTES - LDSCTL_OFF) / 4; u += NWAVES * 64) ((LAS unsigned*)(F.lds + LDSCTL_OFF))[u] = 0u;
    __syncthreads();
#if ONE_LAUNCH
    XcdBarrier bar = xcd_barrier_post((unsigned*)(F.ctl + CW_BAR), F.MISC + 8);
#define GRID_BAR() xcd_barrier(bar)
#else
#define GRID_BAR() do {} while (0)
#endif
    const int lo = args.ph_lo, hi = args.ph_hi;
#define IN(k) (lo <= (k) && (k) < hi)
#define SEAM(k) do { if ((k) + 1 < hi) GRID_BAR(); } while (0)
    const float* const* in = args.in;
    bf16* XN = (bf16*)(ws + WS_XN); bf16* PROJ = (bf16*)(ws + WS_PROJ); float* SS = (float*)(F.ctl + CW_SS);
    float* FZ = (float*)(ws + WS_FZ); float* FC = (float*)(ws + WS_F);

    #ifndef NO_P0
    if (IN(0)) { phase_tid(F); p0_prologue(F, in, ws); SEAM(0); }
#endif

#ifdef PROBE_CLK
    long long pc0 = 0; unsigned long long pr0 = 0, probe_us = 0;
#endif
#pragma unroll 1
    for (int L = 0; L < 4; ++L) {
        const int pb = 1 + 7 * L; const bool isA = L < 2; const int j = L & 1;
        if (IN(pb + 0)) {
#ifdef PROBE_CLK
            if (L == PROBE_CLK - 1) { pc0 = clock64(); pr0 = __builtin_amdgcn_s_memrealtime(); }
#endif
            const bf16* Bt = isA ? (const bf16*)(ws + WS_WINA) + (size_t)j * NPA * D : (L == 2 ? (const bf16*)(ws + WS_WKVQ) : (const bf16*)(ws + WS_WINB1));
            const int N = (L == 3) ? 2 * D : NPA;
            bf16* outp = (L == 3) ? PROJ + 2 * SLOT : PROJ;
            pg8::Gemm g{XN, Bt, M, N, D}; pg8::StaticOrder S; S.init(M, N, F.G, (int)blockIdx.x);
            pg8::EpiBf16R E{outp, D, D, SLOT, SS + (size_t)L * M, 1.f / D, EPS};
#ifndef NO_G1
            pg8::gemm_phase<pg8::EpiBf16R, pg8::StaticOrder, true, true>(F.lds + RING_OFF, g, S, E);
#ifdef DUP_GIN
            pg8::gemm_phase<pg8::EpiBf16R, pg8::StaticOrder, true, true>(F.lds + RING_OFF, g, S, E);
#endif
#ifdef DUP_GIN_NOEPI
            { pg8::EpiNull E0;
#ifdef PROBE_L2RES
              pg8::RepeatOrder S2; S2.n = (M / 256) * (N / 256) / F.G; S2.c = (int)blockIdx.x;
              pg8::gemm_phase<pg8::EpiNull, pg8::RepeatOrder, true, true, false>(F.lds + RING_OFF, g, S2, E0);
#else
              pg8::gemm_phase<pg8::EpiNull, pg8::StaticOrder, true, true, PROBE_BLK>(F.lds + RING_OFF, g, S, E0);
#endif
            }
#endif
#endif
#ifdef PROBE_CLK
            if (L == PROBE_CLK - 1) { const long long dc = clock64() - pc0; const unsigned long long dr = __builtin_amdgcn_s_memrealtime() - pr0; probe_us = PROBE_MODE == 0 ? (unsigned long long)(dc * 100 / (long long)dr) : (unsigned long long)(dc / 256);
              if (PROBE_MODE >= 2 && threadIdx.x == 0) { if (PROBE_MODE == 2) atomicMax((unsigned*)(F.ctl + 2048), (unsigned)probe_us); else atomicMin((unsigned*)(F.ctl + 2048), 0x7fffffffu - (unsigned)probe_us); } }
#endif
            SEAM(pb + 0);
        }
        if (IN(pb + 1) && L == 2) { phase_tid(F);
#ifndef NO_FZ
            if (L == 2) { fz_rows(F, XN, SS + (size_t)L * M, in[7], in[6], in[8], FZ); headnorm_rows(F, PROJ, in[9]); }
#endif
            SEAM(pb + 1);
        }
        if (IN(pb + 2) && L == 2) { phase_tid(F); fscan(F, FZ, FC); SEAM(pb + 2); }
        if (IN(pb + 2) && isA) {
            rec::run<false>(F.lds + RING_OFF, F.G, PROJ, PROJ + SLOT, PROJ + 2 * SLOT, PROJ, in[3], L, (float*)(ws + WS_U), (float*)(ws + WS_DG));
#ifdef DUP_REC
            rec::run<false>(F.lds + RING_OFF, F.G, PROJ, PROJ + SLOT, PROJ + 2 * SLOT, PROJ, in[3], L, (float*)(ws + WS_U), (float*)(ws + WS_DG));
#endif
            SEAM(pb + 2);
        }
        if (IN(pb + 3)) { phase_tid(F);
#ifndef NO_REC
            if (isA) rec::run<true>(F.lds + RING_OFF, F.G, PROJ, PROJ + SLOT, PROJ + 2 * SLOT, PROJ, in[3], L, (float*)(ws + WS_U), (float*)(ws + WS_DG));
#ifdef DUP_REC
            if (isA) rec::run<true>(F.lds + RING_OFF, F.G, PROJ, PROJ + SLOT, PROJ + 2 * SLOT, PROJ, in[3], L, (float*)(ws + WS_U), (float*)(ws + WS_DG));
#endif
#endif
#ifndef NO_ATT
            if (!isA) attn_phase(F, (char*)lds + RING_OFF, PROJ + 2 * SLOT, PROJ, PROJ + SLOT, PROJ + 2 * SLOT, PROJ + 3 * SLOT, in[13] + j * D, in[12] + j * HD, FC, F.ctl + CW_ATT + 64 * j, attn_threshold(F, in[12] + j * HD, in[9]));
#ifdef DUP_ATT
            if (!isA) { __syncthreads(); attn_phase(F, (char*)lds + RING_OFF, PROJ + 2 * SLOT, PROJ, PROJ + SLOT, PROJ + 2 * SLOT, PROJ + 3 * SLOT, in[13] + j * D, in[12] + j * HD, FC, F.ctl + CW_ATT + 64 * (j + 2), attn_threshold(F, in[12] + j * HD, in[9])); }
#endif
#endif
            SEAM(pb + 3);
        }
        bf16* OB = isA ? PROJ : PROJ + 2 * SLOT;
        if (IN(pb + 4) && isA) { phase_tid(F); gatenorm_rows(F, OB, PROJ + 3 * SLOT, (isA ? in[4] : in[13]) + j * D); SEAM(pb + 4); }
        if (IN(pb + 5)) {
            const bf16* Bt = (const bf16*)(ws + (isA ? WS_WOUTA : WS_WOUTB)) + (size_t)j * D * D;
            pg8::Gemm g{OB, Bt, M, D, D}; pg8::StaticOrder S; S.init(M, D, F.G, (int)blockIdx.x);
            pg8::EpiResX E{L == 0 ? in[0] : args.out, args.out, D, L < 3 ? XN : nullptr, SS + (size_t)(L + 1 < 4 ? L + 1 : 3) * M};
#ifndef NO_G2
            pg8::gemm_phase<pg8::EpiResX, pg8::StaticOrder, true, true>(F.lds + RING_OFF, g, S, E);
#endif
            SEAM(pb + 5);
        }
    }
#ifdef PROBE_CLK
    if (PROBE_MODE >= 2) { __syncthreads(); unsigned v = __hip_atomic_load((unsigned*)(F.ctl + 2048), __ATOMIC_RELAXED, __HIP_MEMORY_SCOPE_AGENT); probe_us = PROBE_MODE == 2 ? v : v; }
    if (blockIdx.x == 0 && threadIdx.x == 0) { const unsigned long long t0 = __builtin_amdgcn_s_memrealtime(); while (__builtin_amdgcn_s_memrealtime() - t0 < probe_us * 100ull) __builtin_amdgcn_s_sleep(10); }
#endif
#undef IN
#undef SEAM
}

extern "C" void kernel_launch(void* const* d_in, const int* in_sizes, int n_in, void* d_out, int out_size, void* d_ws, size_t ws_size, hipStream_t stream) {
    static int grid = 0;
    if (grid == 0) {
        if (n_in != 15 || in_sizes[0] != M * D || out_size != M * D || ws_size < WS_END) { fprintf(stderr, "kernel_launch: unexpected shapes (n_in %d, in0 %d, out %d, ws %zu)\n", n_in, n_in > 0 ? in_sizes[0] : -1, out_size, ws_size); grid = -1; return; }
        int dev = 0, cus = 0;
        if (hipGetDevice(&dev) != hipSuccess || hipDeviceGetAttribute(&cus, hipDeviceAttributeMultiprocessorCount, dev) != hipSuccess) { grid = -1; return; }
        if (hipFuncSetAttribute((const void*)fwd_kernel, hipFuncAttributeMaxDynamicSharedMemorySize, LDS_BYTES) != hipSuccess) { fprintf(stderr, "kernel_launch: hipFuncSetAttribute failed\n"); grid = -1; return; }
        int per_cu = 0;
        if (hipOccupancyMaxActiveBlocksPerMultiprocessor(&per_cu, (const void*)fwd_kernel, NWAVES * 64, LDS_BYTES) != hipSuccess || per_cu < 1) fprintf(stderr, "kernel_launch: occupancy query says %d\n", per_cu);
        (void)hipGetLastError();
        grid = cus;
    }
    if (grid < 0) return;
    (void)hipMemsetAsync((char*)d_ws + WS_CTL, 0, CTL_ZERO_BYTES, stream);
    Args a{};
    for (int i = 0; i < 15; ++i) a.in[i] = (const float*)d_in[i];
    a.out = (float*)d_out; a.ws = (unsigned char*)d_ws;
#if ONE_LAUNCH
    a.ph_lo = 0; a.ph_hi = NPHASE;
    hipLaunchKernelGGL(fwd_kernel, dim3(grid), dim3(NWAVES * 64), LDS_BYTES, stream, a);
#else
    for (int p = 0; p < NPHASE; ++p) { if (!phase_live(p)) continue; a.ph_lo = p; a.ph_hi = p + 1; hipLaunchKernelGGL(fwd_kernel, dim3(grid), dim3(NWAVES * 64), LDS_BYTES, stream, a); }
#endif
}
```

```cpp
#include <hip/hip_runtime.h>
#include <hip/hip_bf16.h>
#include <cstdio>
#include <cstdint>
#include <cmath>
namespace pg8 {
#define PG8_LAS __attribute__((address_space(3)))
typedef unsigned short bf16_t;
typedef short bf16x8 __attribute__((ext_vector_type(8)));
typedef float f32x4 __attribute__((ext_vector_type(4)));
typedef unsigned u32x4 __attribute__((ext_vector_type(4)));
constexpr int BM = 256, BK = 64, HALF = 128, HTB = HALF * BK * 2  , STAGE_BYTES = 8 * HTB, NXCD = 8, WGM = 8;

__host__ __device__ __forceinline__ int lds_byte(int r, int c) { const int st = (r >> 4) * 2 + (c >> 5), rr = r & 15, cc = c & 31, ob = rr * 64 + cc * 2; return st * 1024 + (ob ^ (((ob >> 9) & 1) << 5)); }
__host__ __device__ __forceinline__ void stage_rc(int b, int& R, int& C) { const int st = b / 1024, sb = b % 1024, swz = sb ^ (((sb >> 9) & 1) << 5); R = (st >> 1) * 16 + swz / 64; C = (st & 1) * 32 + (swz % 64) / 2; }
__host__ __device__ __forceinline__ int perm32(int rho) { const int n = rho >> 4, i = rho & 15; return 8 * (i >> 2) + 4 * n + (i & 3); }

struct Unit { int pm, pn; };
struct Gemm { const bf16_t* A; const bf16_t* Bt; int M, N, K; };

struct StaticOrder {
    int nM, nN, nwg, G, c;
    __host__ __device__ void init(int M, int N, int G_, int c_) { nM = M / BM; nN = N / BM; nwg = nM * nN; G = G_; c = c_; }
    __host__ __device__ bool next(int i, Unit& u) const {
        const long L = (long)i * G + c; if (L >= nwg) return false;
        int wgid = (int)L; { const int q = nwg / NXCD, r = nwg % NXCD, xcd = wgid % NXCD, off = wgid / NXCD; wgid = (xcd < r ? xcd * (q + 1) : r * (q + 1) + (xcd - r) * q) + off; }
        const int nig = WGM * nN, gid = wgid / nig, fm = gid * WGM, gsz = (nM - fm) < WGM ? (nM - fm) : WGM;
        u.pm = fm + ((wgid % nig) % gsz); u.pn = (wgid % nig) / gsz; return true;
    }
    __device__ __forceinline__ void a_ready(const Unit&) const {}
    __device__ __forceinline__ void done(const Unit&) const {}
};

__device__ __forceinline__ unsigned cvt_pk_bf16(float lo, float hi) { unsigned r; asm volatile("v_cvt_pk_bf16_f32 %0, %1, %2" : "=v"(r) : "v"(lo), "v"(hi)); return r; }
typedef float f32x2 __attribute__((ext_vector_type(2)));
__device__ __forceinline__ f32x2 gelu_pk(f32x2 v) {
    const f32x2 av = __builtin_elementwise_abs(v), d = av * 0.2316418882f + 1.0f;
    f32x2 t; t.x = __builtin_amdgcn_rcpf(d.x); t.y = __builtin_amdgcn_rcpf(d.y);
    f32x2 q = t * 0.5307027145f + (-0.7265760135f); q = q * t + 0.7107068705f; q = q * t + (-0.142248368f); q = q * t + 0.127414796f; q = q * t;
    const f32x2 s = (v * v) * (-0.72134752044f);
    f32x2 e; e.x = __builtin_amdgcn_exp2f(s.x); e.y = __builtin_amdgcn_exp2f(s.y);
    const f32x2 m = v * (q * e), r = v - m;
    f32x2 o; o.x = v.x < 0.f ? m.x : r.x; o.y = v.y < 0.f ? m.y : r.y; return o;
}

template <int ACT  > struct EpiBf16 {
    static constexpr bool PERM = true, AFTER_DRAIN = false; static_assert(ACT == 0 || ACT == 1, "EpiBf16: ACT is 0 (none) or 1 (gelu_pk)");
    bf16_t* O; int ldc; const float* bias; int split_cols; size_t split_stride; float scale0;
    __device__ __forceinline__ void operator()(const f32x4 (&acc)[2][2][4][2], const Unit& u, int wr, int wc, int fr, int fq) const {
        const int row0 = u.pm * BM + wr * 64 + fr; int colt = u.pn * BM; bf16_t* base = O;
        float sc = 1.f; if (split_cols) { const int t = colt / split_cols; base += (size_t)t * split_stride; colt -= t * split_cols; if (t == 0) sc = scale0; }
        const int col0 = colt + wc * 32 + 8 * fq, bcol0 = u.pn * BM + wc * 32 + 8 * fq;
        f32x4 bv[2][2];
#pragma unroll
        for (int bj = 0; bj < 2; ++bj)
#pragma unroll
            for (int n = 0; n < 2; ++n) bv[bj][n] = bias ? *(const f32x4*)(bias + bcol0 + bj * HALF + 4 * n) : (f32x4){0.f, 0.f, 0.f, 0.f};
#pragma unroll
        for (int ai = 0; ai < 2; ++ai)
#pragma unroll
            for (int m = 0; m < 4; ++m) { bf16_t* rowp = base + (size_t)(row0 + ai * HALF + m * 16) * ldc + col0;
#pragma unroll
                for (int bj = 0; bj < 2; ++bj) { f32x4 v0 = acc[ai][bj][m][0] + bv[bj][0], v1 = acc[ai][bj][m][1] + bv[bj][1];
                    if (ACT == 1) { f32x2 a = gelu_pk((f32x2){v0[0], v0[1]}), b = gelu_pk((f32x2){v0[2], v0[3]}), c = gelu_pk((f32x2){v1[0], v1[1]}), d = gelu_pk((f32x2){v1[2], v1[3]});
                        v0 = (f32x4){a.x, a.y, b.x, b.y}; v1 = (f32x4){c.x, c.y, d.x, d.y}; }
                    v0 = v0 * sc; v1 = v1 * sc; u32x4 w; w.x = cvt_pk_bf16(v0[0], v0[1]); w.y = cvt_pk_bf16(v0[2], v0[3]); w.z = cvt_pk_bf16(v1[0], v1[1]); w.w = cvt_pk_bf16(v1[2], v1[3]);
                    *(u32x4*)(rowp + bj * HALF) = w; } }
    }
};
struct EpiRes {
    static constexpr bool PERM = false, AFTER_DRAIN = false;
    const float* res; float* out; int ldc;
    __device__ __forceinline__ void operator()(const f32x4 (&acc)[2][2][4][2], const Unit& u, int wr, int wc, int fr, int fq) const {
        const int row0 = u.pm * BM + wr * 64 + fr, col0 = u.pn * BM + wc * 32 + 4 * fq;
#pragma unroll
        for (int ai = 0; ai < 2; ++ai)
#pragma unroll
            for (int m = 0; m < 4; ++m) { const size_t off = (size_t)(row0 + ai * HALF + m * 16) * ldc + col0;
                f32x4 r[2][2];
#pragma unroll
                for (int bj = 0; bj < 2; ++bj)
#pragma unroll
                    for (int n = 0; n < 2; ++n) r[bj][n] = *(const f32x4*)(res + off + bj * HALF + n * 16);
#pragma unroll
                for (int bj = 0; bj < 2; ++bj)
#pragma unroll
                    for (int n = 0; n < 2; ++n) *(f32x4*)(out + off + bj * HALF + n * 16) = r[bj][n] + acc[ai][bj][m][n]; }
    }
};
struct EpiBf16R {
    static constexpr bool PERM = true, AFTER_DRAIN = false;
    bf16_t* O; int ldc; int split_cols; size_t split_stride; const unsigned long long* ss; float inv_k, eps;
    __device__ __forceinline__ void operator()(const f32x4 (&acc)[2][2][4][2], const Unit& u, int wr, int wc, int fr, int fq) const {
        const int row0 = u.pm * BM + wr * 64 + fr; int colt = u.pn * BM; bf16_t* base = O;
        { const int t = colt / split_cols; base += (size_t)t * split_stride; colt -= t * split_cols; }
        const int col0 = colt + wc * 32 + 8 * fq;
        float rs[2][4];
#pragma unroll
        for (int ai = 0; ai < 2; ++ai)
#pragma unroll
            for (int m = 0; m < 4; ++m) rs[ai][m] = (float)ss[row0 + ai * HALF + m * 16] * (1.0f / 16777216.0f);
#pragma unroll
        for (int ai = 0; ai < 2; ++ai)
#pragma unroll
            for (int m = 0; m < 4; ++m) { bf16_t* rowp = base + (size_t)(row0 + ai * HALF + m * 16) * ldc + col0;
                const float sc = __builtin_amdgcn_rsqf(rs[ai][m] * inv_k + eps);
#pragma unroll
                for (int bj = 0; bj < 2; ++bj) { const f32x4 v0 = acc[ai][bj][m][0] * sc, v1 = acc[ai][bj][m][1] * sc;
                    u32x4 w; w.x = cvt_pk_bf16(v0[0], v0[1]); w.y = cvt_pk_bf16(v0[2], v0[3]); w.z = cvt_pk_bf16(v1[0], v1[1]); w.w = cvt_pk_bf16(v1[2], v1[3]);
                    *(u32x4*)(rowp + bj * HALF) = w; } }
    }
};
struct EpiResX {
    static constexpr bool PERM = false, AFTER_DRAIN = false;
    const float* res; float* out; int ldc; bf16_t* xb; unsigned long long* ssn;
    __device__ __forceinline__ void operator()(const f32x4 (&acc)[2][2][4][2], const Unit& u, int wr, int wc, int fr, int fq) const {
        typedef unsigned u32x2 __attribute__((ext_vector_type(2)));
        const int row0 = u.pm * BM + wr * 64 + fr, col0 = u.pn * BM + wc * 32 + 4 * fq;
#pragma unroll
        for (int ai = 0; ai < 2; ++ai)
#pragma unroll
            for (int m = 0; m < 4; ++m) { const int row = row0 + ai * HALF + m * 16; const size_t off = (size_t)row * ldc + col0;
                float s = 0.f;
#pragma unroll
                for (int bj = 0; bj < 2; ++bj) { const f32x4 r0 = *(const f32x4*)(res + off + bj * HALF), r1 = *(const f32x4*)(res + off + bj * HALF + 16);
#pragma unroll
                    for (int n = 0; n < 2; ++n) { const f32x4 o = (n ? r1 : r0) + acc[ai][bj][m][n]; *(f32x4*)(out + off + bj * HALF + n * 16) = o;
                        if (xb) { u32x2 w; w.x = cvt_pk_bf16(o[0], o[1]); w.y = cvt_pk_bf16(o[2], o[3]); *(u32x2*)(xb + off + bj * HALF + n * 16) = w;
                                  s += (o[0] * o[0] + o[1] * o[1]) + (o[2] * o[2] + o[3] * o[3]); } } }
                if (xb) { s += __shfl_xor(s, 16); s += __shfl_xor(s, 32); if (fq == 0) atomicAdd(ssn + row, (unsigned long long)(s * 16777216.0f)); } }
    }
};
struct EpiNull {
    static constexpr bool PERM = true, AFTER_DRAIN = false;
    __device__ __forceinline__ void operator()(const f32x4 (&acc)[2][2][4][2], const Unit& u, int wr, int wc, int fr, int fq) const {
#pragma unroll
        for (int ai = 0; ai < 2; ++ai)
#pragma unroll
            for (int bj = 0; bj < 2; ++bj)
#pragma unroll
                for (int m = 0; m < 4; ++m)
#pragma unroll
                    for (int n = 0; n < 2; ++n) asm volatile("" :: "v"(acc[ai][bj][m][n]));
    }
};
struct RepeatOrder {
    int n, c;
    __device__ bool next(int i, Unit& u) const { if (i >= n) return false; u.pm = c & 1; u.pn = 0; return true; }
    __device__ __forceinline__ void a_ready(const Unit&) const {}
    __device__ __forceinline__ void done(const Unit&) const {}
};
template <class Epi, class Sched, bool ALIGN_EPI = false, bool SP2 = false, bool BLK = false>
__device__ __forceinline__ void gemm_phase(PG8_LAS unsigned char* lds, const Gemm g, const Sched& S, const Epi& E) {
    int tid_ = threadIdx.x; asm volatile("" : "+v"(tid_));
    const int tid = tid_, wid = __builtin_amdgcn_readfirstlane(tid >> 6), lane = tid & 63, wr = wid >> 2, wc = wid & 3, fr = lane & 15, fq = lane >> 4;
    const int K = g.K, nt = K / BK;
    unsigned voffA[2], voffB[2];
#pragma unroll
    for (int i = 0; i < 2; ++i) { int R, C; stage_rc(tid * 16 + i * 8192, R, C); const int Rb = Epi::PERM ? ((R & ~31) + perm32(R & 31)) : R;
        voffA[i] = (unsigned)(R * (BLK ? BK : K) + C) * 2u; voffB[i] = (unsigned)(Rb * (BLK ? BK : K) + C) * 2u; }
    const size_t kstepA = BLK ? (size_t)g.M * BK * 2 : (size_t)(BK * 2), kstepB = BLK ? (size_t)g.N * BK * 2 : (size_t)(BK * 2);
    const size_t hstep = BLK ? (size_t)HALF * BK * 2 : (size_t)HALF * K * 2;
    const size_t tstep = 2 * hstep;
    const unsigned ldsw = (unsigned)wid * 1024u;
    const int aoff = lds_byte(wr * 64 + fr, fq * 8), boff = lds_byte(wc * 32 + fr, fq * 8);
#define PG8_SA(b, h) (((b) * 2 + (h)) * HTB)
#define PG8_SB(b, h) ((4 + (b) * 2 + (h)) * HTB)
#define PG8_STAGE(bufoff, gbase, voff) do { _Pragma("unroll") for (int _i = 0; _i < 2; ++_i) \
        __builtin_amdgcn_global_load_lds((const unsigned*)((const char*)(gbase) + (voff)[_i]), (PG8_LAS unsigned*)(lds + (bufoff) + ldsw + _i * 8192), 16, 0, 0); } while (0)
#define PG8_LDA(dst, b, h) do { _Pragma("unroll") for (int m = 0; m < 4; ++m) _Pragma("unroll") for (int k = 0; k < 2; ++k) dst[m][k] = *(const PG8_LAS bf16x8*)(lds + PG8_SA(b, h) + aoff + m * 2048 + k * 1024); } while (0)
#define PG8_LDB(dst, b, h) do { _Pragma("unroll") for (int n = 0; n < 2; ++n) _Pragma("unroll") for (int k = 0; k < 2; ++k) dst[n][k] = *(const PG8_LAS bf16x8*)(lds + PG8_SB(b, h) + boff + n * 2048 + k * 1024); } while (0)
#define PG8_MMA(ai, bj, At, Bt) do { __builtin_amdgcn_s_setprio(1); _Pragma("unroll") for (int m = 0; m < 4; ++m) _Pragma("unroll") for (int n = 0; n < 2; ++n) _Pragma("unroll") for (int k = 0; k < 2; ++k) \
        acc[ai][bj][m][n] = __builtin_amdgcn_mfma_f32_16x16x32_bf16(Bt[n][k], At[m][k], acc[ai][bj][m][n], 0, 0, 0); __builtin_amdgcn_s_setprio(0); } while (0)
#define PG8_WAIT_V(n) asm volatile("s_waitcnt vmcnt(" #n ")" ::: "memory")
#define PG8_WAIT_L(n) asm volatile("s_waitcnt lgkmcnt(" #n ")" ::: "memory")
#define PG8_BAR __builtin_amdgcn_s_barrier()
#define PG8_SCHED __builtin_amdgcn_sched_barrier(0)
    Unit cur, nxt; int ui = 0;
    if (!S.next(0, cur)) return;
    f32x4 acc[2][2][4][2];
#pragma unroll
    for (int a = 0; a < 2; ++a)
#pragma unroll
        for (int b = 0; b < 2; ++b)
#pragma unroll
            for (int m = 0; m < 4; ++m)
#pragma unroll
                for (int n = 0; n < 2; ++n) acc[a][b][m][n] = (f32x4){0.f, 0.f, 0.f, 0.f};
    bf16x8 At[4][2], B0[2][2], B1[2][2];
    const char* cA = (const char*)g.A + (size_t)cur.pm * tstep; const char* cB = (const char*)g.Bt + (size_t)cur.pn * tstep;
    S.a_ready(cur);
    if constexpr (SP2) {
        PG8_STAGE(PG8_SB(0, 0), cB, voffB); PG8_STAGE(PG8_SB(0, 1), cB + hstep, voffB); PG8_STAGE(PG8_SA(0, 0), cA, voffA); PG8_STAGE(PG8_SA(0, 1), cA + hstep, voffA);
        if (wr == 1) PG8_BAR;
        PG8_WAIT_V(2); PG8_BAR;
        PG8_STAGE(PG8_SB(1, 0), cB + kstepB, voffB); PG8_STAGE(PG8_SA(1, 0), cA + kstepA, voffA); PG8_STAGE(PG8_SB(1, 1), cB + hstep + kstepB, voffB);
        PG8_WAIT_V(6); PG8_BAR;
    } else {
        PG8_STAGE(PG8_SB(0, 0), cB, voffB); PG8_STAGE(PG8_SA(0, 0), cA, voffA); PG8_STAGE(PG8_SB(0, 1), cB + hstep, voffB); PG8_STAGE(PG8_SA(0, 1), cA + hstep, voffA);
        if (wr == 1) PG8_BAR;
        PG8_WAIT_V(4); PG8_BAR;
        PG8_STAGE(PG8_SB(1, 0), cB + kstepB, voffB); PG8_STAGE(PG8_SA(1, 0), cA + kstepA, voffA); PG8_STAGE(PG8_SB(1, 1), cB + hstep + kstepB, voffB);
        PG8_WAIT_V(6); PG8_BAR;
    }
    for (;;) {
        const bool has_next = S.next(ui + 1, nxt);
        const char* nA = has_next ? (const char*)g.A + (size_t)nxt.pm * tstep : cA; const char* nB = has_next ? (const char*)g.Bt + (size_t)nxt.pn * tstep : cB;
        for (int t = 0; t < nt; t += 2) {
            const bool last = (t == nt - 2);
            const char* a1 = cA + (size_t)(t + 1) * kstepA;
            const char* a2 = last ? nA : cA + (size_t)(t + 2) * kstepA; const char* b2 = last ? nB : cB + (size_t)(t + 2) * kstepB;
            const char* a3 = a2 + kstepA; const char* b3 = b2 + kstepB;
            if (last && has_next) S.a_ready(nxt);
            if constexpr (SP2) {
            PG8_LDB(B0, 0, 0); PG8_LDB(B1, 0, 1); PG8_SCHED; PG8_LDA(At, 0, 0); PG8_STAGE(PG8_SA(1, 1), a1 + hstep, voffA);
            PG8_WAIT_V(8); PG8_WAIT_L(0); PG8_BAR; PG8_MMA(0, 0, At, B0); PG8_MMA(0, 1, At, B1); PG8_BAR; PG8_SCHED;
            PG8_LDA(At, 0, 1); PG8_STAGE(PG8_SB(0, 0), b2, voffB); PG8_STAGE(PG8_SB(0, 1), b2 + hstep, voffB); PG8_STAGE(PG8_SA(0, 0), a2, voffA);
            PG8_WAIT_V(8); PG8_WAIT_L(0); PG8_BAR; PG8_MMA(1, 0, At, B0); PG8_MMA(1, 1, At, B1); PG8_BAR; PG8_SCHED;
            PG8_LDB(B0, 1, 0); PG8_LDB(B1, 1, 1); PG8_SCHED; PG8_LDA(At, 1, 0); PG8_STAGE(PG8_SA(0, 1), a2 + hstep, voffA);
            PG8_WAIT_V(8); PG8_WAIT_L(0); PG8_BAR; PG8_MMA(0, 0, At, B0); PG8_MMA(0, 1, At, B1); PG8_BAR; PG8_SCHED;
            PG8_LDA(At, 1, 1); PG8_STAGE(PG8_SB(1, 0), b3, voffB); PG8_STAGE(PG8_SB(1, 1), b3 + hstep, voffB); PG8_STAGE(PG8_SA(1, 0), a3, voffA);
            PG8_WAIT_V(8); PG8_WAIT_L(0); PG8_BAR; PG8_MMA(1, 0, At, B0); PG8_MMA(1, 1, At, B1); PG8_BAR; PG8_SCHED;
            } else {
            PG8_LDB(B0, 0, 0); PG8_SCHED; PG8_LDA(At, 0, 0); PG8_STAGE(PG8_SA(1, 1), a1 + hstep, voffA);
            PG8_WAIT_L(8); PG8_BAR; PG8_WAIT_L(0); PG8_MMA(0, 0, At, B0); PG8_BAR; PG8_SCHED;
            PG8_LDB(B1, 0, 1); PG8_STAGE(PG8_SB(0, 0), b2, voffB);
            PG8_BAR; PG8_WAIT_L(0); PG8_MMA(0, 1, At, B1); PG8_BAR;
            PG8_LDA(At, 0, 1); PG8_STAGE(PG8_SA(0, 0), a2, voffA);
            PG8_BAR; PG8_WAIT_L(0); PG8_MMA(1, 0, At, B0); PG8_BAR; PG8_SCHED;
            PG8_STAGE(PG8_SB(0, 1), b2 + hstep, voffB);
            PG8_WAIT_V(6); PG8_BAR; PG8_MMA(1, 1, At, B1); PG8_BAR;
            PG8_LDB(B0, 1, 0); PG8_SCHED; PG8_LDA(At, 1, 0); PG8_STAGE(PG8_SA(0, 1), a2 + hstep, voffA);
            PG8_WAIT_L(8); PG8_BAR; PG8_WAIT_L(0); PG8_MMA(0, 0, At, B0); PG8_BAR; PG8_SCHED;
            PG8_LDB(B1, 1, 1); PG8_STAGE(PG8_SB(1, 0), b3, voffB);
            PG8_BAR; PG8_WAIT_L(0); PG8_MMA(0, 1, At, B1); PG8_BAR;
            PG8_LDA(At, 1, 1); PG8_STAGE(PG8_SA(1, 0), a3, voffA);
            PG8_BAR; PG8_WAIT_L(0); PG8_MMA(1, 0, At, B0); PG8_BAR; PG8_SCHED;
            PG8_STAGE(PG8_SB(1, 1), b3 + hstep, voffB);
            PG8_WAIT_V(6); PG8_BAR; PG8_MMA(1, 1, At, B1); PG8_BAR;
            }
        }
        if constexpr (ALIGN_EPI) { if (wr == 0) PG8_BAR; }
        if constexpr (!Epi::AFTER_DRAIN) { E(acc, cur, wr, wc, fr, fq); S.done(cur); }
        if (!has_next) break;
#pragma unroll
        for (int a = 0; a < 2; ++a)
#pragma unroll
            for (int b = 0; b < 2; ++b)
#pragma unroll
                for (int m = 0; m < 4; ++m)
#pragma unroll
                    for (int n = 0; n < 2; ++n) acc[a][b][m][n] = (f32x4){0.f, 0.f, 0.f, 0.f};
        cur = nxt; cA = nA; cB = nB; ++ui;
        if constexpr (ALIGN_EPI) { if (wr == 1) PG8_BAR; }
    }
    PG8_WAIT_V(0);
    if constexpr (!ALIGN_EPI) { if (wr == 0) PG8_BAR; }
    PG8_BAR;
    if constexpr (Epi::AFTER_DRAIN) { E.fused(acc, cur, wr, wc, fr, fq, lds, wid, lane); S.done(cur); }
#undef PG8_SA
#undef PG8_SB
#undef PG8_STAGE
#undef PG8_LDA
#undef PG8_LDB
#undef PG8_MMA
#undef PG8_WAIT_V
#undef PG8_WAIT_L
#undef PG8_BAR
#undef PG8_SCHED
}
}
namespace fox {
constexpr int ALD = 2048;
constexpr int AD = 128;
constexpr float SCALE = 0.08838834764831845f;
constexpr float INVS = 11.313708498984761f;
constexpr float THR = 8.f;
constexpr int NW = 8, QBLK = 32, KVBLK = 64, QB = NW * QBLK;
constexpr int SHM_V = KVBLK * AD * 2, SHM_K = KVBLK * AD * 2;
constexpr int LDS_F = 2 * SHM_V + 2 * SHM_K + NW * 64 * 4;
constexpr int LDS_BYTES = LDS_F + 2 * 256;
constexpr int SO_PITCH = 264, SO_WAVE = 32 * SO_PITCH, LDS_SO = 71680;
constexpr float NEPS = 1e-6f;

using bf16 = __hip_bfloat16;
typedef short bf16x8 __attribute__((ext_vector_type(8)));
typedef short s16x4 __attribute__((ext_vector_type(4)));
typedef float f32x16 __attribute__((ext_vector_type(16)));
typedef float f32x4 __attribute__((ext_vector_type(4)));
typedef unsigned u32x4 __attribute__((ext_vector_type(4)));

#define KSWZ(row, colB) ((row) * 256 + ((colB) ^ (((row) & 7) << 4)))
#define SBAR() __builtin_amdgcn_sched_barrier(0)
__device__ __forceinline__ int v_st(int k, int c) { const int kk = (k & ~0xC) | ((k & 4) << 1) | ((k & 8) >> 1); return ((kk >> 3) * 4 + (c >> 5)) * 512 + ((kk & 7) * 32 + (c & 31)) * 2; }
__device__ __forceinline__ int v_rd_base(int lane) { return ((lane & 3) << 3) | (((lane >> 2) & 3) << 6) | (((lane >> 4) & 1) << 5) | (((lane >> 5) & 1) << 8); }
constexpr int v_rd_off(int d0, int ks, int half) { return d0 * 512 + ks * 4096 + half * 2048; }
__device__ __forceinline__ int crow(int r, int hi) { return (r & 3) + 8 * (r >> 2) + 4 * hi; }
__device__ __forceinline__ unsigned cvtpk(float lo, float hi) {
    unsigned r; asm volatile("v_cvt_pk_bf16_f32 %0, %1, %2" : "=v"(r) : "v"(lo), "v"(hi)); return r;
}
typedef __amdgpu_buffer_rsrc_t rsrc_t;
__device__ __forceinline__ rsrc_t mk_rsrc(const void* p) { return __builtin_amdgcn_make_buffer_rsrc((void*)p, (short)0, 0x7ffffff0, 0x00020000); }
__device__ __forceinline__ bf16x8 ldb8(rsrc_t r, int voff, int soff) { return __builtin_bit_cast(bf16x8, __builtin_amdgcn_raw_buffer_load_b128(r, voff, soff, 0)); }
__device__ __forceinline__ f32x4 ldf4(rsrc_t r, int voff, int soff) { return __builtin_bit_cast(f32x4, __builtin_amdgcn_raw_buffer_load_b128(r, voff, soff, 0)); }
__device__ __forceinline__ void mask_tile(f32x16& p0, f32x16& p1, int dq, unsigned W) {
    const float NEG = -__builtin_inff();
#pragma unroll
    for (int r = 0; r < 16; ++r) {
        const int c = (r & 3) + 8 * (r >> 2);
        if ((unsigned)(dq - c) >= W) p0[r] = NEG;
        if ((unsigned)(dq - c - 32) >= W) p1[r] = NEG;
    }
}
__device__ __forceinline__ void partialSM(f32x16& p0, f32x16& p1, float& m_reg, float& mn, float& alpha) {
    float pmax = p0[0]; for (int r = 1; r < 16; ++r) pmax = fmaxf(pmax, p0[r]); for (int r = 0; r < 16; ++r) pmax = fmaxf(pmax, p1[r]);
    { auto rr = __builtin_amdgcn_permlane32_swap(__float_as_uint(pmax), __float_as_uint(pmax), false, false);
      pmax = fmaxf(__uint_as_float(rr[0]), __uint_as_float(rr[1])); }
    constexpr float C2 = 1.4426950408889634f * SCALE;
    if (__builtin_expect(__all((pmax - m_reg) * SCALE <= THR), 1)) { mn = m_reg; alpha = 1.f; }
    else { mn = fmaxf(m_reg, pmax); alpha = __builtin_amdgcn_exp2f((m_reg - mn) * C2); m_reg = mn; }
    const float mnL = -mn * C2;
    for (int r = 0; r < 16; ++r) p0[r] = fmaf(p0[r], C2, mnL); for (int r = 0; r < 16; ++r) p1[r] = fmaf(p1[r], C2, mnL);
    for (int r = 0; r < 16; ++r) p0[r] = __builtin_amdgcn_exp2f(p0[r]);
}
__device__ __forceinline__ void finishSM(f32x16& p0, f32x16& p1, float alpha, float& l_reg, bf16x8& pa0, bf16x8& pa1, bf16x8& pa2, bf16x8& pa3) {
    for (int r = 0; r < 16; ++r) p1[r] = __builtin_amdgcn_exp2f(p1[r]);
    float ps = 0; for (int r = 0; r < 16; ++r) ps += p0[r]; for (int r = 0; r < 16; ++r) ps += p1[r];
    { auto rr = __builtin_amdgcn_permlane32_swap(__float_as_uint(ps), __float_as_uint(ps), false, false);
      ps = __uint_as_float(rr[0]) + __uint_as_float(rr[1]); }
    l_reg = l_reg * alpha + ps;
#define PK4(P, B_, OUT) do { unsigned a0 = cvtpk(P[B_+0], P[B_+1]), a1 = cvtpk(P[B_+2], P[B_+3]);                          \
        unsigned b0 = cvtpk(P[B_+4], P[B_+5]), b1 = cvtpk(P[B_+6], P[B_+7]);                                             \
        auto r0 = __builtin_amdgcn_permlane32_swap(a0, b0, false, false); auto r1 = __builtin_amdgcn_permlane32_swap(a1, b1, false, false); \
        u32x4 w = {r0[0], r1[0], r0[1], r1[1]}; OUT = *reinterpret_cast<bf16x8*>(&w); } while (0)
    PK4(p0, 0, pa0); PK4(p0, 8, pa1); PK4(p1, 0, pa2); PK4(p1, 8, pa3);
#undef PK4
}
template <int KB>
__device__ __forceinline__ void qkt(f32x16& p0, f32x16& p1, const char* K_lds, const char* F_lds, int r32, int hi, const bf16x8* qr) {
    { const f32x4* fk = reinterpret_cast<const f32x4*>(F_lds + KB * 256);
#pragma unroll
      for (int g = 0; g < 4; ++g) { const f32x4 a = fk[2 * g + hi], b = fk[8 + 2 * g + hi];
#pragma unroll
          for (int e = 0; e < 4; ++e) { p0[4 * g + e] = a[e]; p1[4 * g + e] = b[e]; } } }
    const char* kb[4];
#pragma unroll
    for (int dd = 0; dd < 4; ++dd) kb[dd] = K_lds + KB * SHM_K + KSWZ(r32, (dd * 16 + hi * 8) * 2);
#pragma unroll
    for (int d0 = 0; d0 < 8; ++d0) { const char* a = kb[d0 & 3] + (d0 >> 2) * 128;
        bf16x8 b0 = *reinterpret_cast<const bf16x8*>(a);
        bf16x8 b1 = *reinterpret_cast<const bf16x8*>(a + 32 * 256);
        p0 = __builtin_amdgcn_mfma_f32_32x32x16_bf16(b0, qr[d0], p0, 0, 0, 0);
        p1 = __builtin_amdgcn_mfma_f32_32x32x16_bf16(b1, qr[d0], p1, 0, 0, 0); }
}
template <int VB>
__device__ __forceinline__ void pv_tile(f32x16* o, int vb0, bf16x8 pa0, bf16x8 pa1, bf16x8 pa2, bf16x8 pa3) {
#define TRRD(dst, off) asm volatile("ds_read_b64_tr_b16 %0, %1 offset:%2" : "=&v"(dst) : "v"(vb0), "i"(off) : "memory")
#define PV_D0(d0) do { s16x4 l0, l1, l2, l3, h0, h1, h2, h3; constexpr int b_ = VB * SHM_V + v_rd_off(d0, 0, 0);     \
        TRRD(l0, b_); TRRD(h0, b_ + 2048); TRRD(l1, b_ + 4096); TRRD(h1, b_ + 6144); TRRD(l2, b_ + 8192); TRRD(h2, b_ + 10240); TRRD(l3, b_ + 12288); TRRD(h3, b_ + 14336); \
        asm volatile("s_waitcnt lgkmcnt(0)" ::: "memory"); SBAR();                 \
        o[d0] = __builtin_amdgcn_mfma_f32_32x32x16_bf16(pa0, (bf16x8){l0[0], l0[1], l0[2], l0[3], h0[0], h0[1], h0[2], h0[3]}, o[d0], 0, 0, 0);   \
        o[d0] = __builtin_amdgcn_mfma_f32_32x32x16_bf16(pa1, (bf16x8){l1[0], l1[1], l1[2], l1[3], h1[0], h1[1], h1[2], h1[3]}, o[d0], 0, 0, 0);   \
        o[d0] = __builtin_amdgcn_mfma_f32_32x32x16_bf16(pa2, (bf16x8){l2[0], l2[1], l2[2], l2[3], h2[0], h2[1], h2[2], h2[3]}, o[d0], 0, 0, 0);   \
        o[d0] = __builtin_amdgcn_mfma_f32_32x32x16_bf16(pa3, (bf16x8){l3[0], l3[1], l3[2], l3[3], h3[0], h3[1], h3[2], h3[3]}, o[d0], 0, 0, 0); } while (0)
    PV_D0(0); PV_D0(1); PV_D0(2); PV_D0(3);
#undef PV_D0
#undef TRRD
}

struct BlockRef { const bf16* Q; const bf16* K; const bf16* V; bf16* O; const float* F; const bf16* G; const float* wo; int P0; int jlo; };
struct Seam {
    bf16x8 qr[8];
    bf16x8 st_v0, st_v1, st_k0, st_k1; f32x4 st_f;
};
#define VMW() asm volatile("s_waitcnt vmcnt(0)" ::: "memory")
#define VMWN(n) asm volatile("s_waitcnt vmcnt(%0)" :: "i"(n) : "memory")
#define SLOAD_H(rK_, rV_, rF_, k0) do { const int so_ = (k0) * (ALD * 2);                                                    \
                         S.st_v0 = ldb8(rV_, kvoff, so_); S.st_v1 = ldb8(rV_, kvoff, so_ + 32 * ALD * 2);                    \
                         S.st_k0 = ldb8(rK_, kvoff, so_); S.st_k1 = ldb8(rK_, kvoff, so_ + 32 * ALD * 2);                    \
                         if (tid < 16) S.st_f = ldf4(rF_, tid * 16, (k0) * 4); } while (0)
#define QLOAD(rQ_) do { _Pragma("unroll") for (int d0 = 0; d0 < 8; ++d0) S.qr[d0] = ldb8(rQ_, qoff + d0 * 32, 0); } while (0)
#define SWRITE_HK(bf) do { *(bf16x8*)(K_lds + (bf) * SHM_K + kws) = S.st_k0; *(bf16x8*)(K_lds + (bf) * SHM_K + kws + 32 * 256) = S.st_k1; \
                           if (tid < 16) *(f32x4*)(F_lds + (bf) * 256 + tid * 16) = S.st_f; } while (0)
#define SWRITE_HV(bf) do { *(bf16x8*)(V_lds + (bf) * SHM_V + vst0) = S.st_v0; *(bf16x8*)(V_lds + (bf) * SHM_V + vst1) = S.st_v1; } while (0)
#define SWRITE_H(bf) do { SWRITE_HV(bf); SWRITE_HK(bf); } while (0)
__device__ __forceinline__ int fox_jlo(const float* Fn, int P0, float TH) {
    int lane_ = threadIdx.x & 63; asm volatile("" : "+v"(lane_));
    const int ntf = P0 / KVBLK + 4, kt = lane_ < ntf ? lane_ : ntf - 1;
    int zero_ = 0; asm volatile("" : "+v"(zero_));
    const float fe = Fn[kt * KVBLK + KVBLK - 1], fp0 = Fn[P0 + zero_];
    const unsigned long long mk = __ballot(fp0 - fe <= TH);
    return (int)__builtin_ctzll(mk);
}
__device__ __forceinline__ void normalize_q(bf16x8* qr, const float* wq, int hi) {
    float ss = 0.f;
#pragma unroll
    for (int d0 = 0; d0 < 8; ++d0) { const u32x4 w = __builtin_bit_cast(u32x4, qr[d0]);
#pragma unroll
        for (int e = 0; e < 4; ++e) { const float a = __uint_as_float(w[e] << 16), b = __uint_as_float(w[e] & 0xffff0000u); ss += a * a + b * b; } }
    { auto rr = __builtin_amdgcn_permlane32_swap(__float_as_uint(ss), __float_as_uint(ss), false, false); ss = __uint_as_float(rr[0]) + __uint_as_float(rr[1]); }
    const float rs = __builtin_amdgcn_rsqf(ss * (1.f / AD) + NEPS);
#pragma unroll
    for (int d0 = 0; d0 < 8; ++d0) { const u32x4 w = __builtin_bit_cast(u32x4, qr[d0]); const f32x4 w0 = *(const f32x4*)(wq + d0 * 16 + hi * 8), w1 = *(const f32x4*)(wq + d0 * 16 + hi * 8 + 4);
        u32x4 o; o[0] = cvtpk(__uint_as_float(w[0] << 16) * rs * w0[0], __uint_as_float(w[0] & 0xffff0000u) * rs * w0[1]); o[1] = cvtpk(__uint_as_float(w[1] << 16) * rs * w0[2], __uint_as_float(w[1] & 0xffff0000u) * rs * w0[3]);
        o[2] = cvtpk(__uint_as_float(w[2] << 16) * rs * w1[0], __uint_as_float(w[2] & 0xffff0000u) * rs * w1[1]); o[3] = cvtpk(__uint_as_float(w[3] << 16) * rs * w1[2], __uint_as_float(w[3] & 0xffff0000u) * rs * w1[3]);
        qr[d0] = __builtin_bit_cast(bf16x8, o); }
}
__device__ __forceinline__ void causal_prime(const BlockRef& cur, char* lds, Seam& S) {
    int tid_ = threadIdx.x; asm volatile("" : "+v"(tid_));
    const int tid = tid_, wid = __builtin_amdgcn_readfirstlane(tid >> 6), lane = tid & 63, r32 = lane & 31, hi = lane >> 5;
    const int sr = tid >> 4, sc = (tid & 15) * 8, kws = KSWZ(sr, sc * 2); char* K_lds = lds + 2 * SHM_V; char* F_lds = lds + LDS_F;
    const int kvoff = (sr * ALD + sc) * 2, qoff = ((wid * QBLK + r32) * ALD + hi * 8) * 2;
    const rsrc_t rQ = mk_rsrc(cur.Q), rK = mk_rsrc(cur.K), rV = mk_rsrc(cur.V), rF = mk_rsrc(cur.F);
    QLOAD(rQ);
    SLOAD_H(rK, rV, rF, cur.jlo * KVBLK); VMW(); SWRITE_HK(0);
    __syncthreads();
}
__device__ __forceinline__ void causal_block(const BlockRef& cur, const BlockRef& nxt, char* lds, Seam& S, const float* wq) {
    int tid_ = threadIdx.x; asm volatile("" : "+v"(tid_));
    const int tid = tid_, wid = __builtin_amdgcn_readfirstlane(tid >> 6), lane = tid & 63, r32 = lane & 31, hi = lane >> 5;
    constexpr int W = 1 << 30;
    const int j_lo = cur.jlo, NT = (cur.P0 + QB - 1) / KVBLK + 1 - j_lo;
    const int qlo = cur.P0 + wid * QBLK, qm = qlo + r32 - 4 * hi;
    char* V_lds = lds; char* K_lds = lds + 2 * SHM_V; char* F_lds = lds + LDS_F;
    float* ws = (float*)(lds + 2 * SHM_V + 2 * SHM_K) + wid * 64; float* li_l = ws, * al_l = ws + 32;
    float m_reg = -1e30f, l_reg = 0; f32x16 o[4] = {};
    const int sr = tid >> 4, sc = (tid & 15) * 8, vst0 = v_st(sr, sc), vst1 = v_st(32 + sr, sc), kws = KSWZ(sr, sc * 2);
    const int vb0 = (int)(uintptr_t)V_lds + v_rd_base(lane);
    const int kvoff = (sr * ALD + sc) * 2, qoff = ((wid * QBLK + r32) * ALD + hi * 8) * 2;
    const rsrc_t Kh = mk_rsrc(cur.K), Vh = mk_rsrc(cur.V), Fh = mk_rsrc(cur.F);
#define RESC(a) do { if (__any((a) < 1.f)) { if (hi == 0) al_l[r32] = (a); asm volatile("s_waitcnt lgkmcnt(0)" ::: "memory");              \
                     for (int d_ = 0; d_ < 4; ++d_) for (int r = 0; r < 16; ++r) o[d_][r] *= al_l[crow(r, hi)]; } } while (0)
#define KBASE(t) ((j_lo + (t)) * KVBLK)
#define MASKT(P0_, P1_, t) do { const int kb_ = KBASE(t); if (kb_ + KVBLK - 1 > qlo) mask_tile(P0_, P1_, qm - kb_, (unsigned)W); } while (0)
    constexpr int NQL = 8;
#define SEAM_K0() do { VMWN(NQL); SWRITE_HK(0); SBAR(); } while (0)
    f32x16 pA0, pA1, pB0, pB1; float mnA, mnB, alA, alB; bf16x8 pa0, pa1, pa2, pa3;
    normalize_q(S.qr, wq, hi);
    SWRITE_HV(0); SBAR();
    if (NT > 1) { SLOAD_H(Kh, Vh, Fh, KBASE(1)); }
    SBAR(); qkt<0>(pA0, pA1, K_lds, F_lds, r32, hi, S.qr);
    MASKT(pA0, pA1, 0); partialSM(pA0, pA1, m_reg, mnA, alA);
    if (NT > 1) { VMW(); SWRITE_H(1); }
    __syncthreads();
#define HALF_STEP(PX0, PX1, mnX, alX, PY0, PY1, alY, t, KB, VB, SB) do {                                                      \
        SBAR(); qkt<KB>(PX0, PX1, K_lds, F_lds, r32, hi, S.qr);                                                               \
        finishSM(PY0, PY1, alY, l_reg, pa0, pa1, pa2, pa3); SBAR();                                                           \
        if ((t) + 1 < NT) { SLOAD_H(Kh, Vh, Fh, KBASE((t) + 1)); SBAR(); }                                                    \
        pv_tile<VB>(o, vb0, pa0, pa1, pa2, pa3); MASKT(PX0, PX1, (t)); partialSM(PX0, PX1, m_reg, mnX, alX);                  \
        __syncthreads();                                                                                                      \
        if ((t) + 1 < NT) { VMW(); SWRITE_H(SB); }                                                                            \
        RESC(alX); __syncthreads(); } while (0)
    for (int t = 1; t + 1 < NT; t += 2) {
        HALF_STEP(pB0, pB1, mnB, alB, pA0, pA1, alA, t, 1, 0, 0);
        HALF_STEP(pA0, pA1, mnA, alA, pB0, pB1, alB, t + 1, 0, 1, 1);
    }
    const bool even = (NT & 1) == 0;
    if (even) { SBAR(); qkt<1>(pB0, pB1, K_lds, F_lds, r32, hi, S.qr); SBAR(); }
    { const rsrc_t nK = mk_rsrc(nxt.K), nV = mk_rsrc(nxt.V), nF = mk_rsrc(nxt.F), nQ = mk_rsrc(nxt.Q);
      SLOAD_H(nK, nV, nF, nxt.jlo * KVBLK); SBAR();
      QLOAD(nQ); }
    SBAR();
    finishSM(pA0, pA1, alA, l_reg, pa0, pa1, pa2, pa3); SBAR();
    pv_tile<0>(o, vb0, pa0, pa1, pa2, pa3);
    if (even) { MASKT(pB0, pB1, NT - 1); partialSM(pB0, pB1, m_reg, mnB, alB); __syncthreads(); RESC(alB);
        finishSM(pB0, pB1, alB, l_reg, pa0, pa1, pa2, pa3); SBAR(); pv_tile<1>(o, vb0, pa0, pa1, pa2, pa3); }
    SBAR(); SEAM_K0();
    { char* so = lds + LDS_SO + wid * SO_WAVE;
      const int erow = lane >> 1, eh = lane & 1, eoff = ((wid * QBLK + erow) * ALD + eh * 64) * 2;
      const rsrc_t rG = mk_rsrc(cur.G), rO = mk_rsrc(cur.O);
      bf16x8 gt[8];
#pragma unroll
      for (int i = 0; i < 8; ++i) gt[i] = ldb8(rG, eoff + i * 16, 0);
      if (hi == 0) li_l[r32] = l_reg; asm volatile("s_waitcnt lgkmcnt(0)" ::: "memory");
#pragma unroll
      for (int r = 0; r < 16; ++r) { const float rl = __builtin_amdgcn_rcpf(li_l[crow(r, hi)]);
#pragma unroll
        for (int d0 = 0; d0 < 4; ++d0) *(unsigned short*)(so + crow(r, hi) * SO_PITCH + (d0 * 32 + r32) * 2) = (unsigned short)(cvtpk(o[d0][r] * rl, 0.f) & 0xffffu); }
      asm volatile("s_waitcnt lgkmcnt(0)" ::: "memory");
      typedef unsigned u32x2 __attribute__((ext_vector_type(2)));
      u32x2 xw[16]; float ssq = 0.f;
#pragma unroll
      for (int i = 0; i < 16; ++i) { xw[i] = *(const u32x2*)(so + erow * SO_PITCH + eh * 128 + i * 8);
#pragma unroll
        for (int e = 0; e < 2; ++e) { const float a = __uint_as_float(xw[i][e] << 16), b = __uint_as_float(xw[i][e] & 0xffff0000u); ssq += a * a + b * b; } }
      ssq += __shfl_xor(ssq, 1);
      const float rs = __builtin_amdgcn_rsqf(ssq * (1.f / AD) + NEPS);
#pragma unroll
      for (int i = 0; i < 8; ++i) { const f32x4 w0 = *(const f32x4*)(cur.wo + eh * 64 + i * 8), w1 = *(const f32x4*)(cur.wo + eh * 64 + i * 8 + 4);
        const u32x4 g = __builtin_bit_cast(u32x4, gt[i]); const float ww[8] = {w0[0], w0[1], w0[2], w0[3], w1[0], w1[1], w1[2], w1[3]};
        u32x4 ow;
#pragma unroll
        for (int e = 0; e < 4; ++e) { const unsigned xv = xw[2 * i + (e >> 1)][e & 1];
            const float x0 = __uint_as_float(xv << 16), x1 = __uint_as_float(xv & 0xffff0000u), g0 = __uint_as_float(g[e] << 16), g1 = __uint_as_float(g[e] & 0xffff0000u);
            const float s0 = g0 * __builtin_amdgcn_rcpf(1.f + __builtin_amdgcn_exp2f(-1.4426950408889634f * g0)), s1 = g1 * __builtin_amdgcn_rcpf(1.f + __builtin_amdgcn_exp2f(-1.4426950408889634f * g1));
            ow[e] = cvtpk(x0 * rs * ww[2 * e] * s0, x1 * rs * ww[2 * e + 1] * s1); }
        __builtin_amdgcn_raw_buffer_store_b128(ow, rO, eoff + i * 16, 0, 0); } }
    __syncthreads();
#undef RESC
#undef KBASE
#undef MASKT
#undef SEAM_K0
#undef HALF_STEP
}
#undef QLOAD
#undef VMW
#undef VMWN
#undef SLOAD_H
#undef SWRITE_HK
#undef SWRITE_HV
#undef SWRITE_H
#undef KSWZ
#undef SBAR
}
namespace rec {
typedef short bf16x8 __attribute__((ext_vector_type(8)));
typedef short bf16x4 __attribute__((ext_vector_type(4)));
typedef float f32x4 __attribute__((ext_vector_type(4)));
typedef float f32x2 __attribute__((ext_vector_type(2)));
typedef __bf16 bf16x2_t __attribute__((ext_vector_type(2)));
typedef unsigned u32x4 __attribute__((ext_vector_type(4)));
typedef unsigned u32x2 __attribute__((ext_vector_type(2)));
#define REC_LAS __attribute__((address_space(3)))
constexpr int RT = 4096, RD = 2048, NSEG = 4, SEG = RT / NSEG, NCH = SEG / 64;
constexpr int QP = 272, TP = 144;
constexpr int OFF_KB = 160 * QP, OFF_KHT = OFF_KB + 64 * QP, OFF_VT = OFF_KHT + 128 * TP, OFF_AM = OFF_VT + 128 * TP, OFF_TOT = OFF_AM + 64 * TP, OFF_DL = OFF_TOT + 8 * 128 * 4, OFF_SO = OFF_DL + 512, LDS_END = OFF_SO + 64 * QP;
static_assert(LDS_END <= 131072, "recurrence LDS map");
__device__ __forceinline__ constexpr int qv_off(int j) { return (64 * j - 8 * j * (j - 1)) * QP; }
__device__ __forceinline__ unsigned cvt2(float lo, float hi) { f32x2 v = {lo, hi}; bf16x2_t b = __builtin_convertvector(v, bf16x2_t); return __builtin_bit_cast(unsigned, b); }
__device__ __forceinline__ float ex2(float x) { return __builtin_amdgcn_exp2f(x); }
__device__ __forceinline__ float lo_f(unsigned w) { return __uint_as_float(w << 16); }
__device__ __forceinline__ float hi_f(unsigned w) { return __uint_as_float(w & 0xffff0000u); }

template <bool OUT>
__device__ __forceinline__ void run(REC_LAS unsigned char* lds, int G, const unsigned short* Qp, const unsigned short* Zp, const unsigned short* Vp, unsigned short* Op,
                                    const float* lbl, int layer, float* Ug, float* Dg, const unsigned short* Gp, const float* wo) {
    int tid_ = threadIdx.x; asm volatile("" : "+v"(tid_));
    const int tid = tid_, lane = tid & 63, wv = __builtin_amdgcn_readfirstlane(tid >> 6), fr = lane & 15, fg = lane >> 4;
    constexpr int NU = OUT ? 64 * NSEG : 64 * (NSEG - 1);
    if (OUT) { if (tid < 256) { const int blk = tid >> 7, r = (tid >> 3) & 15, c = tid & 7;
            *(REC_LAS unsigned*)(lds + OFF_AM + (32 * blk + r) * TP + (32 * blk + 16) * 2 + c * 4) = 0u; } }
    for (int u = blockIdx.x; u < NU; u += G) {
        const int bh = OUT ? u / NSEG : u / (NSEG - 1), seg = OUT ? u % NSEG : u % (NSEG - 1), b = bh >> 4, h = bh & 15;
        float lb[2];
#pragma unroll
        for (int dd = 0; dd < 2; ++dd) { const int c = h * 128 + 2 * lane + dd; lb[dd] = layer == 0 ? 0.f : 1.f / (1.f + __expf(lbl[c] - lbl[RD + c])); }
        f32x4 st[8];
#pragma unroll
        for (int kt = 0; kt < 8; ++kt) st[kt] = (f32x4){0.f, 0.f, 0.f, 0.f};
        if (OUT) {
            for (int s2 = 0; s2 < seg; ++s2) {
                const float* U = Ug + ((size_t)(bh * (NSEG - 1) + s2) << 14); const float* Dv = Dg + (bh * (NSEG - 1) + s2) * 128;
#pragma unroll
                for (int kt = 0; kt < 8; ++kt) { const f32x4 dvv = *(const f32x4*)(Dv + 16 * kt + 4 * fg);
#pragma unroll
                    for (int e = 0; e < 4; ++e) st[kt][e] = dvv[e] * st[kt][e] + U[(16 * kt + 4 * fg + e) * 128 + 16 * wv + fr]; }
            }
        }
        const int er = tid >> 3, es = tid & 7;
#define REC_FLUSH(cp, g0, g1) do { const REC_LAS unsigned char* sp = lds + OFF_SO + er * QP + es * 32;                                          \
            const u32x4 x0 = *(const REC_LAS u32x4*)sp, x1 = *(const REC_LAS u32x4*)(sp + 16);                                                    \
            float xf[16], gf[16]; float ssq = 0.f;                                                                                                \
            _Pragma("unroll") for (int e = 0; e < 4; ++e) { xf[2 * e] = lo_f(x0[e]); xf[2 * e + 1] = hi_f(x0[e]); xf[8 + 2 * e] = lo_f(x1[e]); xf[9 + 2 * e] = hi_f(x1[e]);   \
                gf[2 * e] = lo_f(g0[e]); gf[2 * e + 1] = hi_f(g0[e]); gf[8 + 2 * e] = lo_f(g1[e]); gf[9 + 2 * e] = hi_f(g1[e]); }                 \
            _Pragma("unroll") for (int e = 0; e < 16; ++e) ssq += xf[e] * xf[e];                                                                  \
            ssq += __shfl_xor(ssq, 1); ssq += __shfl_xor(ssq, 2); ssq += __shfl_xor(ssq, 4);                                                      \
            const float rs_ = __builtin_amdgcn_rsqf(ssq * (1.f / 128.f) + 1e-6f);                                                                 \
            u32x4 y0, y1;                                                                                                                         \
            _Pragma("unroll") for (int q4 = 0; q4 < 4; ++q4) { const f32x4 w4 = *(const f32x4*)(wo + h * 128 + es * 16 + 4 * q4); float yv[4];     \
                _Pragma("unroll") for (int e = 0; e < 4; ++e) { const float g_ = gf[4 * q4 + e]; yv[e] = xf[4 * q4 + e] * rs_ * w4[e] * g_ * __builtin_amdgcn_rcpf(1.f + ex2(-1.4426950408889634f * g_)); } \
                if (q4 < 2) { y0[2 * q4] = cvt2(yv[0], yv[1]); y0[2 * q4 + 1] = cvt2(yv[2], yv[3]); } else { y1[2 * (q4 - 2)] = cvt2(yv[0], yv[1]); y1[2 * (q4 - 2) + 1] = cvt2(yv[2], yv[3]); } }   \
            unsigned short* op_ = Op + row0 + (size_t)(64 * (cp) + er) * RD + es * 16; *(u32x4*)op_ = y0; *(u32x4*)(op_ + 8) = y1; } while (0)
        float dsum[2] = {0.f, 0.f};
        const size_t row0 = (size_t)(b * RT + seg * SEG) * RD + h * 128;
        unsigned nq[8], nz[8], nv[8];
#pragma unroll
        for (int e = 0; e < 8; ++e) { const size_t o = row0 + (size_t)(8 * wv + e) * RD + 2 * lane; nq[e] = *(const unsigned*)(Qp + o); nz[e] = *(const unsigned*)(Zp + o); nv[e] = *(const unsigned*)(Vp + o); }
#pragma unroll 1
        for (int c = 0; c < NCH; ++c) {
            unsigned cq[8], cz[8], cv[8];
#pragma unroll
            for (int e = 0; e < 8; ++e) { cq[e] = nq[e]; cz[e] = nz[e]; cv[e] = nv[e]; }
            if (c + 1 < NCH) {
#pragma unroll
                for (int e = 0; e < 8; ++e) { const size_t o = row0 + (size_t)(64 * (c + 1) + 8 * wv + e) * RD + 2 * lane; nq[e] = *(const unsigned*)(Qp + o); nz[e] = *(const unsigned*)(Zp + o); nv[e] = *(const unsigned*)(Vp + o); }
            }
            float kf[8][2], cs[8][2];
#pragma unroll
            for (int e = 0; e < 8; ++e) {
#pragma unroll
                for (int dd = 0; dd < 2; ++dd) {
                    const float z = dd ? hi_f(cz[e]) : lo_f(cz[e]);
                    const float ez = ex2(-1.4426950408889634f * fabsf(z)), inv = __builtin_amdgcn_rcpf(1.f + ez);
                    const float sig = z >= 0.f ? inv : ez * inv, nsig = z >= 0.f ? ez * inv : inv;
                    const float f = lb[dd] + (1.f - lb[dd]) * sig;
                    kf[e][dd] = (1.f - lb[dd]) * nsig;
                    const float gl = __builtin_amdgcn_logf(f);
                    cs[e][dd] = e ? cs[e - 1][dd] + gl : gl;
                }
            }
            *(REC_LAS f32x2*)(lds + OFF_TOT + (wv * 128 + 2 * lane) * 4) = (f32x2){cs[7][0], cs[7][1]};
            __syncthreads();
            float P[9][2];
            P[0][0] = 0.f; P[0][1] = 0.f;
#pragma unroll
            for (int w = 0; w < 8; ++w) { const f32x2 t2 = *(const REC_LAS f32x2*)(lds + OFF_TOT + (w * 128 + 2 * lane) * 4); P[w + 1][0] = P[w][0] + t2[0]; P[w + 1][1] = P[w][1] + t2[1]; }
            float base[2], bl[2], Bj[4][2];
#pragma unroll
            for (int dd = 0; dd < 2; ++dd) { bl[dd] = P[8][dd]; float bs = 0.f;
#pragma unroll
                for (int w = 0; w < 8; ++w) bs = (w == wv) ? P[w][dd] : bs;
                base[dd] = bs;
#pragma unroll
                for (int j = 0; j < 4; ++j) Bj[j][dd] = P[2 * j][dd]; }
            const int jb = wv >> 1;
            float Bown[2];
#pragma unroll
            for (int dd = 0; dd < 2; ++dd) { float bo = 0.f;
#pragma unroll
                for (int j = 0; j < 4; ++j) bo = (j == jb) ? Bj[j][dd] : bo;
                Bown[dd] = bo; }
            float Ej[4][2], Eend[2];
#pragma unroll
            for (int dd = 0; dd < 2; ++dd) { Eend[dd] = ex2(bl[dd] - Bown[dd]);
#pragma unroll
                for (int j = 0; j < 4; ++j) Ej[j][dd] = (j < jb) ? ex2(Bown[dd] - Bj[j][dd]) : 1.f; }
            unsigned khw[2][4], vtw[2][4];
#pragma unroll
            for (int e = 0; e < 8; ++e) {
                const int t = 8 * wv + e;
                float eo[2], ko[2], qv[2];
#pragma unroll
                for (int dd = 0; dd < 2; ++dd) { const float x = base[dd] + cs[e][dd] - Bown[dd];
                    eo[dd] = ex2(x); ko[dd] = kf[e][dd] * ex2(fminf(-x, 120.f)); qv[dd] = (dd ? hi_f(cq[e]) : lo_f(cq[e])) * eo[dd]; }
                if (OUT) {
#pragma unroll
                    for (int j = 0; j < 4; ++j) if (j <= jb)
                        *(REC_LAS unsigned*)(lds + qv_off(j) + (t - 16 * j) * QP + lane * 4) = cvt2(qv[0] * Ej[j][0], qv[1] * Ej[j][1]);
                    *(REC_LAS unsigned*)(lds + OFF_KB + t * QP + lane * 4) = cvt2(ko[0], ko[1]);
                }
                const float kh0 = ko[0] * Eend[0], kh1 = ko[1] * Eend[1];
                if (e & 1) { khw[0][e >> 1] = cvt2(__uint_as_float(khw[0][e >> 1]), kh0); khw[1][e >> 1] = cvt2(__uint_as_float(khw[1][e >> 1]), kh1);
                             vtw[0][e >> 1] = (vtw[0][e >> 1] >> 16) | (cv[e] << 16); vtw[1][e >> 1] = (vtw[1][e >> 1] >> 16) | (cv[e] & 0xffff0000u); }
                else { khw[0][e >> 1] = __float_as_uint(kh0); khw[1][e >> 1] = __float_as_uint(kh1); vtw[0][e >> 1] = cv[e] << 16; vtw[1][e >> 1] = cv[e] & 0xffff0000u; }
            }
#pragma unroll
            for (int dd = 0; dd < 2; ++dd) {
                *(REC_LAS u32x4*)(lds + OFF_KHT + (2 * lane + dd) * TP + wv * 16) = (u32x4){khw[dd][0], khw[dd][1], khw[dd][2], khw[dd][3]};
                *(REC_LAS u32x4*)(lds + OFF_VT + (2 * lane + dd) * TP + wv * 16) = (u32x4){vtw[dd][0], vtw[dd][1], vtw[dd][2], vtw[dd][3]};
            }
            if (wv == 0) *(REC_LAS f32x2*)(lds + OFF_DL + 2 * lane * 4) = (f32x2){ex2(bl[0]), ex2(bl[1])};
            dsum[0] += bl[0]; dsum[1] += bl[1];
            __syncthreads();
            if (OUT) {
#pragma unroll 1
                for (int blk = wv; blk < 10; blk += 8) {
                    const int i = blk < 1 ? 0 : blk < 3 ? 1 : blk < 6 ? 2 : 3, j = blk - (i * (i + 1)) / 2;
                    f32x4 a = {0.f, 0.f, 0.f, 0.f};
                    const REC_LAS unsigned char* ka = lds + OFF_KB + (16 * j + fr) * QP + fg * 16;
                    const REC_LAS unsigned char* qa = lds + qv_off(j) + (16 * (i - j) + fr) * QP + fg * 16;
#pragma unroll
                    for (int kk = 0; kk < 4; ++kk) a = __builtin_amdgcn_mfma_f32_16x16x32_bf16(*(const REC_LAS bf16x8*)(ka + kk * 64), *(const REC_LAS bf16x8*)(qa + kk * 64), a, 0, 0, 0);
                    if (i == j) {
#pragma unroll
                        for (int e = 0; e < 4; ++e) a[e] = (4 * fg + e <= fr) ? a[e] : 0.f; }
                    u32x2 w2; w2.x = cvt2(a[0], a[1]); w2.y = cvt2(a[2], a[3]);
                    *(REC_LAS u32x2*)(lds + OFF_AM + (16 * i + fr) * TP + (16 * j + 4 * fg) * 2) = w2;
                }
                __syncthreads();
            }
            u32x4 gq0 = {0u, 0u, 0u, 0u}, gq1 = {0u, 0u, 0u, 0u};
            if (OUT) { const unsigned short* gp_ = Gp + row0 + (size_t)(64 * c + er) * RD + es * 16; gq0 = *(const u32x4*)gp_; gq1 = *(const u32x4*)(gp_ + 8); }
            bf16x8 vb[2];
#pragma unroll
            for (int kk = 0; kk < 2; ++kk) vb[kk] = *(const REC_LAS bf16x8*)(lds + OFF_VT + (16 * wv + fr) * TP + kk * 64 + fg * 16);
            if (OUT) {
                bf16x8 sb[4];
#pragma unroll
                for (int k4 = 0; k4 < 4; ++k4) { u32x4 w4; w4.x = cvt2(st[2 * k4][0], st[2 * k4][1]); w4.y = cvt2(st[2 * k4][2], st[2 * k4][3]); w4.z = cvt2(st[2 * k4 + 1][0], st[2 * k4 + 1][1]); w4.w = cvt2(st[2 * k4 + 1][2], st[2 * k4 + 1][3]);
                    sb[k4] = __builtin_bit_cast(bf16x8, w4); }
#pragma unroll
                for (int mt = 0; mt < 4; ++mt) {
                    f32x4 acc = {0.f, 0.f, 0.f, 0.f};
#pragma unroll
                    for (int kk = 0; kk < 2; ++kk) if (kk <= (mt >> 1))
                        acc = __builtin_amdgcn_mfma_f32_16x16x32_bf16(*(const REC_LAS bf16x8*)(lds + OFF_AM + (16 * mt + fr) * TP + kk * 64 + fg * 16), vb[kk], acc, 0, 0, 0);
#pragma unroll
                    for (int k4 = 0; k4 < 4; ++k4) {
                        const REC_LAS unsigned char* qa = lds + (16 * mt + fr) * QP + k4 * 64 + fg * 8;
                        const u32x2 lo2 = *(const REC_LAS u32x2*)qa, hi2 = *(const REC_LAS u32x2*)(qa + 32);
                        const u32x4 w4 = {lo2.x, lo2.y, hi2.x, hi2.y};
                        acc = __builtin_amdgcn_mfma_f32_16x16x32_bf16(__builtin_bit_cast(bf16x8, w4), sb[k4], acc, 0, 0, 0);
                    }
#pragma unroll
                    for (int e = 0; e < 4; ++e) *(REC_LAS unsigned short*)(lds + OFF_SO + (16 * mt + 4 * fg + e) * QP + (16 * wv + fr) * 2) = (unsigned short)(cvt2(acc[e], 0.f) & 0xffffu);
                }
            }
#pragma unroll
            for (int kt = 0; kt < 8; ++kt) {
                const f32x4 dl4 = *(const REC_LAS f32x4*)(lds + OFF_DL + (16 * kt + 4 * fg) * 4);
                st[kt] = st[kt] * dl4;
#pragma unroll
                for (int kk = 0; kk < 2; ++kk)
                    st[kt] = __builtin_amdgcn_mfma_f32_16x16x32_bf16(*(const REC_LAS bf16x8*)(lds + OFF_KHT + (16 * kt + fr) * TP + kk * 64 + fg * 16), vb[kk], st[kt], 0, 0, 0);
            }
            if (OUT) { __syncthreads();
                REC_FLUSH(c, gq0, gq1); }
        }
        if (!OUT) {
            float* U = Ug + ((size_t)u << 14);
#pragma unroll
            for (int kt = 0; kt < 8; ++kt)
#pragma unroll
                for (int e = 0; e < 4; ++e) U[(16 * kt + 4 * fg + e) * 128 + 16 * wv + fr] = st[kt][e];
            if (wv == 0) *(f32x2*)(Dg + u * 128 + 2 * lane) = (f32x2){ex2(dsum[0]), ex2(dsum[1])};
        }
        __syncthreads();
    }
}
#undef REC_FLUSH
#undef REC_LAS
}
#define GAS __attribute__((address_space(1)))
#define LAS __attribute__((address_space(3)))
typedef unsigned short bf16;
typedef unsigned v4u __attribute__((ext_vector_type(4)));
typedef float f32x4 __attribute__((ext_vector_type(4)));
typedef short bf16x8 __attribute__((ext_vector_type(8)));
typedef GAS unsigned gu32;
typedef GAS unsigned long long gu64;
#define RLX_AGENT __ATOMIC_RELAXED, __HIP_MEMORY_SCOPE_AGENT
#define LDS_WAIT() asm volatile("s_waitcnt lgkmcnt(0)" ::: "memory")
#define VM_WAIT() asm volatile("s_waitcnt vmcnt(0)" ::: "memory")
__device__ __forceinline__ unsigned long long rt() { return __builtin_amdgcn_s_memrealtime(); }
__device__ __forceinline__ unsigned f2bf(float f) { unsigned u = __builtin_bit_cast(unsigned, f); return (u + 0x7fffu + ((u >> 16) & 1u)) >> 16; }
__device__ __forceinline__ unsigned pk2(float lo, float hi) { return f2bf(lo) | (f2bf(hi) << 16); }
#define XB_TMO      128
#define XB_XCNT(j)  (256  + 64 * (j))
#define XB_XSUB(j)  (1280 + 64 * (j))
#define XB_XGEN(j)  (2304 + 64 * (j))
#define XB_TOP      3328
#define XB_TOPGEN   3392
#define XCD_BAR_WORDS 3456
#define XB_SPIN_CAP (1u << 18)

__device__ __forceinline__ unsigned xb_ld(unsigned* p)              { return __hip_atomic_load(p, __ATOMIC_RELAXED, __HIP_MEMORY_SCOPE_AGENT); }
__device__ __forceinline__ unsigned xb_add(unsigned* p, unsigned v) { return __hip_atomic_fetch_add(p, v, __ATOMIC_RELAXED, __HIP_MEMORY_SCOPE_AGENT); }
__device__ __forceinline__ unsigned xb_xcc_id() { return (unsigned)__builtin_amdgcn_s_getreg((3 << 11) | 20) & 0xFu; }
#define XB_SPIN(cond, bar) do { unsigned _sp = 0; while (cond) { __builtin_amdgcn_s_sleep(1); \
    if ((++_sp & 255u) == 0u) { if (xb_ld(&(bar)[XB_TMO])) break; if (_sp > XB_SPIN_CAP) { atomicAdd(&(bar)[XB_TMO], 1u); break; } } } } while (0)

struct XcdBarrier {
    unsigned* bar; unsigned x;
    volatile LAS unsigned* st;
};

__device__ __forceinline__ XcdBarrier xcd_barrier_post(unsigned* bar, volatile LAS unsigned* st) {
    XcdBarrier b; b.bar = bar; b.x = xb_xcc_id(); b.st = st;
    if (threadIdx.x == 0) (void)xb_add(&bar[XB_XCNT(b.x)], 1u);
    return b;
}
__device__ __forceinline__ void xcd_barrier_complete(unsigned* bar, unsigned x, unsigned& nloc, unsigned& nx) {
    const unsigned G = gridDim.x * gridDim.y * gridDim.z;
    unsigned sum, cnt, mine, sp = 0u;
    for (;;) {
        sum = 0u; cnt = 0u; mine = 0u;
#pragma unroll
        for (unsigned j = 0; j < 16; ++j) { const unsigned c = xb_ld(&bar[XB_XCNT(j)]); sum += c; cnt += (c > 0u) ? 1u : 0u; mine = (j == x) ? c : mine; }
        if (sum == G) break;
        __builtin_amdgcn_s_sleep(1);
        if ((++sp & 255u) == 0u) { if (xb_ld(&bar[XB_TMO])) break; if (sp > XB_SPIN_CAP) { atomicAdd(&bar[XB_TMO], 1u); break; } }
    }
    nloc = mine > 0u ? mine : 1u; nx = cnt > 0u ? cnt : 1u;
}

__device__ __forceinline__ void xcd_barrier(const XcdBarrier& b) {
    asm volatile("s_waitcnt vmcnt(0)" ::: "memory");
    __syncthreads();
    if (threadIdx.x == 0) {
        unsigned* bar = b.bar;
        __builtin_amdgcn_s_waitcnt(0);
        unsigned nloc = b.st[0], nx = b.st[1];
        if (nloc == 0u) { xcd_barrier_complete(bar, b.x, nloc, nx); b.st[0] = nloc; b.st[1] = nx; }
        const unsigned old = xb_add(&bar[XB_XSUB(b.x)], 1u);
        const unsigned gen = old / nloc;
        if (old + 1u == (gen + 1u) * nloc) {
            __builtin_amdgcn_fence(__ATOMIC_RELEASE, "agent");
            asm volatile("s_waitcnt vmcnt(0)" ::: "memory");
            const unsigned og = xb_add(&bar[XB_TOP], 1u);
            const unsigned tg = og / nx;
            if (og + 1u == (tg + 1u) * nx) xb_add(&bar[XB_TOPGEN], 1u);
            else XB_SPIN(xb_ld(&bar[XB_TOPGEN]) == tg, bar);
            __builtin_amdgcn_fence(__ATOMIC_ACQUIRE, "agent");
            xb_add(&bar[XB_XGEN(b.x)], 1u);
            asm volatile("s_waitcnt vmcnt(0)" ::: "memory");
        } else {
            XB_SPIN(xb_ld(&bar[XB_XGEN(b.x)]) == gen, bar);
            __builtin_amdgcn_fence(__ATOMIC_ACQUIRE, "agent");
            asm volatile("s_waitcnt vmcnt(0)" ::: "memory");
        }
    }
    __syncthreads();
}
#define PROBE_MODE 0
constexpr int NWAVES = 8;
#ifndef ONE_LAUNCH
#define ONE_LAUNCH 1
#endif
constexpr int BATCH = 4, T = 4096, D = 2048, H = 16, HD = 128;
constexpr int M = BATCH * T;
constexpr int NPA = 8192;
constexpr float EPS = 1e-6f;
constexpr size_t MiB = 1u << 20;
constexpr size_t WS_CTL = 0, CTL_ZERO_BYTES = 1 * MiB;
constexpr size_t WS_WINA = 2 * MiB;
constexpr size_t WS_WOUTA = 66 * MiB;
constexpr size_t WS_WKVQ = 82 * MiB;
constexpr size_t WS_WINB1 = 114 * MiB;
constexpr size_t WS_WOUTB = 130 * MiB;
constexpr size_t WS_XN = 146 * MiB;
constexpr size_t WS_PROJ = 210 * MiB;
constexpr size_t WS_FZ = 466 * MiB;
constexpr size_t WS_F = 467 * MiB;
constexpr size_t WS_U = 468 * MiB;
constexpr size_t WS_DG = 480 * MiB;
constexpr size_t WS_END = 481 * MiB;
constexpr size_t SLOT = (size_t)M * D;
constexpr int CW_TMO = 0, CW_CODE = 1;
constexpr int CW_BAR = 4096;
constexpr int CW_ATT = 16384;
constexpr int CW_SS = 32768;
constexpr int RING_OFF = 0, RING_BYTES = 131072;
constexpr int SCRATCH_BYTES = 139264;
constexpr int LDSCTL_OFF = SCRATCH_BYTES, MISC_OFF = LDSCTL_OFF + 320;
constexpr int LDS_BYTES = 147456;
static_assert(MISC_OFF + 128 <= LDS_BYTES, "LDS map");

struct Frame {
    LAS unsigned char* lds;
    volatile LAS unsigned* MISC;
    gu32* ctl;
    int tid, lane, wave;
    int vcu, G;
};
__device__ __forceinline__ void phase_tid(Frame& F) { int t = threadIdx.x; asm volatile("" : "+v"(t)); F.tid = t; F.lane = t & 63; F.wave = __builtin_amdgcn_readfirstlane(t >> 6); }

__device__ __forceinline__ float wave_sum(float v) {
#pragma unroll
    for (int o = 1; o < 64; o <<= 1) v += __shfl_xor(v, o);
    return v;
}
__device__ __forceinline__ float bf2f(unsigned short b) { return __uint_as_float((unsigned)b << 16); }
__device__ __forceinline__ float bflo(unsigned w) { return __uint_as_float(w << 16); }
__device__ __forceinline__ float bfhi(unsigned w) { return __uint_as_float(w & 0xffff0000u); }

__device__ __forceinline__ void p0_transpose_item(const float* W, int ldw, int ncols, const float* nw, bf16* WT, LAS float* scr, int item, int lane) {
    const int nblk = ncols / 32, kb = item / nblk, nb = item % nblk, k0 = 64 * kb, n0 = 32 * nb;
#pragma unroll 8
    for (int i = 0; i < 32; ++i) { const int kk = 2 * i + (lane >> 5); const float s = nw ? nw[k0 + kk] : 1.f; scr[kk * 33 + (lane & 31)] = W[(size_t)(k0 + kk) * ldw + n0 + (lane & 31)] * s; }
    LDS_WAIT(); asm volatile("" ::: "memory");
    const int c = lane & 7;
#pragma unroll
    for (int j = 0; j < 4; ++j) { const int n = (lane >> 3) + 8 * j; const LAS float* s = scr + (8 * c) * 33 + n;
        v4u o; o.x = pk2(s[0 * 33], s[1 * 33]); o.y = pk2(s[2 * 33], s[3 * 33]); o.z = pk2(s[4 * 33], s[5 * 33]); o.w = pk2(s[6 * 33], s[7 * 33]);
        *(GAS v4u*)(WT + (size_t)(n0 + n) * D + k0 + 8 * c) = o; }
    LDS_WAIT(); asm volatile("" ::: "memory");
}
__device__ __forceinline__ void xb_rows(Frame& F, const float* xin, bf16* xb, unsigned long long* ss) {
    const int gw = F.vcu * NWAVES + F.wave, NGW = F.G * NWAVES;
    for (int m = gw; m < M; m += NGW) {
        const GAS f32x4* xr = (const GAS f32x4*)(xin + (size_t)m * D) + F.lane;
        f32x4 v[8]; float s = 0.f;
#pragma unroll
        for (int j = 0; j < 8; ++j) { v[j] = xr[64 * j]; s += (v[j].x * v[j].x + v[j].y * v[j].y) + (v[j].z * v[j].z + v[j].w * v[j].w); }
        s = wave_sum(s);
        GAS unsigned long long* o8 = (GAS unsigned long long*)(xb + (size_t)m * D) + F.lane;
#pragma unroll
        for (int j = 0; j < 8; ++j) o8[64 * j] = (unsigned long long)pk2(v[j].x, v[j].y) | ((unsigned long long)pk2(v[j].z, v[j].w) << 32);
        if (F.lane == 0) ss[m] = (unsigned long long)(s * 16777216.0f);
    }
}
__device__ __forceinline__ void p0_prologue(Frame& F, const float* const* in, unsigned char* ws) {
    LAS float* scr = (LAS float*)(F.lds + RING_OFF + F.wave * 16384);
    const int gw = F.vcu * NWAVES + F.wave, NGW = F.G * NWAVES;
    constexpr int I_INA = 32 * 256, I_SQ = 32 * 64, I_4K = 32 * 128;
    constexpr int NITEMS = 2 * I_INA + 2 * I_SQ + 3 * I_4K + 2 * I_SQ;
    for (int it = gw; it < NITEMS; it += NGW) {
        int r = it;
        if (r < 2 * I_INA) { const int l = r / I_INA; r -= l * I_INA; p0_transpose_item(in[2] + (size_t)l * D * NPA, NPA, NPA, in[1] + l * D, (bf16*)(ws + WS_WINA) + (size_t)l * NPA * D, scr, r, F.lane); continue; } r -= 2 * I_INA;
        if (r < 2 * I_SQ) { const int l = r / I_SQ; r -= l * I_SQ; p0_transpose_item(in[5] + (size_t)l * D * D, D, D, nullptr, (bf16*)(ws + WS_WOUTA) + (size_t)l * D * D, scr, r, F.lane); continue; } r -= 2 * I_SQ;
        if (r < I_4K) { p0_transpose_item(in[7], 2 * D + H, 2 * D, in[6], (bf16*)(ws + WS_WKVQ), scr, r, F.lane); continue; } r -= I_4K;
        if (r < I_4K) { p0_transpose_item(in[11], 2 * D, 2 * D, in[10], (bf16*)(ws + WS_WKVQ) + (size_t)2 * D * D, scr, r, F.lane); continue; } r -= I_4K;
        if (r < I_4K) { p0_transpose_item(in[11] + (size_t)D * 2 * D, 2 * D, 2 * D, in[10] + D, (bf16*)(ws + WS_WINB1), scr, r, F.lane); continue; } r -= I_4K;
        { const int l = r / I_SQ; r -= l * I_SQ; p0_transpose_item(in[14] + (size_t)l * D * D, D, D, nullptr, (bf16*)(ws + WS_WOUTB) + (size_t)l * D * D, scr, r, F.lane); }
    }
    xb_rows(F, in[0], (bf16*)(ws + WS_XN), (unsigned long long*)(F.ctl + CW_SS));
}
__device__ __forceinline__ float sum16(float v) { v += __shfl_xor(v, 1); v += __shfl_xor(v, 2); v += __shfl_xor(v, 4); v += __shfl_xor(v, 8); return v; }
__device__ __forceinline__ void headnorm_rows(Frame& F, bf16* X, const float* w) {
    const int gw = F.vcu * NWAVES + F.wave, NGW = F.G * NWAVES;
    for (int m = gw; m < M; m += NGW) {
        GAS v4u* xr = (GAS v4u*)(X + (size_t)m * D) + F.lane;
#pragma unroll
        for (int j = 0; j < 4; ++j) {
            const v4u x = xr[64 * j]; float f[8] = {bflo(x.x), bfhi(x.x), bflo(x.y), bfhi(x.y), bflo(x.z), bfhi(x.z), bflo(x.w), bfhi(x.w)};
            float s = 0.f;
#pragma unroll
            for (int e = 0; e < 8; ++e) s += f[e] * f[e];
            const float r = 1.0f / sqrtf(sum16(s) * (1.f / HD) + EPS);
            const int d0 = (8 * F.lane) & 127;
            const f32x4 w0 = *(const f32x4*)(w + d0), w1 = *(const f32x4*)(w + d0 + 4);
            v4u o; o.x = pk2(f[0] * r * w0.x, f[1] * r * w0.y); o.y = pk2(f[2] * r * w0.z, f[3] * r * w0.w); o.z = pk2(f[4] * r * w1.x, f[5] * r * w1.y); o.w = pk2(f[6] * r * w1.z, f[7] * r * w1.w);
            xr[64 * j] = o;
        }
    }
}
__device__ __forceinline__ float silu_f(float g) { return g / (1.f + __expf(-g)); }
__device__ __forceinline__ void gatenorm_rows(Frame& F, bf16* O, const bf16* G, const float* w) {
    const int gw = F.vcu * NWAVES + F.wave, NGW = F.G * NWAVES;
    for (int m = gw; m < M; m += NGW) {
        GAS v4u* xr = (GAS v4u*)(O + (size_t)m * D) + F.lane; const GAS v4u* gr = (const GAS v4u*)(G + (size_t)m * D) + F.lane;
#pragma unroll
        for (int j = 0; j < 4; ++j) {
            const v4u x = xr[64 * j], g = gr[64 * j];
            float f[8] = {bflo(x.x), bfhi(x.x), bflo(x.y), bfhi(x.y), bflo(x.z), bfhi(x.z), bflo(x.w), bfhi(x.w)};
            const float q[8] = {bflo(g.x), bfhi(g.x), bflo(g.y), bfhi(g.y), bflo(g.z), bfhi(g.z), bflo(g.w), bfhi(g.w)};
            float s = 0.f;
#pragma unroll
            for (int e = 0; e < 8; ++e) s += f[e] * f[e];
            const float r = 1.0f / sqrtf(sum16(s) * (1.f / HD) + EPS);
            const int c0 = 8 * (F.lane + 64 * j);
            const f32x4 w0 = *(const f32x4*)(w + c0), w1 = *(const f32x4*)(w + c0 + 4);
            const float ww[8] = {w0.x, w0.y, w0.z, w0.w, w1.x, w1.y, w1.z, w1.w};
#pragma unroll
            for (int e = 0; e < 8; ++e) f[e] = f[e] * r * ww[e] * silu_f(q[e]);
            v4u o; o.x = pk2(f[0], f[1]); o.y = pk2(f[2], f[3]); o.z = pk2(f[4], f[5]); o.w = pk2(f[6], f[7]);
            xr[64 * j] = o;
        }
    }
}
__device__ __forceinline__ void fz_rows(Frame& F, const bf16* xn, const unsigned long long* ss, const float* kvw, const float* kvnw, const float* fbias, float* fzls) {
    LAS float* wf = (LAS float*)(F.lds);
    for (int idx = F.tid; idx < D * 16; idx += NWAVES * 64) { const int k = idx >> 4, j = idx & 15; wf[k * 16 + (k >> 3) * 4 + j] = kvw[(size_t)k * (2 * D + H) + 2 * D + j] * kvnw[k]; }
    __syncthreads();
    const int gw = F.vcu * NWAVES + F.wave, NGW = F.G * NWAVES;
    for (int m = gw; m < M; m += NGW) {
        const GAS v4u* xr = (const GAS v4u*)(xn + (size_t)m * D) + F.lane;
        float acc[16];
#pragma unroll
        for (int j = 0; j < 16; ++j) acc[j] = 0.f;
#pragma unroll 1
        for (int jj = 0; jj < 4; ++jj) {
            const v4u x = xr[64 * jj]; const float f[8] = {bflo(x.x), bfhi(x.x), bflo(x.y), bfhi(x.y), bflo(x.z), bfhi(x.z), bflo(x.w), bfhi(x.w)};
            const int c = F.lane + 64 * jj;
#pragma unroll 2
            for (int e = 0; e < 8; ++e) { const LAS f32x4* wr = (const LAS f32x4*)(wf + (8 * c + e) * 16 + c * 4);
#pragma unroll
                for (int q = 0; q < 4; ++q) { const f32x4 w4 = wr[q]; acc[4 * q + 0] += f[e] * w4.x; acc[4 * q + 1] += f[e] * w4.y; acc[4 * q + 2] += f[e] * w4.z; acc[4 * q + 3] += f[e] * w4.w; } }
        }
        float mine = 0.f;
#pragma unroll
        for (int j = 0; j < 16; ++j) { const float s = wave_sum(acc[j]); if (F.lane == j) mine = s; }
        if (F.lane < 16) { const float z = mine * (1.0f / sqrtf((float)ss[m] * (1.0f / 16777216.0f) * (1.f / D) + EPS)) + fbias[F.lane]; fzls[(size_t)m * 16 + F.lane] = fminf(z, 0.f) - __logf(1.f + __expf(-fabsf(z))); }
    }
    __syncthreads();
}
__device__ __forceinline__ void fscan(Frame& F, const float* fzls, float* Fo) {
    LAS float* wt = (LAS float*)(F.lds);
    for (int u = blockIdx.x; u < BATCH * H; u += F.G) {
        const int b = u / H, h = u % H, t0 = F.tid * 8;
        float v[8];
#pragma unroll
        for (int e = 0; e < 8; ++e) v[e] = fzls[(size_t)(b * T + t0 + e) * 16 + h];
#pragma unroll
        for (int e = 1; e < 8; ++e) v[e] += v[e - 1];
        float incl = v[7];
#pragma unroll
        for (int o = 1; o < 64; o <<= 1) { const float n = __shfl_up(incl, o); if (F.lane >= o) incl += n; }
        if (F.lane == 63) wt[F.wave] = incl;
        __syncthreads();
        float base = incl - v[7];
        for (int w = 0; w < F.wave; ++w) base += wt[w];
#pragma unroll
        for (int e = 0; e < 8; ++e) Fo[(size_t)u * T + t0 + e] = -(v[e] + base) * fox::INVS;
        __syncthreads();
    }
}
__device__ __forceinline__ fox::BlockRef attn_ref(int L, const bf16* Q, const bf16* K, const bf16* V, bf16* O, const bf16* G, const float* wo, const float* Fc, float TH) {
    const int bh = L & 63, qb = 15 - (L >> 6), b = bh / H, h = bh % H;
    fox::BlockRef r; const size_t base = (size_t)b * T * D + h * HD;
    r.Q = (const fox::bf16*)Q + base + (size_t)qb * 256 * D; r.O = (fox::bf16*)O + base + (size_t)qb * 256 * D; r.K = (const fox::bf16*)K + base; r.V = (const fox::bf16*)V + base;
    r.G = (const fox::bf16*)G + base + (size_t)qb * 256 * D; r.wo = wo + h * HD;
    r.F = Fc + (size_t)bh * T; r.P0 = qb * 256; r.jlo = fox::fox_jlo(r.F, r.P0, TH); return r;
}
__device__ __forceinline__ float attn_threshold(Frame& F, const float* wq, const float* wk) {
    float a = fmaxf(fabsf(wq[F.lane]), fabsf(wq[F.lane + 64])), c = fmaxf(fabsf(wk[F.lane]), fabsf(wk[F.lane + 64]));
#pragma unroll
    for (int o = 1; o < 64; o <<= 1) { a = fmaxf(a, __shfl_xor(a, o)); c = fmaxf(c, __shfl_xor(c, o)); }
    return 2.f * (128.f * 1.02f * a * c) + 152.f / (1.4426950408889634f * fox::SCALE);
}
__device__ __forceinline__ void attn_phase(Frame& F, char* lds, const bf16* Q, const bf16* K, const bf16* V, bf16* O, const bf16* G, const float* wo, const float* wq, const float* Fc, gu32* ctr, float TH) {
    constexpr int total = BATCH * H * 16;
    volatile LAS int* tk = (volatile LAS int*)(F.lds + 69632);
    if (F.tid == 0) { tk[0] = (int)__hip_atomic_fetch_add(ctr, 1u, RLX_AGENT); tk[1] = (int)__hip_atomic_fetch_add(ctr, 1u, RLX_AGENT); }
    __syncthreads();
    int Lc = tk[0], Ln = tk[1];
    if (Lc >= total) return;
    fox::BlockRef cur = attn_ref(Lc, Q, K, V, O, G, wo, Fc, TH);
    fox::Seam S;
    fox::causal_prime(cur, lds, S);
    for (int i = 0;; ++i) {
        if (F.tid == 0) tk[2 + (i & 1)] = (int)__hip_atomic_fetch_add(ctr, 1u, RLX_AGENT);
        const bool has_next = Ln < total;
        const fox::BlockRef nxt = has_next ? attn_ref(Ln, Q, K, V, O, G, wo, Fc, TH) : cur;
        fox::causal_block(cur, nxt, lds, S, wq);
        if (!has_next) break;
        const int L2 = tk[2 + (i & 1)];
        cur = nxt; Lc = Ln; Ln = L2;
    }
}

constexpr int NPHASE = 29;
__host__ __device__ constexpr bool phase_live(int id) {
    if (id == 0) return true;
    const int L = (id - 1) / 7, s = (id - 1) % 7;
    if (s == 1) return L == 2;
    if (s == 2) return L <= 2;
    if (s == 6) return false;
    if (s == 4) return false;
    return true;
}
struct Args { const float* in[15]; float* out; unsigned char* ws; int ph_lo, ph_hi; };
__global__ void __launch_bounds__(NWAVES * 64, 2) fwd_kernel(Args args) {
    extern __shared__ __attribute__((aligned(16))) unsigned char lds[];
    Frame F;
    F.lds = (LAS unsigned char*)lds;
    F.MISC = (volatile LAS unsigned*)(F.lds + MISC_OFF);
    phase_tid(F);
    F.G = gridDim.x; { const int bx = blockIdx.x; F.vcu = (F.G % 8 == 0) ? (bx % 8) * (F.G / 8) + bx / 8 : bx; }
    unsigned char* ws = args.ws;
    F.ctl = (gu32*)(ws + WS_CTL);
    for (int u = F.tid; u < (LDS_BYTES - LDSCTL_OFF) / 4; u += NWAVES * 64) ((LAS unsigned*)(F.lds + LDSCTL_OFF))[u] = 0u;
    __syncthreads();
#if ONE_LAUNCH
    XcdBarrier bar = xcd_barrier_post((unsigned*)(F.ctl + CW_BAR), F.MISC + 8);
#define GRID_BAR() xcd_barrier(bar)
#else
#define GRID_BAR() do {} while (0)
#endif
    const int lo = args.ph_lo, hi = args.ph_hi;
#define IN(k) (lo <= (k) && (k) < hi)
#define SEAM(k) do { if ((k) + 1 < hi) GRID_BAR(); } while (0)
    const float* const* in = args.in;
    bf16* XN = (bf16*)(ws + WS_XN); bf16* PROJ = (bf16*)(ws + WS_PROJ); unsigned long long* SS = (unsigned long long*)(F.ctl + CW_SS);
    float* FZ = (float*)(ws + WS_FZ); float* FC = (float*)(ws + WS_F);

    #ifndef NO_P0
    if (IN(0)) { phase_tid(F); p0_prologue(F, in, ws); SEAM(0); }
#endif

#ifdef PROBE_CLK
    long long pc0 = 0; unsigned long long pr0 = 0, probe_us = 0;
#endif
#pragma unroll 1
    for (int L = 0; L < 4; ++L) {
        const int pb = 1 + 7 * L; const bool isA = L < 2; const int j = L & 1;
        if (IN(pb + 0)) {
#ifdef PROBE_CLK
            if (L == PROBE_CLK - 1) { pc0 = clock64(); pr0 = __builtin_amdgcn_s_memrealtime(); }
#endif
            const bf16* Bt = isA ? (const bf16*)(ws + WS_WINA) + (size_t)j * NPA * D : (L == 2 ? (const bf16*)(ws + WS_WKVQ) : (const bf16*)(ws + WS_WINB1));
            const int N = (L == 3) ? 2 * D : NPA;
            bf16* outp = (L == 3) ? PROJ + 2 * SLOT : PROJ;
            pg8::Gemm g{XN, Bt, M, N, D}; pg8::StaticOrder S; S.init(M, N, F.G, (int)blockIdx.x);
            pg8::EpiBf16R E{outp, D, D, SLOT, SS + (size_t)L * M, 1.f / D, EPS};
#ifndef NO_G1
            pg8::gemm_phase<pg8::EpiBf16R, pg8::StaticOrder, true, true>(F.lds + RING_OFF, g, S, E);
#ifdef DUP_GIN
            pg8::gemm_phase<pg8::EpiBf16R, pg8::StaticOrder, true, true>(F.lds + RING_OFF, g, S, E);
#endif
#ifdef DUP_GIN_NOEPI
            { pg8::EpiNull E0;
#ifdef PROBE_L2RES
              pg8::RepeatOrder S2; S2.n = (M / 256) * (N / 256) / F.G; S2.c = (int)blockIdx.x;
              pg8::gemm_phase<pg8::EpiNull, pg8::RepeatOrder, true, true, false>(F.lds + RING_OFF, g, S2, E0);
#else
              pg8::gemm_phase<pg8::EpiNull, pg8::StaticOrder, true, true, PROBE_BLK>(F.lds + RING_OFF, g, S, E0);
#endif
            }
#endif
#endif
#ifdef PROBE_CLK
            if (L == PROBE_CLK - 1) { const long long dc = clock64() - pc0; const unsigned long long dr = __builtin_amdgcn_s_memrealtime() - pr0; probe_us = PROBE_MODE == 0 ? (unsigned long long)(dc * 100 / (long long)dr) : (unsigned long long)(dc / 256);
              if (PROBE_MODE >= 2 && threadIdx.x == 0) { if (PROBE_MODE == 2) atomicMax((unsigned*)(F.ctl + 2048), (unsigned)probe_us); else atomicMin((unsigned*)(F.ctl + 2048), 0x7fffffffu - (unsigned)probe_us); } }
#endif
            SEAM(pb + 0);
        }
        if (IN(pb + 1) && L == 2) { phase_tid(F);
#ifndef NO_FZ
            if (L == 2) { fz_rows(F, XN, SS + (size_t)L * M, in[7], in[6], in[8], FZ); headnorm_rows(F, PROJ, in[9]); }
#endif
            SEAM(pb + 1);
        }
        if (IN(pb + 2) && L == 2) { phase_tid(F); fscan(F, FZ, FC); SEAM(pb + 2); }
        if (IN(pb + 2) && isA) {
            rec::run<false>(F.lds + RING_OFF, F.G, PROJ, PROJ + SLOT, PROJ + 2 * SLOT, PROJ, in[3], L, (float*)(ws + WS_U), (float*)(ws + WS_DG), PROJ + 3 * SLOT, in[4] + j * D);
#ifdef DUP_REC
            rec::run<false>(F.lds + RING_OFF, F.G, PROJ, PROJ + SLOT, PROJ + 2 * SLOT, PROJ, in[3], L, (float*)(ws + WS_U), (float*)(ws + WS_DG), PROJ + 3 * SLOT, in[4] + j * D);
#endif
            SEAM(pb + 2);
        }
        if (IN(pb + 3)) { phase_tid(F);
#ifndef NO_REC
            if (isA) rec::run<true>(F.lds + RING_OFF, F.G, PROJ, PROJ + SLOT, PROJ + 2 * SLOT, PROJ, in[3], L, (float*)(ws + WS_U), (float*)(ws + WS_DG), PROJ + 3 * SLOT, in[4] + j * D);
#ifdef DUP_REC
            if (isA) rec::run<true>(F.lds + RING_OFF, F.G, PROJ, PROJ + SLOT, PROJ + 2 * SLOT, PROJ, in[3], L, (float*)(ws + WS_U), (float*)(ws + WS_DG), PROJ + 3 * SLOT, in[4] + j * D);
#endif
#endif
#ifndef NO_ATT
            if (!isA) attn_phase(F, (char*)lds + RING_OFF, PROJ + 2 * SLOT, PROJ, PROJ + SLOT, PROJ + 2 * SLOT, PROJ + 3 * SLOT, in[13] + j * D, in[12] + j * HD, FC, F.ctl + CW_ATT + 64 * j, attn_threshold(F, in[12] + j * HD, in[9]));
#ifdef DUP_ATT
            if (!isA) { __syncthreads(); attn_phase(F, (char*)lds + RING_OFF, PROJ + 2 * SLOT, PROJ, PROJ + SLOT, PROJ + 2 * SLOT, PROJ + 3 * SLOT, in[13] + j * D, in[12] + j * HD, FC, F.ctl + CW_ATT + 64 * (j + 2), attn_threshold(F, in[12] + j * HD, in[9])); }
#endif
#endif
            SEAM(pb + 3);
        }
        bf16* OB = isA ? PROJ : PROJ + 2 * SLOT;
        if (false) { phase_tid(F); gatenorm_rows(F, OB, PROJ + 3 * SLOT, (isA ? in[4] : in[13]) + j * D); SEAM(pb + 4); }
        if (IN(pb + 5)) {
            const bf16* Bt = (const bf16*)(ws + (isA ? WS_WOUTA : WS_WOUTB)) + (size_t)j * D * D;
            pg8::Gemm g{OB, Bt, M, D, D}; pg8::StaticOrder S; S.init(M, D, F.G, (int)blockIdx.x);
            pg8::EpiResX E{L == 0 ? in[0] : args.out, args.out, D, L < 3 ? XN : nullptr, SS + (size_t)(L + 1 < 4 ? L + 1 : 3) * M};
#ifndef NO_G2
            pg8::gemm_phase<pg8::EpiResX, pg8::StaticOrder, true, true>(F.lds + RING_OFF, g, S, E);
#endif
            SEAM(pb + 5);
        }
    }
#ifdef PROBE_CLK
    if (PROBE_MODE >= 2) { __syncthreads(); unsigned v = __hip_atomic_load((unsigned*)(F.ctl + 2048), __ATOMIC_RELAXED, __HIP_MEMORY_SCOPE_AGENT); probe_us = PROBE_MODE == 2 ? v : v; }
    if (blockIdx.x == 0 && threadIdx.x == 0) { const unsigned long long t0 = __builtin_amdgcn_s_memrealtime(); while (__builtin_amdgcn_s_memrealtime() - t0 < probe_us * 100ull) __builtin_amdgcn_s_sleep(10); }
#endif
#undef IN
#undef SEAM
}

extern "C" void kernel_launch(void* const* d_in, const int* in_sizes, int n_in, void* d_out, int out_size, void* d_ws, size_t ws_size, hipStream_t stream) {
    static int grid = 0;
    if (grid == 0) {
        if (n_in != 15 || in_sizes[0] != M * D || out_size != M * D || ws_size < WS_END) { fprintf(stderr, "kernel_launch: unexpected shapes (n_in %d, in0 %d, out %d, ws %zu)\n", n_in, n_in > 0 ? in_sizes[0] : -1, out_size, ws_size); grid = -1; return; }
        int dev = 0, cus = 0;
        if (hipGetDevice(&dev) != hipSuccess || hipDeviceGetAttribute(&cus, hipDeviceAttributeMultiprocessorCount, dev) != hipSuccess) { grid = -1; return; }
        if (hipFuncSetAttribute((const void*)fwd_kernel, hipFuncAttributeMaxDynamicSharedMemorySize, LDS_BYTES) != hipSuccess) { fprintf(stderr, "kernel_launch: hipFuncSetAttribute failed\n"); grid = -1; return; }
        int per_cu = 0;
        if (hipOccupancyMaxActiveBlocksPerMultiprocessor(&per_cu, (const void*)fwd_kernel, NWAVES * 64, LDS_BYTES) != hipSuccess || per_cu < 1) fprintf(stderr, "kernel_launch: occupancy query says %d\n", per_cu);
        (void)hipGetLastError();
        grid = cus;
    }
    if (grid < 0) return;
    (void)hipMemsetAsync((char*)d_ws + WS_CTL, 0, CTL_ZERO_BYTES, stream);
    Args a{};
    for (int i = 0; i < 15; ++i) a.in[i] = (const float*)d_in[i];
    a.out = (float*)d_out; a.ws = (unsigned char*)d_ws;
#if ONE_LAUNCH
    a.ph_lo = 0; a.ph_hi = NPHASE;
    hipLaunchKernelGGL(fwd_kernel, dim3(grid), dim3(NWAVES * 64), LDS_BYTES, stream, a);
#else
    for (int p = 0; p < NPHASE; ++p) { if (!phase_live(p)) continue; a.ph_lo = p; a.ph_hi = p + 1; hipLaunchKernelGGL(fwd_kernel, dim3(grid), dim3(NWAVES * 64), LDS_BYTES, stream, a); }
#endif
}
```

```cpp
#include <hip/hip_runtime.h>
#include <hip/hip_bf16.h>
#include <cstdio>
#include <cstdint>
#include <cmath>
namespace pg8 {
#define PG8_LAS __attribute__((address_space(3)))
typedef unsigned short bf16_t;
typedef short bf16x8 __attribute__((ext_vector_type(8)));
typedef float f32x4 __attribute__((ext_vector_type(4)));
typedef unsigned u32x4 __attribute__((ext_vector_type(4)));
constexpr int BM = 256, BK = 64, HALF = 128, HTB = HALF * BK * 2  , STAGE_BYTES = 8 * HTB, NXCD = 8, WGM = 8;

__host__ __device__ __forceinline__ int lds_byte(int r, int c) { const int st = (r >> 4) * 2 + (c >> 5), rr = r & 15, cc = c & 31, ob = rr * 64 + cc * 2; return st * 1024 + (ob ^ (((ob >> 9) & 1) << 5)); }
__host__ __device__ __forceinline__ void stage_rc(int b, int& R, int& C) { const int st = b / 1024, sb = b % 1024, swz = sb ^ (((sb >> 9) & 1) << 5); R = (st >> 1) * 16 + swz / 64; C = (st & 1) * 32 + (swz % 64) / 2; }
__host__ __device__ __forceinline__ int perm32(int rho) { const int n = rho >> 4, i = rho & 15; return 8 * (i >> 2) + 4 * n + (i & 3); }

struct Unit { int pm, pn; };
struct Gemm { const bf16_t* A; const bf16_t* Bt; int M, N, K; };

struct StaticOrder {
    int nM, nN, nwg, G, c;
    __host__ __device__ void init(int M, int N, int G_, int c_) { nM = M / BM; nN = N / BM; nwg = nM * nN; G = G_; c = c_; }
    __host__ __device__ bool next(int i, Unit& u) const {
        const long L = (long)i * G + c; if (L >= nwg) return false;
        int wgid = (int)L; { const int q = nwg / NXCD, r = nwg % NXCD, xcd = wgid % NXCD, off = wgid / NXCD; wgid = (xcd < r ? xcd * (q + 1) : r * (q + 1) + (xcd - r) * q) + off; }
        const int nig = WGM * nN, gid = wgid / nig, fm = gid * WGM, gsz = (nM - fm) < WGM ? (nM - fm) : WGM;
        u.pm = fm + ((wgid % nig) % gsz); u.pn = (wgid % nig) / gsz; return true;
    }
    __device__ __forceinline__ void a_ready(const Unit&) const {}
    __device__ __forceinline__ void done(const Unit&) const {}
};

__device__ __forceinline__ unsigned cvt_pk_bf16(float lo, float hi) { unsigned r; asm volatile("v_cvt_pk_bf16_f32 %0, %1, %2" : "=v"(r) : "v"(lo), "v"(hi)); return r; }
typedef float f32x2 __attribute__((ext_vector_type(2)));
__device__ __forceinline__ f32x2 gelu_pk(f32x2 v) {
    const f32x2 av = __builtin_elementwise_abs(v), d = av * 0.2316418882f + 1.0f;
    f32x2 t; t.x = __builtin_amdgcn_rcpf(d.x); t.y = __builtin_amdgcn_rcpf(d.y);
    f32x2 q = t * 0.5307027145f + (-0.7265760135f); q = q * t + 0.7107068705f; q = q * t + (-0.142248368f); q = q * t + 0.127414796f; q = q * t;
    const f32x2 s = (v * v) * (-0.72134752044f);
    f32x2 e; e.x = __builtin_amdgcn_exp2f(s.x); e.y = __builtin_amdgcn_exp2f(s.y);
    const f32x2 m = v * (q * e), r = v - m;
    f32x2 o; o.x = v.x < 0.f ? m.x : r.x; o.y = v.y < 0.f ? m.y : r.y; return o;
}

template <int ACT  > struct EpiBf16 {
    static constexpr bool PERM = true, AFTER_DRAIN = false; static_assert(ACT == 0 || ACT == 1, "EpiBf16: ACT is 0 (none) or 1 (gelu_pk)");
    bf16_t* O; int ldc; const float* bias; int split_cols; size_t split_stride; float scale0;
    __device__ __forceinline__ void operator()(const f32x4 (&acc)[2][2][4][2], const Unit& u, int wr, int wc, int fr, int fq) const {
        const int row0 = u.pm * BM + wr * 64 + fr; int colt = u.pn * BM; bf16_t* base = O;
        float sc = 1.f; if (split_cols) { const int t = colt / split_cols; base += (size_t)t * split_stride; colt -= t * split_cols; if (t == 0) sc = scale0; }
        const int col0 = colt + wc * 32 + 8 * fq, bcol0 = u.pn * BM + wc * 32 + 8 * fq;
        f32x4 bv[2][2];
#pragma unroll
        for (int bj = 0; bj < 2; ++bj)
#pragma unroll
            for (int n = 0; n < 2; ++n) bv[bj][n] = bias ? *(const f32x4*)(bias + bcol0 + bj * HALF + 4 * n) : (f32x4){0.f, 0.f, 0.f, 0.f};
#pragma unroll
        for (int ai = 0; ai < 2; ++ai)
#pragma unroll
            for (int m = 0; m < 4; ++m) { bf16_t* rowp = base + (size_t)(row0 + ai * HALF + m * 16) * ldc + col0;
#pragma unroll
                for (int bj = 0; bj < 2; ++bj) { f32x4 v0 = acc[ai][bj][m][0] + bv[bj][0], v1 = acc[ai][bj][m][1] + bv[bj][1];
                    if (ACT == 1) { f32x2 a = gelu_pk((f32x2){v0[0], v0[1]}), b = gelu_pk((f32x2){v0[2], v0[3]}), c = gelu_pk((f32x2){v1[0], v1[1]}), d = gelu_pk((f32x2){v1[2], v1[3]});
                        v0 = (f32x4){a.x, a.y, b.x, b.y}; v1 = (f32x4){c.x, c.y, d.x, d.y}; }
                    v0 = v0 * sc; v1 = v1 * sc; u32x4 w; w.x = cvt_pk_bf16(v0[0], v0[1]); w.y = cvt_pk_bf16(v0[2], v0[3]); w.z = cvt_pk_bf16(v1[0], v1[1]); w.w = cvt_pk_bf16(v1[2], v1[3]);
                    *(u32x4*)(rowp + bj * HALF) = w; } }
    }
};
struct EpiRes {
    static constexpr bool PERM = false, AFTER_DRAIN = false;
    const float* res; float* out; int ldc;
    __device__ __forceinline__ void operator()(const f32x4 (&acc)[2][2][4][2], const Unit& u, int wr, int wc, int fr, int fq) const {
        const int row0 = u.pm * BM + wr * 64 + fr, col0 = u.pn * BM + wc * 32 + 4 * fq;
#pragma unroll
        for (int ai = 0; ai < 2; ++ai)
#pragma unroll
            for (int m = 0; m < 4; ++m) { const size_t off = (size_t)(row0 + ai * HALF + m * 16) * ldc + col0;
                f32x4 r[2][2];
#pragma unroll
                for (int bj = 0; bj < 2; ++bj)
#pragma unroll
                    for (int n = 0; n < 2; ++n) r[bj][n] = *(const f32x4*)(res + off + bj * HALF + n * 16);
#pragma unroll
                for (int bj = 0; bj < 2; ++bj)
#pragma unroll
                    for (int n = 0; n < 2; ++n) *(f32x4*)(out + off + bj * HALF + n * 16) = r[bj][n] + acc[ai][bj][m][n]; }
    }
};
struct EpiBf16R {
    static constexpr bool PERM = true, AFTER_DRAIN = false;
    bf16_t* O; int ldc; int split_cols; size_t split_stride; const unsigned long long* ss; float inv_k, eps;
    __device__ __forceinline__ void operator()(const f32x4 (&acc)[2][2][4][2], const Unit& u, int wr, int wc, int fr, int fq) const {
        const int row0 = u.pm * BM + wr * 64 + fr; int colt = u.pn * BM; bf16_t* base = O;
        { const int t = colt / split_cols; base += (size_t)t * split_stride; colt -= t * split_cols; }
        const int col0 = colt + wc * 32 + 8 * fq;
        float rs[2][4];
#pragma unroll
        for (int ai = 0; ai < 2; ++ai)
#pragma unroll
            for (int m = 0; m < 4; ++m) rs[ai][m] = (float)ss[row0 + ai * HALF + m * 16] * (1.0f / 16777216.0f);
#pragma unroll
        for (int ai = 0; ai < 2; ++ai)
#pragma unroll
            for (int m = 0; m < 4; ++m) { bf16_t* rowp = base + (size_t)(row0 + ai * HALF + m * 16) * ldc + col0;
                const float sc = __builtin_amdgcn_rsqf(rs[ai][m] * inv_k + eps);
#pragma unroll
                for (int bj = 0; bj < 2; ++bj) { const f32x4 v0 = acc[ai][bj][m][0] * sc, v1 = acc[ai][bj][m][1] * sc;
                    u32x4 w; w.x = cvt_pk_bf16(v0[0], v0[1]); w.y = cvt_pk_bf16(v0[2], v0[3]); w.z = cvt_pk_bf16(v1[0], v1[1]); w.w = cvt_pk_bf16(v1[2], v1[3]);
                    *(u32x4*)(rowp + bj * HALF) = w; } }
    }
};
struct EpiResX {
    static constexpr bool PERM = false, AFTER_DRAIN = false;
    const float* res; float* out; int ldc; bf16_t* xb; unsigned long long* ssn;
    __device__ __forceinline__ void operator()(const f32x4 (&acc)[2][2][4][2], const Unit& u, int wr, int wc, int fr, int fq) const {
        typedef unsigned u32x2 __attribute__((ext_vector_type(2)));
        const int row0 = u.pm * BM + wr * 64 + fr, col0 = u.pn * BM + wc * 32 + 4 * fq;
#pragma unroll
        for (int ai = 0; ai < 2; ++ai)
#pragma unroll
            for (int m = 0; m < 4; ++m) { const int row = row0 + ai * HALF + m * 16; const size_t off = (size_t)row * ldc + col0;
                float s = 0.f;
#pragma unroll
                for (int bj = 0; bj < 2; ++bj) { const f32x4 r0 = *(const f32x4*)(res + off + bj * HALF), r1 = *(const f32x4*)(res + off + bj * HALF + 16);
#pragma unroll
                    for (int n = 0; n < 2; ++n) { const f32x4 o = (n ? r1 : r0) + acc[ai][bj][m][n]; *(f32x4*)(out + off + bj * HALF + n * 16) = o;
                        if (xb) { u32x2 w; w.x = cvt_pk_bf16(o[0], o[1]); w.y = cvt_pk_bf16(o[2], o[3]); *(u32x2*)(xb + off + bj * HALF + n * 16) = w;
                                  s += (o[0] * o[0] + o[1] * o[1]) + (o[2] * o[2] + o[3] * o[3]); } } }
                if (xb) { s += __shfl_xor(s, 16); s += __shfl_xor(s, 32); if (fq == 0) atomicAdd(ssn + row, (unsigned long long)(s * 16777216.0f)); } }
    }
};
struct EpiNull {
    static constexpr bool PERM = true, AFTER_DRAIN = false;
    __device__ __forceinline__ void operator()(const f32x4 (&acc)[2][2][4][2], const Unit& u, int wr, int wc, int fr, int fq) const {
#pragma unroll
        for (int ai = 0; ai < 2; ++ai)
#pragma unroll
            for (int bj = 0; bj < 2; ++bj)
#pragma unroll
                for (int m = 0; m < 4; ++m)
#pragma unroll
                    for (int n = 0; n < 2; ++n) asm volatile("" :: "v"(acc[ai][bj][m][n]));
    }
};
struct RepeatOrder {
    int n, c;
    __device__ bool next(int i, Unit& u) const { if (i >= n) return false; u.pm = c & 1; u.pn = 0; return true; }
    __device__ __forceinline__ void a_ready(const Unit&) const {}
    __device__ __forceinline__ void done(const Unit&) const {}
};
struct EpiResB {
    static constexpr bool PERM = false, AFTER_DRAIN = false;
    bf16_t* xb; int ldc; float* outf; unsigned long long* ssn;
    __device__ __forceinline__ void operator()(const f32x4 (&acc)[2][2][4][2], const Unit& u, int wr, int wc, int fr, int fq) const {
        typedef unsigned u32x2 __attribute__((ext_vector_type(2)));
        const int row0 = u.pm * BM + wr * 64 + fr, col0 = u.pn * BM + wc * 32 + 4 * fq;
#pragma unroll
        for (int ai = 0; ai < 2; ++ai)
#pragma unroll
            for (int m = 0; m < 4; ++m) { const int row = row0 + ai * HALF + m * 16; const size_t off = (size_t)row * ldc + col0;
                u32x2 r[2][2];
#pragma unroll
                for (int bj = 0; bj < 2; ++bj)
#pragma unroll
                    for (int n = 0; n < 2; ++n) r[bj][n] = *(const u32x2*)(xb + off + bj * HALF + n * 16);
                float s = 0.f;
#pragma unroll
                for (int bj = 0; bj < 2; ++bj)
#pragma unroll
                    for (int n = 0; n < 2; ++n) { const u32x2 rr = r[bj][n];
                        f32x4 o = acc[ai][bj][m][n]; o[0] += __uint_as_float(rr.x << 16); o[1] += __uint_as_float(rr.x & 0xffff0000u); o[2] += __uint_as_float(rr.y << 16); o[3] += __uint_as_float(rr.y & 0xffff0000u);
                        if (outf) { *(f32x4*)(outf + off + bj * HALF + n * 16) = o; }
                        else { u32x2 w; w.x = cvt_pk_bf16(o[0], o[1]); w.y = cvt_pk_bf16(o[2], o[3]); *(u32x2*)(xb + off + bj * HALF + n * 16) = w;
                               const float q0 = __uint_as_float(w.x << 16), q1 = __uint_as_float(w.x & 0xffff0000u), q2 = __uint_as_float(w.y << 16), q3 = __uint_as_float(w.y & 0xffff0000u);
                               s += (q0 * q0 + q1 * q1) + (q2 * q2 + q3 * q3); } }
                if (!outf) { s += __shfl_xor(s, 16); s += __shfl_xor(s, 32); if (fq == 0) atomicAdd(ssn + row, (unsigned long long)(s * 16777216.0f)); } }
    }
};
template <class Epi, class Sched, bool ALIGN_EPI = false, bool SP2 = false, bool BLK = false>
__device__ __forceinline__ void gemm_phase(PG8_LAS unsigned char* lds, const Gemm g, const Sched& S, const Epi& E) {
    int tid_ = threadIdx.x; asm volatile("" : "+v"(tid_));
    const int tid = tid_, wid = __builtin_amdgcn_readfirstlane(tid >> 6), lane = tid & 63, wr = wid >> 2, wc = wid & 3, fr = lane & 15, fq = lane >> 4;
    const int K = g.K, nt = K / BK;
    unsigned voffA[2], voffB[2];
#pragma unroll
    for (int i = 0; i < 2; ++i) { int R, C; stage_rc(tid * 16 + i * 8192, R, C); const int Rb = Epi::PERM ? ((R & ~31) + perm32(R & 31)) : R;
        voffA[i] = (unsigned)(R * (BLK ? BK : K) + C) * 2u; voffB[i] = (unsigned)(Rb * (BLK ? BK : K) + C) * 2u; }
    const size_t kstepA = BLK ? (size_t)g.M * BK * 2 : (size_t)(BK * 2), kstepB = BLK ? (size_t)g.N * BK * 2 : (size_t)(BK * 2);
    const size_t hstep = BLK ? (size_t)HALF * BK * 2 : (size_t)HALF * K * 2;
    const size_t tstep = 2 * hstep;
    const unsigned ldsw = (unsigned)wid * 1024u;
    const int aoff = lds_byte(wr * 64 + fr, fq * 8), boff = lds_byte(wc * 32 + fr, fq * 8);
#define PG8_SA(b, h) (((b) * 2 + (h)) * HTB)
#define PG8_SB(b, h) ((4 + (b) * 2 + (h)) * HTB)
#define PG8_STAGE(bufoff, gbase, voff) do { _Pragma("unroll") for (int _i = 0; _i < 2; ++_i) \
        __builtin_amdgcn_global_load_lds((const unsigned*)((const char*)(gbase) + (voff)[_i]), (PG8_LAS unsigned*)(lds + (bufoff) + ldsw + _i * 8192), 16, 0, 0); } while (0)
#define PG8_LDA(dst, b, h) do { _Pragma("unroll") for (int m = 0; m < 4; ++m) _Pragma("unroll") for (int k = 0; k < 2; ++k) dst[m][k] = *(const PG8_LAS bf16x8*)(lds + PG8_SA(b, h) + aoff + m * 2048 + k * 1024); } while (0)
#define PG8_LDB(dst, b, h) do { _Pragma("unroll") for (int n = 0; n < 2; ++n) _Pragma("unroll") for (int k = 0; k < 2; ++k) dst[n][k] = *(const PG8_LAS bf16x8*)(lds + PG8_SB(b, h) + boff + n * 2048 + k * 1024); } while (0)
#define PG8_MMA(ai, bj, At, Bt) do { __builtin_amdgcn_s_setprio(1); _Pragma("unroll") for (int m = 0; m < 4; ++m) _Pragma("unroll") for (int n = 0; n < 2; ++n) _Pragma("unroll") for (int k = 0; k < 2; ++k) \
        acc[ai][bj][m][n] = __builtin_amdgcn_mfma_f32_16x16x32_bf16(Bt[n][k], At[m][k], acc[ai][bj][m][n], 0, 0, 0); __builtin_amdgcn_s_setprio(0); } while (0)
#define PG8_WAIT_V(n) asm volatile("s_waitcnt vmcnt(" #n ")" ::: "memory")
#define PG8_WAIT_L(n) asm volatile("s_waitcnt lgkmcnt(" #n ")" ::: "memory")
#define PG8_BAR __builtin_amdgcn_s_barrier()
#define PG8_SCHED __builtin_amdgcn_sched_barrier(0)
    Unit cur, nxt; int ui = 0;
    if (!S.next(0, cur)) return;
    f32x4 acc[2][2][4][2];
#pragma unroll
    for (int a = 0; a < 2; ++a)
#pragma unroll
        for (int b = 0; b < 2; ++b)
#pragma unroll
            for (int m = 0; m < 4; ++m)
#pragma unroll
                for (int n = 0; n < 2; ++n) acc[a][b][m][n] = (f32x4){0.f, 0.f, 0.f, 0.f};
    bf16x8 At[4][2], B0[2][2], B1[2][2];
    const char* cA = (const char*)g.A + (size_t)cur.pm * tstep; const char* cB = (const char*)g.Bt + (size_t)cur.pn * tstep;
    S.a_ready(cur);
    if constexpr (SP2) {
        PG8_STAGE(PG8_SB(0, 0), cB, voffB); PG8_STAGE(PG8_SB(0, 1), cB + hstep, voffB); PG8_STAGE(PG8_SA(0, 0), cA, voffA); PG8_STAGE(PG8_SA(0, 1), cA + hstep, voffA);
        if (wr == 1) PG8_BAR;
        PG8_WAIT_V(2); PG8_BAR;
        PG8_STAGE(PG8_SB(1, 0), cB + kstepB, voffB); PG8_STAGE(PG8_SA(1, 0), cA + kstepA, voffA); PG8_STAGE(PG8_SB(1, 1), cB + hstep + kstepB, voffB);
        PG8_WAIT_V(6); PG8_BAR;
    } else {
        PG8_STAGE(PG8_SB(0, 0), cB, voffB); PG8_STAGE(PG8_SA(0, 0), cA, voffA); PG8_STAGE(PG8_SB(0, 1), cB + hstep, voffB); PG8_STAGE(PG8_SA(0, 1), cA + hstep, voffA);
        if (wr == 1) PG8_BAR;
        PG8_WAIT_V(4); PG8_BAR;
        PG8_STAGE(PG8_SB(1, 0), cB + kstepB, voffB); PG8_STAGE(PG8_SA(1, 0), cA + kstepA, voffA); PG8_STAGE(PG8_SB(1, 1), cB + hstep + kstepB, voffB);
        PG8_WAIT_V(6); PG8_BAR;
    }
    for (;;) {
        const bool has_next = S.next(ui + 1, nxt);
        const char* nA = has_next ? (const char*)g.A + (size_t)nxt.pm * tstep : cA; const char* nB = has_next ? (const char*)g.Bt + (size_t)nxt.pn * tstep : cB;
        for (int t = 0; t < nt; t += 2) {
            const bool last = (t == nt - 2);
            const char* a1 = cA + (size_t)(t + 1) * kstepA;
            const char* a2 = last ? nA : cA + (size_t)(t + 2) * kstepA; const char* b2 = last ? nB : cB + (size_t)(t + 2) * kstepB;
            const char* a3 = a2 + kstepA; const char* b3 = b2 + kstepB;
            if (last && has_next) S.a_ready(nxt);
            if constexpr (SP2) {
            PG8_LDB(B0, 0, 0); PG8_LDB(B1, 0, 1); PG8_SCHED; PG8_LDA(At, 0, 0); PG8_STAGE(PG8_SA(1, 1), a1 + hstep, voffA);
            PG8_WAIT_V(8); PG8_WAIT_L(0); PG8_BAR; PG8_MMA(0, 0, At, B0); PG8_MMA(0, 1, At, B1); PG8_BAR; PG8_SCHED;
            PG8_LDA(At, 0, 1); PG8_STAGE(PG8_SB(0, 0), b2, voffB); PG8_STAGE(PG8_SB(0, 1), b2 + hstep, voffB); PG8_STAGE(PG8_SA(0, 0), a2, voffA);
            PG8_WAIT_V(8); PG8_WAIT_L(0); PG8_BAR; PG8_MMA(1, 0, At, B0); PG8_MMA(1, 1, At, B1); PG8_BAR; PG8_SCHED;
            PG8_LDB(B0, 1, 0); PG8_LDB(B1, 1, 1); PG8_SCHED; PG8_LDA(At, 1, 0); PG8_STAGE(PG8_SA(0, 1), a2 + hstep, voffA);
            PG8_WAIT_V(8); PG8_WAIT_L(0); PG8_BAR; PG8_MMA(0, 0, At, B0); PG8_MMA(0, 1, At, B1); PG8_BAR; PG8_SCHED;
            PG8_LDA(At, 1, 1); PG8_STAGE(PG8_SB(1, 0), b3, voffB); PG8_STAGE(PG8_SB(1, 1), b3 + hstep, voffB); PG8_STAGE(PG8_SA(1, 0), a3, voffA);
            PG8_WAIT_V(8); PG8_WAIT_L(0); PG8_BAR; PG8_MMA(1, 0, At, B0); PG8_MMA(1, 1, At, B1); PG8_BAR; PG8_SCHED;
            } else {
            PG8_LDB(B0, 0, 0); PG8_SCHED; PG8_LDA(At, 0, 0); PG8_STAGE(PG8_SA(1, 1), a1 + hstep, voffA);
            PG8_WAIT_L(8); PG8_BAR; PG8_WAIT_L(0); PG8_MMA(0, 0, At, B0); PG8_BAR; PG8_SCHED;
            PG8_LDB(B1, 0, 1); PG8_STAGE(PG8_SB(0, 0), b2, voffB);
            PG8_BAR; PG8_WAIT_L(0); PG8_MMA(0, 1, At, B1); PG8_BAR;
            PG8_LDA(At, 0, 1); PG8_STAGE(PG8_SA(0, 0), a2, voffA);
            PG8_BAR; PG8_WAIT_L(0); PG8_MMA(1, 0, At, B0); PG8_BAR; PG8_SCHED;
            PG8_STAGE(PG8_SB(0, 1), b2 + hstep, voffB);
            PG8_WAIT_V(6); PG8_BAR; PG8_MMA(1, 1, At, B1); PG8_BAR;
            PG8_LDB(B0, 1, 0); PG8_SCHED; PG8_LDA(At, 1, 0); PG8_STAGE(PG8_SA(0, 1), a2 + hstep, voffA);
            PG8_WAIT_L(8); PG8_BAR; PG8_WAIT_L(0); PG8_MMA(0, 0, At, B0); PG8_BAR; PG8_SCHED;
            PG8_LDB(B1, 1, 1); PG8_STAGE(PG8_SB(1, 0), b3, voffB);
            PG8_BAR; PG8_WAIT_L(0); PG8_MMA(0, 1, At, B1); PG8_BAR;
            PG8_LDA(At, 1, 1); PG8_STAGE(PG8_SA(1, 0), a3, voffA);
            PG8_BAR; PG8_WAIT_L(0); PG8_MMA(1, 0, At, B0); PG8_BAR; PG8_SCHED;
            PG8_STAGE(PG8_SB(1, 1), b3 + hstep, voffB);
            PG8_WAIT_V(6); PG8_BAR; PG8_MMA(1, 1, At, B1); PG8_BAR;
            }
        }
        if constexpr (ALIGN_EPI) { if (wr == 0) PG8_BAR; }
        if constexpr (!Epi::AFTER_DRAIN) { E(acc, cur, wr, wc, fr, fq); S.done(cur); }
        if (!has_next) break;
#pragma unroll
        for (int a = 0; a < 2; ++a)
#pragma unroll
            for (int b = 0; b < 2; ++b)
#pragma unroll
                for (int m = 0; m < 4; ++m)
#pragma unroll
                    for (int n = 0; n < 2; ++n) acc[a][b][m][n] = (f32x4){0.f, 0.f, 0.f, 0.f};
        cur = nxt; cA = nA; cB = nB; ++ui;
        if constexpr (ALIGN_EPI) { if (wr == 1) PG8_BAR; }
    }
    PG8_WAIT_V(0);
    if constexpr (!ALIGN_EPI) { if (wr == 0) PG8_BAR; }
    PG8_BAR;
    if constexpr (Epi::AFTER_DRAIN) { E.fused(acc, cur, wr, wc, fr, fq, lds, wid, lane); S.done(cur); }
#undef PG8_SA
#undef PG8_SB
#undef PG8_STAGE
#undef PG8_LDA
#undef PG8_LDB
#undef PG8_MMA
#undef PG8_WAIT_V
#undef PG8_WAIT_L
#undef PG8_BAR
#undef PG8_SCHED
}
}
namespace fox {
constexpr int ALD = 2048;
constexpr int AD = 128;
constexpr float SCALE = 0.08838834764831845f;
constexpr float INVS = 11.313708498984761f;
constexpr float THR = 8.f;
constexpr int NW = 8, QBLK = 32, KVBLK = 64, QB = NW * QBLK;
constexpr int SHM_V = KVBLK * AD * 2, SHM_K = KVBLK * AD * 2;
constexpr int LDS_F = 2 * SHM_V + 2 * SHM_K + NW * 64 * 4;
constexpr int LDS_BYTES = LDS_F + 2 * 256;
constexpr int SO_PITCH = 264, SO_WAVE = 32 * SO_PITCH, LDS_SO = 71680;
constexpr float NEPS = 1e-6f;

using bf16 = __hip_bfloat16;
typedef short bf16x8 __attribute__((ext_vector_type(8)));
typedef short s16x4 __attribute__((ext_vector_type(4)));
typedef float f32x16 __attribute__((ext_vector_type(16)));
typedef float f32x4 __attribute__((ext_vector_type(4)));
typedef unsigned u32x4 __attribute__((ext_vector_type(4)));

#define KSWZ(row, colB) ((row) * 256 + ((colB) ^ (((row) & 7) << 4)))
#define SBAR() __builtin_amdgcn_sched_barrier(0)
__device__ __forceinline__ int v_st(int k, int c) { const int kk = (k & ~0xC) | ((k & 4) << 1) | ((k & 8) >> 1); return ((kk >> 3) * 4 + (c >> 5)) * 512 + ((kk & 7) * 32 + (c & 31)) * 2; }
__device__ __forceinline__ int v_rd_base(int lane) { return ((lane & 3) << 3) | (((lane >> 2) & 3) << 6) | (((lane >> 4) & 1) << 5) | (((lane >> 5) & 1) << 8); }
constexpr int v_rd_off(int d0, int ks, int half) { return d0 * 512 + ks * 4096 + half * 2048; }
__device__ __forceinline__ int crow(int r, int hi) { return (r & 3) + 8 * (r >> 2) + 4 * hi; }
__device__ __forceinline__ unsigned cvtpk(float lo, float hi) {
    unsigned r; asm volatile("v_cvt_pk_bf16_f32 %0, %1, %2" : "=v"(r) : "v"(lo), "v"(hi)); return r;
}
typedef __amdgpu_buffer_rsrc_t rsrc_t;
__device__ __forceinline__ rsrc_t mk_rsrc(const void* p) { return __builtin_amdgcn_make_buffer_rsrc((void*)p, (short)0, 0x7ffffff0, 0x00020000); }
__device__ __forceinline__ bf16x8 ldb8(rsrc_t r, int voff, int soff) { return __builtin_bit_cast(bf16x8, __builtin_amdgcn_raw_buffer_load_b128(r, voff, soff, 0)); }
__device__ __forceinline__ f32x4 ldf4(rsrc_t r, int voff, int soff) { return __builtin_bit_cast(f32x4, __builtin_amdgcn_raw_buffer_load_b128(r, voff, soff, 0)); }
__device__ __forceinline__ void mask_tile(f32x16& p0, f32x16& p1, int dq, unsigned W) {
    const float NEG = -__builtin_inff();
#pragma unroll
    for (int r = 0; r < 16; ++r) {
        const int c = (r & 3) + 8 * (r >> 2);
        if ((unsigned)(dq - c) >= W) p0[r] = NEG;
        if ((unsigned)(dq - c - 32) >= W) p1[r] = NEG;
    }
}
__device__ __forceinline__ void partialSM(f32x16& p0, f32x16& p1, float& m_reg, float& mn, float& alpha) {
    float pmax = p0[0]; for (int r = 1; r < 16; ++r) pmax = fmaxf(pmax, p0[r]); for (int r = 0; r < 16; ++r) pmax = fmaxf(pmax, p1[r]);
    { auto rr = __builtin_amdgcn_permlane32_swap(__float_as_uint(pmax), __float_as_uint(pmax), false, false);
      pmax = fmaxf(__uint_as_float(rr[0]), __uint_as_float(rr[1])); }
    constexpr float C2 = 1.4426950408889634f * SCALE;
    if (__builtin_expect(__all((pmax - m_reg) * SCALE <= THR), 1)) { mn = m_reg; alpha = 1.f; }
    else { mn = fmaxf(m_reg, pmax); alpha = __builtin_amdgcn_exp2f((m_reg - mn) * C2); m_reg = mn; }
    const float mnL = -mn * C2;
    for (int r = 0; r < 16; ++r) p0[r] = fmaf(p0[r], C2, mnL); for (int r = 0; r < 16; ++r) p1[r] = fmaf(p1[r], C2, mnL);
    for (int r = 0; r < 16; ++r) p0[r] = __builtin_amdgcn_exp2f(p0[r]);
}
__device__ __forceinline__ void finishSM(f32x16& p0, f32x16& p1, float alpha, float& l_reg, bf16x8& pa0, bf16x8& pa1, bf16x8& pa2, bf16x8& pa3) {
    for (int r = 0; r < 16; ++r) p1[r] = __builtin_amdgcn_exp2f(p1[r]);
    float ps = 0; for (int r = 0; r < 16; ++r) ps += p0[r]; for (int r = 0; r < 16; ++r) ps += p1[r];
    { auto rr = __builtin_amdgcn_permlane32_swap(__float_as_uint(ps), __float_as_uint(ps), false, false);
      ps = __uint_as_float(rr[0]) + __uint_as_float(rr[1]); }
    l_reg = l_reg * alpha + ps;
#define PK4(P, B_, OUT) do { unsigned a0 = cvtpk(P[B_+0], P[B_+1]), a1 = cvtpk(P[B_+2], P[B_+3]);                          \
        unsigned b0 = cvtpk(P[B_+4], P[B_+5]), b1 = cvtpk(P[B_+6], P[B_+7]);                                             \
        auto r0 = __builtin_amdgcn_permlane32_swap(a0, b0, false, false); auto r1 = __builtin_amdgcn_permlane32_swap(a1, b1, false, false); \
        u32x4 w = {r0[0], r1[0], r0[1], r1[1]}; OUT = *reinterpret_cast<bf16x8*>(&w); } while (0)
    PK4(p0, 0, pa0); PK4(p0, 8, pa1); PK4(p1, 0, pa2); PK4(p1, 8, pa3);
#undef PK4
}
template <int KB>
__device__ __forceinline__ void qkt(f32x16& p0, f32x16& p1, const char* K_lds, const char* F_lds, int r32, int hi, const bf16x8* qr) {
    { const f32x4* fk = reinterpret_cast<const f32x4*>(F_lds + KB * 256);
#pragma unroll
      for (int g = 0; g < 4; ++g) { const f32x4 a = fk[2 * g + hi], b = fk[8 + 2 * g + hi];
#pragma unroll
          for (int e = 0; e < 4; ++e) { p0[4 * g + e] = a[e]; p1[4 * g + e] = b[e]; } } }
    const char* kb[4];
#pragma unroll
    for (int dd = 0; dd < 4; ++dd) kb[dd] = K_lds + KB * SHM_K + KSWZ(r32, (dd * 16 + hi * 8) * 2);
#pragma unroll
    for (int d0 = 0; d0 < 8; ++d0) { const char* a = kb[d0 & 3] + (d0 >> 2) * 128;
        bf16x8 b0 = *reinterpret_cast<const bf16x8*>(a);
        bf16x8 b1 = *reinterpret_cast<const bf16x8*>(a + 32 * 256);
        p0 = __builtin_amdgcn_mfma_f32_32x32x16_bf16(b0, qr[d0], p0, 0, 0, 0);
        p1 = __builtin_amdgcn_mfma_f32_32x32x16_bf16(b1, qr[d0], p1, 0, 0, 0); }
}
template <int VB>
__device__ __forceinline__ void pv_tile(f32x16* o, int vb0, bf16x8 pa0, bf16x8 pa1, bf16x8 pa2, bf16x8 pa3) {
#define TRRD(dst, off) asm volatile("ds_read_b64_tr_b16 %0, %1 offset:%2" : "=&v"(dst) : "v"(vb0), "i"(off) : "memory")
#define PV_D0(d0) do { s16x4 l0, l1, l2, l3, h0, h1, h2, h3; constexpr int b_ = VB * SHM_V + v_rd_off(d0, 0, 0);     \
        TRRD(l0, b_); TRRD(h0, b_ + 2048); TRRD(l1, b_ + 4096); TRRD(h1, b_ + 6144); TRRD(l2, b_ + 8192); TRRD(h2, b_ + 10240); TRRD(l3, b_ + 12288); TRRD(h3, b_ + 14336); \
        asm volatile("s_waitcnt lgkmcnt(0)" ::: "memory"); SBAR();                 \
        o[d0] = __builtin_amdgcn_mfma_f32_32x32x16_bf16(pa0, (bf16x8){l0[0], l0[1], l0[2], l0[3], h0[0], h0[1], h0[2], h0[3]}, o[d0], 0, 0, 0);   \
        o[d0] = __builtin_amdgcn_mfma_f32_32x32x16_bf16(pa1, (bf16x8){l1[0], l1[1], l1[2], l1[3], h1[0], h1[1], h1[2], h1[3]}, o[d0], 0, 0, 0);   \
        o[d0] = __builtin_amdgcn_mfma_f32_32x32x16_bf16(pa2, (bf16x8){l2[0], l2[1], l2[2], l2[3], h2[0], h2[1], h2[2], h2[3]}, o[d0], 0, 0, 0);   \
        o[d0] = __builtin_amdgcn_mfma_f32_32x32x16_bf16(pa3, (bf16x8){l3[0], l3[1], l3[2], l3[3], h3[0], h3[1], h3[2], h3[3]}, o[d0], 0, 0, 0); } while (0)
    PV_D0(0); PV_D0(1); PV_D0(2); PV_D0(3);
#undef PV_D0
#undef TRRD
}

struct BlockRef { const bf16* Q; const bf16* K; const bf16* V; bf16* O; const float* F; const bf16* G; const float* wo; int P0; int jlo; };
struct Seam {
    bf16x8 qr[8];
    bf16x8 st_v0, st_v1, st_k0, st_k1; f32x4 st_f;
};
#define VMW() asm volatile("s_waitcnt vmcnt(0)" ::: "memory")
#define VMWN(n) asm volatile("s_waitcnt vmcnt(%0)" :: "i"(n) : "memory")
#define SLOAD_H(rK_, rV_, rF_, k0) do { const int so_ = (k0) * (ALD * 2);                                                    \
                         S.st_v0 = ldb8(rV_, kvoff, so_); S.st_v1 = ldb8(rV_, kvoff, so_ + 32 * ALD * 2);                    \
                         S.st_k0 = ldb8(rK_, kvoff, so_); S.st_k1 = ldb8(rK_, kvoff, so_ + 32 * ALD * 2);                    \
                         if (tid < 16) S.st_f = ldf4(rF_, tid * 16, (k0) * 4); } while (0)
#define QLOAD(rQ_) do { _Pragma("unroll") for (int d0 = 0; d0 < 8; ++d0) S.qr[d0] = ldb8(rQ_, qoff + d0 * 32, 0); } while (0)
#define SWRITE_HK(bf) do { *(bf16x8*)(K_lds + (bf) * SHM_K + kws) = S.st_k0; *(bf16x8*)(K_lds + (bf) * SHM_K + kws + 32 * 256) = S.st_k1; \
                           if (tid < 16) *(f32x4*)(F_lds + (bf) * 256 + tid * 16) = S.st_f; } while (0)
#define SWRITE_HV(bf) do { *(bf16x8*)(V_lds + (bf) * SHM_V + vst0) = S.st_v0; *(bf16x8*)(V_lds + (bf) * SHM_V + vst1) = S.st_v1; } while (0)
#define SWRITE_H(bf) do { SWRITE_HV(bf); SWRITE_HK(bf); } while (0)
__device__ __forceinline__ int fox_jlo(const float* Fn, int P0, float TH) {
    int lane_ = threadIdx.x & 63; asm volatile("" : "+v"(lane_));
    const int ntf = P0 / KVBLK + 4, kt = lane_ < ntf ? lane_ : ntf - 1;
    int zero_ = 0; asm volatile("" : "+v"(zero_));
    const float fe = Fn[kt * KVBLK + KVBLK - 1], fp0 = Fn[P0 + zero_];
    const unsigned long long mk = __ballot(fp0 - fe <= TH);
    return (int)__builtin_ctzll(mk);
}
__device__ __forceinline__ void normalize_q(bf16x8* qr, const float* wq, int hi) {
    float ss = 0.f;
#pragma unroll
    for (int d0 = 0; d0 < 8; ++d0) { const u32x4 w = __builtin_bit_cast(u32x4, qr[d0]);
#pragma unroll
        for (int e = 0; e < 4; ++e) { const float a = __uint_as_float(w[e] << 16), b = __uint_as_float(w[e] & 0xffff0000u); ss += a * a + b * b; } }
    { auto rr = __builtin_amdgcn_permlane32_swap(__float_as_uint(ss), __float_as_uint(ss), false, false); ss = __uint_as_float(rr[0]) + __uint_as_float(rr[1]); }
    const float rs = __builtin_amdgcn_rsqf(ss * (1.f / AD) + NEPS);
#pragma unroll
    for (int d0 = 0; d0 < 8; ++d0) { const u32x4 w = __builtin_bit_cast(u32x4, qr[d0]); const f32x4 w0 = *(const f32x4*)(wq + d0 * 16 + hi * 8), w1 = *(const f32x4*)(wq + d0 * 16 + hi * 8 + 4);
        u32x4 o; o[0] = cvtpk(__uint_as_float(w[0] << 16) * rs * w0[0], __uint_as_float(w[0] & 0xffff0000u) * rs * w0[1]); o[1] = cvtpk(__uint_as_float(w[1] << 16) * rs * w0[2], __uint_as_float(w[1] & 0xffff0000u) * rs * w0[3]);
        o[2] = cvtpk(__uint_as_float(w[2] << 16) * rs * w1[0], __uint_as_float(w[2] & 0xffff0000u) * rs * w1[1]); o[3] = cvtpk(__uint_as_float(w[3] << 16) * rs * w1[2], __uint_as_float(w[3] & 0xffff0000u) * rs * w1[3]);
        qr[d0] = __builtin_bit_cast(bf16x8, o); }
}
__device__ __forceinline__ void causal_prime(const BlockRef& cur, char* lds, Seam& S) {
    int tid_ = threadIdx.x; asm volatile("" : "+v"(tid_));
    const int tid = tid_, wid = __builtin_amdgcn_readfirstlane(tid >> 6), lane = tid & 63, r32 = lane & 31, hi = lane >> 5;
    const int sr = tid >> 4, sc = (tid & 15) * 8, kws = KSWZ(sr, sc * 2); char* K_lds = lds + 2 * SHM_V; char* F_lds = lds + LDS_F;
    const int kvoff = (sr * ALD + sc) * 2, qoff = ((wid * QBLK + r32) * ALD + hi * 8) * 2;
    const rsrc_t rQ = mk_rsrc(cur.Q), rK = mk_rsrc(cur.K), rV = mk_rsrc(cur.V), rF = mk_rsrc(cur.F);
    QLOAD(rQ);
    SLOAD_H(rK, rV, rF, cur.jlo * KVBLK); VMW(); SWRITE_HK(0);
    __syncthreads();
}
__device__ __forceinline__ void causal_block(const BlockRef& cur, const BlockRef& nxt, char* lds, Seam& S, const float* wq) {
    int tid_ = threadIdx.x; asm volatile("" : "+v"(tid_));
    const int tid = tid_, wid = __builtin_amdgcn_readfirstlane(tid >> 6), lane = tid & 63, r32 = lane & 31, hi = lane >> 5;
    constexpr int W = 1 << 30;
    const int j_lo = cur.jlo, NT = (cur.P0 + QB - 1) / KVBLK + 1 - j_lo;
    const int qlo = cur.P0 + wid * QBLK, qm = qlo + r32 - 4 * hi;
    char* V_lds = lds; char* K_lds = lds + 2 * SHM_V; char* F_lds = lds + LDS_F;
    float* ws = (float*)(lds + 2 * SHM_V + 2 * SHM_K) + wid * 64; float* li_l = ws, * al_l = ws + 32;
    float m_reg = -1e30f, l_reg = 0; f32x16 o[4] = {};
    const int sr = tid >> 4, sc = (tid & 15) * 8, vst0 = v_st(sr, sc), vst1 = v_st(32 + sr, sc), kws = KSWZ(sr, sc * 2);
    const int vb0 = (int)(uintptr_t)V_lds + v_rd_base(lane);
    const int kvoff = (sr * ALD + sc) * 2, qoff = ((wid * QBLK + r32) * ALD + hi * 8) * 2;
    const rsrc_t Kh = mk_rsrc(cur.K), Vh = mk_rsrc(cur.V), Fh = mk_rsrc(cur.F);
#define RESC(a) do { if (__any((a) < 1.f)) { if (hi == 0) al_l[r32] = (a); asm volatile("s_waitcnt lgkmcnt(0)" ::: "memory");              \
                     for (int d_ = 0; d_ < 4; ++d_) for (int r = 0; r < 16; ++r) o[d_][r] *= al_l[crow(r, hi)]; } } while (0)
#define KBASE(t) ((j_lo + (t)) * KVBLK)
#define MASKT(P0_, P1_, t) do { const int kb_ = KBASE(t); if (kb_ + KVBLK - 1 > qlo) mask_tile(P0_, P1_, qm - kb_, (unsigned)W); } while (0)
    constexpr int NQL = 8;
#define SEAM_K0() do { VMWN(NQL); SWRITE_HK(0); SBAR(); } while (0)
    f32x16 pA0, pA1, pB0, pB1; float mnA, mnB, alA, alB; bf16x8 pa0, pa1, pa2, pa3;
    normalize_q(S.qr, wq, hi);
    SWRITE_HV(0); SBAR();
    if (NT > 1) { SLOAD_H(Kh, Vh, Fh, KBASE(1)); }
    SBAR(); qkt<0>(pA0, pA1, K_lds, F_lds, r32, hi, S.qr);
    MASKT(pA0, pA1, 0); partialSM(pA0, pA1, m_reg, mnA, alA);
    if (NT > 1) { VMW(); SWRITE_H(1); }
    __syncthreads();
#define HALF_STEP(PX0, PX1, mnX, alX, PY0, PY1, alY, t, KB, VB, SB) do {                                                      \
        SBAR(); qkt<KB>(PX0, PX1, K_lds, F_lds, r32, hi, S.qr);                                                               \
        finishSM(PY0, PY1, alY, l_reg, pa0, pa1, pa2, pa3); SBAR();                                                           \
        if ((t) + 1 < NT) { SLOAD_H(Kh, Vh, Fh, KBASE((t) + 1)); SBAR(); }                                                    \
        pv_tile<VB>(o, vb0, pa0, pa1, pa2, pa3); MASKT(PX0, PX1, (t)); partialSM(PX0, PX1, m_reg, mnX, alX);                  \
        __syncthreads();                                                                                                      \
        if ((t) + 1 < NT) { VMW(); SWRITE_H(SB); }                                                                            \
        RESC(alX); __syncthreads(); } while (0)
    for (int t = 1; t + 1 < NT; t += 2) {
        HALF_STEP(pB0, pB1, mnB, alB, pA0, pA1, alA, t, 1, 0, 0);
        HALF_STEP(pA0, pA1, mnA, alA, pB0, pB1, alB, t + 1, 0, 1, 1);
    }
    const bool even = (NT & 1) == 0;
    if (even) { SBAR(); qkt<1>(pB0, pB1, K_lds, F_lds, r32, hi, S.qr); SBAR(); }
    { const rsrc_t nK = mk_rsrc(nxt.K), nV = mk_rsrc(nxt.V), nF = mk_rsrc(nxt.F), nQ = mk_rsrc(nxt.Q);
      SLOAD_H(nK, nV, nF, nxt.jlo * KVBLK); SBAR();
      QLOAD(nQ); }
    SBAR();
    finishSM(pA0, pA1, alA, l_reg, pa0, pa1, pa2, pa3); SBAR();
    pv_tile<0>(o, vb0, pa0, pa1, pa2, pa3);
    if (even) { MASKT(pB0, pB1, NT - 1); partialSM(pB0, pB1, m_reg, mnB, alB); __syncthreads(); RESC(alB);
        finishSM(pB0, pB1, alB, l_reg, pa0, pa1, pa2, pa3); SBAR(); pv_tile<1>(o, vb0, pa0, pa1, pa2, pa3); }
    SBAR(); SEAM_K0();
    { char* so = lds + LDS_SO + wid * SO_WAVE;
      const int erow = lane >> 1, eh = lane & 1, eoff = ((wid * QBLK + erow) * ALD + eh * 64) * 2;
      const rsrc_t rG = mk_rsrc(cur.G), rO = mk_rsrc(cur.O);
      bf16x8 gt[8];
#pragma unroll
      for (int i = 0; i < 8; ++i) gt[i] = ldb8(rG, eoff + i * 16, 0);
      if (hi == 0) li_l[r32] = l_reg; asm volatile("s_waitcnt lgkmcnt(0)" ::: "memory");
#pragma unroll
      for (int r = 0; r < 16; ++r) { const float rl = __builtin_amdgcn_rcpf(li_l[crow(r, hi)]);
#pragma unroll
        for (int d0 = 0; d0 < 4; ++d0) *(unsigned short*)(so + crow(r, hi) * SO_PITCH + (d0 * 32 + r32) * 2) = (unsigned short)(cvtpk(o[d0][r] * rl, 0.f) & 0xffffu); }
      asm volatile("s_waitcnt lgkmcnt(0)" ::: "memory");
      typedef unsigned u32x2 __attribute__((ext_vector_type(2)));
      u32x2 xw[16]; float ssq = 0.f;
#pragma unroll
      for (int i = 0; i < 16; ++i) { xw[i] = *(const u32x2*)(so + erow * SO_PITCH + eh * 128 + i * 8);
#pragma unroll
        for (int e = 0; e < 2; ++e) { const float a = __uint_as_float(xw[i][e] << 16), b = __uint_as_float(xw[i][e] & 0xffff0000u); ssq += a * a + b * b; } }
      ssq += __shfl_xor(ssq, 1);
      const float rs = __builtin_amdgcn_rsqf(ssq * (1.f / AD) + NEPS);
#pragma unroll
      for (int i = 0; i < 8; ++i) { const f32x4 w0 = *(const f32x4*)(cur.wo + eh * 64 + i * 8), w1 = *(const f32x4*)(cur.wo + eh * 64 + i * 8 + 4);
        const u32x4 g = __builtin_bit_cast(u32x4, gt[i]); const float ww[8] = {w0[0], w0[1], w0[2], w0[3], w1[0], w1[1], w1[2], w1[3]};
        u32x4 ow;
#pragma unroll
        for (int e = 0; e < 4; ++e) { const unsigned xv = xw[2 * i + (e >> 1)][e & 1];
            const float x0 = __uint_as_float(xv << 16), x1 = __uint_as_float(xv & 0xffff0000u), g0 = __uint_as_float(g[e] << 16), g1 = __uint_as_float(g[e] & 0xffff0000u);
            const float s0 = g0 * __builtin_amdgcn_rcpf(1.f + __builtin_amdgcn_exp2f(-1.4426950408889634f * g0)), s1 = g1 * __builtin_amdgcn_rcpf(1.f + __builtin_amdgcn_exp2f(-1.4426950408889634f * g1));
            ow[e] = cvtpk(x0 * rs * ww[2 * e] * s0, x1 * rs * ww[2 * e + 1] * s1); }
        __builtin_amdgcn_raw_buffer_store_b128(ow, rO, eoff + i * 16, 0, 0); } }
    __syncthreads();
#undef RESC
#undef KBASE
#undef MASKT
#undef SEAM_K0
#undef HALF_STEP
}
#undef QLOAD
#undef VMW
#undef VMWN
#undef SLOAD_H
#undef SWRITE_HK
#undef SWRITE_HV
#undef SWRITE_H
#undef KSWZ
#undef SBAR
}
namespace rec {
typedef short bf16x8 __attribute__((ext_vector_type(8)));
typedef short bf16x4 __attribute__((ext_vector_type(4)));
typedef float f32x4 __attribute__((ext_vector_type(4)));
typedef float f32x2 __attribute__((ext_vector_type(2)));
typedef __bf16 bf16x2_t __attribute__((ext_vector_type(2)));
typedef unsigned u32x4 __attribute__((ext_vector_type(4)));
typedef unsigned u32x2 __attribute__((ext_vector_type(2)));
#define REC_LAS __attribute__((address_space(3)))
constexpr int RT = 4096, RD = 2048, NSEG = 4, SEG = RT / NSEG, NCH = SEG / 64;
constexpr int QP = 272, TP = 144;
constexpr int OFF_KB = 160 * QP, OFF_KHT = OFF_KB + 64 * QP, OFF_VT = OFF_KHT + 128 * TP, OFF_AM = OFF_VT + 128 * TP, OFF_TOT = OFF_AM + 64 * TP, OFF_DL = OFF_TOT + 8 * 128 * 4, OFF_SO = OFF_DL + 512, LDS_END = OFF_SO + 64 * QP;
static_assert(LDS_END <= 131072, "recurrence LDS map");
__device__ __forceinline__ constexpr int qv_off(int j) { return (64 * j - 8 * j * (j - 1)) * QP; }
__device__ __forceinline__ unsigned cvt2(float lo, float hi) { f32x2 v = {lo, hi}; bf16x2_t b = __builtin_convertvector(v, bf16x2_t); return __builtin_bit_cast(unsigned, b); }
__device__ __forceinline__ float ex2(float x) { return __builtin_amdgcn_exp2f(x); }
__device__ __forceinline__ float lo_f(unsigned w) { return __uint_as_float(w << 16); }
__device__ __forceinline__ float hi_f(unsigned w) { return __uint_as_float(w & 0xffff0000u); }

template <bool OUT>
__device__ __forceinline__ void run(REC_LAS unsigned char* lds, int G, const unsigned short* Qp, const unsigned short* Zp, const unsigned short* Vp, unsigned short* Op,
                                    const float* lbl, int layer, float* Ug, float* Dg, const unsigned short* Gp, const float* wo) {
    int tid_ = threadIdx.x; asm volatile("" : "+v"(tid_));
    const int tid = tid_, lane = tid & 63, wv = __builtin_amdgcn_readfirstlane(tid >> 6), fr = lane & 15, fg = lane >> 4;
    constexpr int NU = OUT ? 64 * NSEG : 64 * (NSEG - 1);
    if (OUT) { if (tid < 256) { const int blk = tid >> 7, r = (tid >> 3) & 15, c = tid & 7;
            *(REC_LAS unsigned*)(lds + OFF_AM + (32 * blk + r) * TP + (32 * blk + 16) * 2 + c * 4) = 0u; } }
    for (int u = blockIdx.x; u < NU; u += G) {
        const int bh = OUT ? u / NSEG : u / (NSEG - 1), seg = OUT ? u % NSEG : u % (NSEG - 1), b = bh >> 4, h = bh & 15;
        float lb[2];
#pragma unroll
        for (int dd = 0; dd < 2; ++dd) { const int c = h * 128 + 2 * lane + dd; lb[dd] = layer == 0 ? 0.f : 1.f / (1.f + __expf(lbl[c] - lbl[RD + c])); }
        f32x4 st[8];
#pragma unroll
        for (int kt = 0; kt < 8; ++kt) st[kt] = (f32x4){0.f, 0.f, 0.f, 0.f};
        if (OUT) {
            for (int s2 = 0; s2 < seg; ++s2) {
                const float* U = Ug + ((size_t)(bh * (NSEG - 1) + s2) << 14); const float* Dv = Dg + (bh * (NSEG - 1) + s2) * 128;
                f32x4 uu[8];
#pragma unroll
                for (int kt = 0; kt < 8; ++kt) uu[kt] = *(const f32x4*)(U + ((kt * 8 + wv) * 64 + lane) * 4);
#pragma unroll
                for (int kt = 0; kt < 8; ++kt) { const f32x4 dvv = *(const f32x4*)(Dv + 16 * kt + 4 * fg); st[kt] = dvv * st[kt] + uu[kt]; }
            }
        }
        const int er = tid >> 3, es = tid & 7;
#define REC_FLUSH(cp, g0, g1) do { const REC_LAS unsigned char* sp = lds + OFF_SO + er * QP + es * 32;                                          \
            const u32x4 x0 = *(const REC_LAS u32x4*)sp, x1 = *(const REC_LAS u32x4*)(sp + 16);                                                    \
            float xf[16], gf[16]; float ssq = 0.f;                                                                                                \
            _Pragma("unroll") for (int e = 0; e < 4; ++e) { xf[2 * e] = lo_f(x0[e]); xf[2 * e + 1] = hi_f(x0[e]); xf[8 + 2 * e] = lo_f(x1[e]); xf[9 + 2 * e] = hi_f(x1[e]);   \
                gf[2 * e] = lo_f(g0[e]); gf[2 * e + 1] = hi_f(g0[e]); gf[8 + 2 * e] = lo_f(g1[e]); gf[9 + 2 * e] = hi_f(g1[e]); }                 \
            _Pragma("unroll") for (int e = 0; e < 16; ++e) ssq += xf[e] * xf[e];                                                                  \
            ssq += __shfl_xor(ssq, 1); ssq += __shfl_xor(ssq, 2); ssq += __shfl_xor(ssq, 4);                                                      \
            const float rs_ = __builtin_amdgcn_rsqf(ssq * (1.f / 128.f) + 1e-6f);                                                                 \
            u32x4 y0, y1;                                                                                                                         \
            _Pragma("unroll") for (int q4 = 0; q4 < 4; ++q4) { const f32x4 w4 = *(const f32x4*)(wo + h * 128 + es * 16 + 4 * q4); float yv[4];     \
                _Pragma("unroll") for (int e = 0; e < 4; ++e) { const float g_ = gf[4 * q4 + e]; yv[e] = xf[4 * q4 + e] * rs_ * w4[e] * g_ * __builtin_amdgcn_rcpf(1.f + ex2(-1.4426950408889634f * g_)); } \
                if (q4 < 2) { y0[2 * q4] = cvt2(yv[0], yv[1]); y0[2 * q4 + 1] = cvt2(yv[2], yv[3]); } else { y1[2 * (q4 - 2)] = cvt2(yv[0], yv[1]); y1[2 * (q4 - 2) + 1] = cvt2(yv[2], yv[3]); } }   \
            unsigned short* op_ = Op + row0 + (size_t)(64 * (cp) + er) * RD + es * 16; *(u32x4*)op_ = y0; *(u32x4*)(op_ + 8) = y1; } while (0)
        float dsum[2] = {0.f, 0.f};
        const size_t row0 = (size_t)(b * RT + seg * SEG) * RD + h * 128;
        unsigned nq[8], nz[8], nv[8];
#pragma unroll
        for (int e = 0; e < 8; ++e) { const size_t o = row0 + (size_t)(8 * wv + e) * RD + 2 * lane; nq[e] = *(const unsigned*)(Qp + o); nz[e] = *(const unsigned*)(Zp + o); nv[e] = *(const unsigned*)(Vp + o); }
#pragma unroll 1
        for (int c = 0; c < NCH; ++c) {
            unsigned cq[8], cz[8], cv[8];
#pragma unroll
            for (int e = 0; e < 8; ++e) { cq[e] = nq[e]; cz[e] = nz[e]; cv[e] = nv[e]; }
            if (c + 1 < NCH) {
#pragma unroll
                for (int e = 0; e < 8; ++e) { const size_t o = row0 + (size_t)(64 * (c + 1) + 8 * wv + e) * RD + 2 * lane; nq[e] = *(const unsigned*)(Qp + o); nz[e] = *(const unsigned*)(Zp + o); nv[e] = *(const unsigned*)(Vp + o); }
            }
            float kf[8][2], cs[8][2];
#pragma unroll
            for (int e = 0; e < 8; ++e) {
#pragma unroll
                for (int dd = 0; dd < 2; ++dd) {
                    const float z = dd ? hi_f(cz[e]) : lo_f(cz[e]);
                    const float ez = ex2(-1.4426950408889634f * fabsf(z)), inv = __builtin_amdgcn_rcpf(1.f + ez);
                    const float sig = z >= 0.f ? inv : ez * inv, nsig = z >= 0.f ? ez * inv : inv;
                    const float f = lb[dd] + (1.f - lb[dd]) * sig;
                    kf[e][dd] = (1.f - lb[dd]) * nsig;
                    const float gl = __builtin_amdgcn_logf(f);
                    cs[e][dd] = e ? cs[e - 1][dd] + gl : gl;
                }
            }
            *(REC_LAS f32x2*)(lds + OFF_TOT + (wv * 128 + 2 * lane) * 4) = (f32x2){cs[7][0], cs[7][1]};
            __syncthreads();
            float P[9][2];
            P[0][0] = 0.f; P[0][1] = 0.f;
#pragma unroll
            for (int w = 0; w < 8; ++w) { const f32x2 t2 = *(const REC_LAS f32x2*)(lds + OFF_TOT + (w * 128 + 2 * lane) * 4); P[w + 1][0] = P[w][0] + t2[0]; P[w + 1][1] = P[w][1] + t2[1]; }
            float base[2], bl[2], Bj[4][2];
#pragma unroll
            for (int dd = 0; dd < 2; ++dd) { bl[dd] = P[8][dd]; float bs = 0.f;
#pragma unroll
                for (int w = 0; w < 8; ++w) bs = (w == wv) ? P[w][dd] : bs;
                base[dd] = bs;
#pragma unroll
                for (int j = 0; j < 4; ++j) Bj[j][dd] = P[2 * j][dd]; }
            const int jb = wv >> 1;
            float Bown[2];
#pragma unroll
            for (int dd = 0; dd < 2; ++dd) { float bo = 0.f;
#pragma unroll
                for (int j = 0; j < 4; ++j) bo = (j == jb) ? Bj[j][dd] : bo;
                Bown[dd] = bo; }
            float Ej[4][2], Eend[2];
#pragma unroll
            for (int dd = 0; dd < 2; ++dd) { Eend[dd] = ex2(bl[dd] - Bown[dd]);
#pragma unroll
                for (int j = 0; j < 4; ++j) Ej[j][dd] = (j < jb) ? ex2(Bown[dd] - Bj[j][dd]) : 1.f; }
            unsigned khw[2][4], vtw[2][4];
#pragma unroll
            for (int e = 0; e < 8; ++e) {
                const int t = 8 * wv + e;
                float eo[2], ko[2], qv[2];
#pragma unroll
                for (int dd = 0; dd < 2; ++dd) { const float x = base[dd] + cs[e][dd] - Bown[dd];
                    eo[dd] = ex2(x); ko[dd] = kf[e][dd] * ex2(fminf(-x, 120.f)); qv[dd] = (dd ? hi_f(cq[e]) : lo_f(cq[e])) * eo[dd]; }
                if (OUT) {
#pragma unroll
                    for (int j = 0; j < 4; ++j) if (j <= jb)
                        *(REC_LAS unsigned*)(lds + qv_off(j) + (t - 16 * j) * QP + lane * 4) = cvt2(qv[0] * Ej[j][0], qv[1] * Ej[j][1]);
                    *(REC_LAS unsigned*)(lds + OFF_KB + t * QP + lane * 4) = cvt2(ko[0], ko[1]);
                }
                const float kh0 = ko[0] * Eend[0], kh1 = ko[1] * Eend[1];
                if (e & 1) { khw[0][e >> 1] = cvt2(__uint_as_float(khw[0][e >> 1]), kh0); khw[1][e >> 1] = cvt2(__uint_as_float(khw[1][e >> 1]), kh1);
                             vtw[0][e >> 1] = (vtw[0][e >> 1] >> 16) | (cv[e] << 16); vtw[1][e >> 1] = (vtw[1][e >> 1] >> 16) | (cv[e] & 0xffff0000u); }
                else { khw[0][e >> 1] = __float_as_uint(kh0); khw[1][e >> 1] = __float_as_uint(kh1); vtw[0][e >> 1] = cv[e] << 16; vtw[1][e >> 1] = cv[e] & 0xffff0000u; }
            }
#pragma unroll
            for (int dd = 0; dd < 2; ++dd) {
                *(REC_LAS u32x4*)(lds + OFF_KHT + (2 * lane + dd) * TP + wv * 16) = (u32x4){khw[dd][0], khw[dd][1], khw[dd][2], khw[dd][3]};
                *(REC_LAS u32x4*)(lds + OFF_VT + (2 * lane + dd) * TP + wv * 16) = (u32x4){vtw[dd][0], vtw[dd][1], vtw[dd][2], vtw[dd][3]};
            }
            if (wv == 0) *(REC_LAS f32x2*)(lds + OFF_DL + 2 * lane * 4) = (f32x2){ex2(bl[0]), ex2(bl[1])};
            dsum[0] += bl[0]; dsum[1] += bl[1];
            __syncthreads();
            if (OUT) {
#pragma unroll 1
                for (int blk = wv; blk < 10; blk += 8) {
                    const int i = blk < 1 ? 0 : blk < 3 ? 1 : blk < 6 ? 2 : 3, j = blk - (i * (i + 1)) / 2;
                    f32x4 a = {0.f, 0.f, 0.f, 0.f};
                    const REC_LAS unsigned char* ka = lds + OFF_KB + (16 * j + fr) * QP + fg * 16;
                    const REC_LAS unsigned char* qa = lds + qv_off(j) + (16 * (i - j) + fr) * QP + fg * 16;
#pragma unroll
                    for (int kk = 0; kk < 4; ++kk) a = __builtin_amdgcn_mfma_f32_16x16x32_bf16(*(const REC_LAS bf16x8*)(ka + kk * 64), *(const REC_LAS bf16x8*)(qa + kk * 64), a, 0, 0, 0);
                    if (i == j) {
#pragma unroll
                        for (int e = 0; e < 4; ++e) a[e] = (4 * fg + e <= fr) ? a[e] : 0.f; }
                    u32x2 w2; w2.x = cvt2(a[0], a[1]); w2.y = cvt2(a[2], a[3]);
                    *(REC_LAS u32x2*)(lds + OFF_AM + (16 * i + fr) * TP + (16 * j + 4 * fg) * 2) = w2;
                }
                __syncthreads();
            }
            u32x4 gq0 = {0u, 0u, 0u, 0u}, gq1 = {0u, 0u, 0u, 0u};
            if (OUT) { const unsigned short* gp_ = Gp + row0 + (size_t)(64 * c + er) * RD + es * 16; gq0 = *(const u32x4*)gp_; gq1 = *(const u32x4*)(gp_ + 8); }
            bf16x8 vb[2];
#pragma unroll
            for (int kk = 0; kk < 2; ++kk) vb[kk] = *(const REC_LAS bf16x8*)(lds + OFF_VT + (16 * wv + fr) * TP + kk * 64 + fg * 16);
            if (OUT) {
                bf16x8 sb[4];
#pragma unroll
                for (int k4 = 0; k4 < 4; ++k4) { u32x4 w4; w4.x = cvt2(st[2 * k4][0], st[2 * k4][1]); w4.y = cvt2(st[2 * k4][2], st[2 * k4][3]); w4.z = cvt2(st[2 * k4 + 1][0], st[2 * k4 + 1][1]); w4.w = cvt2(st[2 * k4 + 1][2], st[2 * k4 + 1][3]);
                    sb[k4] = __builtin_bit_cast(bf16x8, w4); }
#pragma unroll
                for (int mt = 0; mt < 4; ++mt) {
                    f32x4 acc = {0.f, 0.f, 0.f, 0.f};
#pragma unroll
                    for (int kk = 0; kk < 2; ++kk) if (kk <= (mt >> 1))
                        acc = __builtin_amdgcn_mfma_f32_16x16x32_bf16(*(const REC_LAS bf16x8*)(lds + OFF_AM + (16 * mt + fr) * TP + kk * 64 + fg * 16), vb[kk], acc, 0, 0, 0);
#pragma unroll
                    for (int k4 = 0; k4 < 4; ++k4) {
                        const REC_LAS unsigned char* qa = lds + (16 * mt + fr) * QP + k4 * 64 + fg * 8;
                        const u32x2 lo2 = *(const REC_LAS u32x2*)qa, hi2 = *(const REC_LAS u32x2*)(qa + 32);
                        const u32x4 w4 = {lo2.x, lo2.y, hi2.x, hi2.y};
                        acc = __builtin_amdgcn_mfma_f32_16x16x32_bf16(__builtin_bit_cast(bf16x8, w4), sb[k4], acc, 0, 0, 0);
                    }
#pragma unroll
                    for (int e = 0; e < 4; ++e) *(REC_LAS unsigned short*)(lds + OFF_SO + (16 * mt + 4 * fg + e) * QP + (16 * wv + fr) * 2) = (unsigned short)(cvt2(acc[e], 0.f) & 0xffffu);
                }
            }
#pragma unroll
            for (int kt = 0; kt < 8; ++kt) {
                const f32x4 dl4 = *(const REC_LAS f32x4*)(lds + OFF_DL + (16 * kt + 4 * fg) * 4);
                st[kt] = st[kt] * dl4;
#pragma unroll
                for (int kk = 0; kk < 2; ++kk)
                    st[kt] = __builtin_amdgcn_mfma_f32_16x16x32_bf16(*(const REC_LAS bf16x8*)(lds + OFF_KHT + (16 * kt + fr) * TP + kk * 64 + fg * 16), vb[kk], st[kt], 0, 0, 0);
            }
            if (OUT) { __syncthreads();
                REC_FLUSH(c, gq0, gq1); }
        }
        if (!OUT) {
            float* U = Ug + ((size_t)u << 14);
#pragma unroll
            for (int kt = 0; kt < 8; ++kt) *(f32x4*)(U + ((kt * 8 + wv) * 64 + lane) * 4) = st[kt];
            if (wv == 0) *(f32x2*)(Dg + u * 128 + 2 * lane) = (f32x2){ex2(dsum[0]), ex2(dsum[1])};
        }
        __syncthreads();
    }
}
#undef REC_FLUSH
#undef REC_LAS
}
#define GAS __attribute__((address_space(1)))
#define LAS __attribute__((address_space(3)))
typedef unsigned short bf16;
typedef unsigned v4u __attribute__((ext_vector_type(4)));
typedef float f32x4 __attribute__((ext_vector_type(4)));
typedef short bf16x8 __attribute__((ext_vector_type(8)));
typedef GAS unsigned gu32;
typedef GAS unsigned long long gu64;
#define RLX_AGENT __ATOMIC_RELAXED, __HIP_MEMORY_SCOPE_AGENT
#define LDS_WAIT() asm volatile("s_waitcnt lgkmcnt(0)" ::: "memory")
#define VM_WAIT() asm volatile("s_waitcnt vmcnt(0)" ::: "memory")
__device__ __forceinline__ unsigned long long rt() { return __builtin_amdgcn_s_memrealtime(); }
__device__ __forceinline__ unsigned f2bf(float f) { unsigned u = __builtin_bit_cast(unsigned, f); return (u + 0x7fffu + ((u >> 16) & 1u)) >> 16; }
__device__ __forceinline__ unsigned pk2(float lo, float hi) { return f2bf(lo) | (f2bf(hi) << 16); }
#define XB_TMO      128
#define XB_XCNT(j)  (256  + 64 * (j))
#define XB_XSUB(j)  (1280 + 64 * (j))
#define XB_XGEN(j)  (2304 + 64 * (j))
#define XB_TOP      3328
#define XB_TOPGEN   3392
#define XCD_BAR_WORDS 3456
#define XB_SPIN_CAP (1u << 18)

__device__ __forceinline__ unsigned xb_ld(unsigned* p)              { return __hip_atomic_load(p, __ATOMIC_RELAXED, __HIP_MEMORY_SCOPE_AGENT); }
__device__ __forceinline__ unsigned xb_add(unsigned* p, unsigned v) { return __hip_atomic_fetch_add(p, v, __ATOMIC_RELAXED, __HIP_MEMORY_SCOPE_AGENT); }
__device__ __forceinline__ unsigned xb_xcc_id() { return (unsigned)__builtin_amdgcn_s_getreg((3 << 11) | 20) & 0xFu; }
#define XB_SPIN(cond, bar) do { unsigned _sp = 0; while (cond) { __builtin_amdgcn_s_sleep(1); \
    if ((++_sp & 255u) == 0u) { if (xb_ld(&(bar)[XB_TMO])) break; if (_sp > XB_SPIN_CAP) { atomicAdd(&(bar)[XB_TMO], 1u); break; } } } } while (0)

struct XcdBarrier {
    unsigned* bar; unsigned x;
    volatile LAS unsigned* st;
};

__device__ __forceinline__ XcdBarrier xcd_barrier_post(unsigned* bar, volatile LAS unsigned* st) {
    XcdBarrier b; b.bar = bar; b.x = xb_xcc_id(); b.st = st;
    if (threadIdx.x == 0) (void)xb_add(&bar[XB_XCNT(b.x)], 1u);
    return b;
}
__device__ __forceinline__ void xcd_barrier_complete(unsigned* bar, unsigned x, unsigned& nloc, unsigned& nx) {
    const unsigned G = gridDim.x * gridDim.y * gridDim.z;
    unsigned sum, cnt, mine, sp = 0u;
    for (;;) {
        sum = 0u; cnt = 0u; mine = 0u;
#pragma unroll
        for (unsigned j = 0; j < 16; ++j) { const unsigned c = xb_ld(&bar[XB_XCNT(j)]); sum += c; cnt += (c > 0u) ? 1u : 0u; mine = (j == x) ? c : mine; }
        if (sum == G) break;
        __builtin_amdgcn_s_sleep(1);
        if ((++sp & 255u) == 0u) { if (xb_ld(&bar[XB_TMO])) break; if (sp > XB_SPIN_CAP) { atomicAdd(&bar[XB_TMO], 1u); break; } }
    }
    nloc = mine > 0u ? mine : 1u; nx = cnt > 0u ? cnt : 1u;
}

__device__ __forceinline__ void xcd_barrier(const XcdBarrier& b) {
    asm volatile("s_waitcnt vmcnt(0)" ::: "memory");
    __syncthreads();
    if (threadIdx.x == 0) {
        unsigned* bar = b.bar;
        __builtin_amdgcn_s_waitcnt(0);
        unsigned nloc = b.st[0], nx = b.st[1];
        if (nloc == 0u) { xcd_barrier_complete(bar, b.x, nloc, nx); b.st[0] = nloc; b.st[1] = nx; }
        const unsigned old = xb_add(&bar[XB_XSUB(b.x)], 1u);
        const unsigned gen = old / nloc;
        if (old + 1u == (gen + 1u) * nloc) {
            __builtin_amdgcn_fence(__ATOMIC_RELEASE, "agent");
            asm volatile("s_waitcnt vmcnt(0)" ::: "memory");
            const unsigned og = xb_add(&bar[XB_TOP], 1u);
            const unsigned tg = og / nx;
            if (og + 1u == (tg + 1u) * nx) xb_add(&bar[XB_TOPGEN], 1u);
            else XB_SPIN(xb_ld(&bar[XB_TOPGEN]) == tg, bar);
            __builtin_amdgcn_fence(__ATOMIC_ACQUIRE, "agent");
            xb_add(&bar[XB_XGEN(b.x)], 1u);
            asm volatile("s_waitcnt vmcnt(0)" ::: "memory");
        } else {
            XB_SPIN(xb_ld(&bar[XB_XGEN(b.x)]) == gen, bar);
            __builtin_amdgcn_fence(__ATOMIC_ACQUIRE, "agent");
            asm volatile("s_waitcnt vmcnt(0)" ::: "memory");
        }
    }
    __syncthreads();
}
#define PROBE_MODE 0
constexpr int NWAVES = 8;
#ifndef ONE_LAUNCH
#define ONE_LAUNCH 1
#endif
constexpr int BATCH = 4, T = 4096, D = 2048, H = 16, HD = 128;
constexpr int M = BATCH * T;
constexpr int NPA = 8192;
constexpr float EPS = 1e-6f;
constexpr size_t MiB = 1u << 20;
constexpr size_t WS_CTL = 0, CTL_ZERO_BYTES = 1 * MiB;
constexpr size_t WS_WINA = 2 * MiB;
constexpr size_t WS_WOUTA = 66 * MiB;
constexpr size_t WS_WKVQ = 82 * MiB;
constexpr size_t WS_WINB1 = 114 * MiB;
constexpr size_t WS_WOUTB = 130 * MiB;
constexpr size_t WS_XN = 146 * MiB;
constexpr size_t WS_PROJ = 210 * MiB;
constexpr size_t WS_FZ = 466 * MiB;
constexpr size_t WS_F = 467 * MiB;
constexpr size_t WS_U = 468 * MiB;
constexpr size_t WS_DG = 480 * MiB;
constexpr size_t WS_END = 481 * MiB;
constexpr size_t SLOT = (size_t)M * D;
constexpr int CW_TMO = 0, CW_CODE = 1;
constexpr int CW_BAR = 4096;
constexpr int CW_ATT = 16384;
constexpr int CW_SS = 32768;
constexpr int RING_OFF = 0, RING_BYTES = 131072;
constexpr int SCRATCH_BYTES = 139264;
constexpr int LDSCTL_OFF = SCRATCH_BYTES, MISC_OFF = LDSCTL_OFF + 320;
constexpr int LDS_BYTES = 147456;
static_assert(MISC_OFF + 128 <= LDS_BYTES, "LDS map");

struct Frame {
    LAS unsigned char* lds;
    volatile LAS unsigned* MISC;
    gu32* ctl;
    int tid, lane, wave;
    int vcu, G;
};
__device__ __forceinline__ void phase_tid(Frame& F) { int t = threadIdx.x; asm volatile("" : "+v"(t)); F.tid = t; F.lane = t & 63; F.wave = __builtin_amdgcn_readfirstlane(t >> 6); }

__device__ __forceinline__ float wave_sum(float v) {
#pragma unroll
    for (int o = 1; o < 64; o <<= 1) v += __shfl_xor(v, o);
    return v;
}
__device__ __forceinline__ float bf2f(unsigned short b) { return __uint_as_float((unsigned)b << 16); }
__device__ __forceinline__ float bflo(unsigned w) { return __uint_as_float(w << 16); }
__device__ __forceinline__ float bfhi(unsigned w) { return __uint_as_float(w & 0xffff0000u); }

__device__ __forceinline__ void p0_transpose_item(const float* W, int ldw, int ncols, const float* nw, bf16* WT, LAS float* scr, int item, int lane) {
    const int nblk = ncols / 32, kb = item / nblk, nb = item % nblk, k0 = 64 * kb, n0 = 32 * nb;
#pragma unroll 8
    for (int i = 0; i < 32; ++i) { const int kk = 2 * i + (lane >> 5); const float s = nw ? nw[k0 + kk] : 1.f; scr[kk * 33 + (lane & 31)] = W[(size_t)(k0 + kk) * ldw + n0 + (lane & 31)] * s; }
    LDS_WAIT(); asm volatile("" ::: "memory");
    const int c = lane & 7;
#pragma unroll
    for (int j = 0; j < 4; ++j) { const int n = (lane >> 3) + 8 * j; const LAS float* s = scr + (8 * c) * 33 + n;
        v4u o; o.x = pk2(s[0 * 33], s[1 * 33]); o.y = pk2(s[2 * 33], s[3 * 33]); o.z = pk2(s[4 * 33], s[5 * 33]); o.w = pk2(s[6 * 33], s[7 * 33]);
        *(GAS v4u*)(WT + (size_t)(n0 + n) * D + k0 + 8 * c) = o; }
    LDS_WAIT(); asm volatile("" ::: "memory");
}
__device__ __forceinline__ void xb_rows(Frame& F, const float* xin, bf16* xb, unsigned long long* ss) {
    const int gw = F.vcu * NWAVES + F.wave, NGW = F.G * NWAVES;
    for (int m = gw; m < M; m += NGW) {
        const GAS f32x4* xr = (const GAS f32x4*)(xin + (size_t)m * D) + F.lane;
        f32x4 v[8]; float s = 0.f;
#pragma unroll
        for (int j = 0; j < 8; ++j) { v[j] = xr[64 * j]; s += (v[j].x * v[j].x + v[j].y * v[j].y) + (v[j].z * v[j].z + v[j].w * v[j].w); }
        s = wave_sum(s);
        GAS unsigned long long* o8 = (GAS unsigned long long*)(xb + (size_t)m * D) + F.lane;
#pragma unroll
        for (int j = 0; j < 8; ++j) o8[64 * j] = (unsigned long long)pk2(v[j].x, v[j].y) | ((unsigned long long)pk2(v[j].z, v[j].w) << 32);
        if (F.lane == 0) ss[m] = (unsigned long long)(s * 16777216.0f);
    }
}
__device__ __forceinline__ void p0_prologue(Frame& F, const float* const* in, unsigned char* ws) {
    LAS float* scr = (LAS float*)(F.lds + RING_OFF + F.wave * 16384);
    const int gw = F.vcu * NWAVES + F.wave, NGW = F.G * NWAVES;
    constexpr int I_INA = 32 * 256, I_SQ = 32 * 64, I_4K = 32 * 128;
    constexpr int NITEMS = 2 * I_INA + 2 * I_SQ + 3 * I_4K + 2 * I_SQ;
    for (int it = gw; it < NITEMS; it += NGW) {
        int r = it;
        if (r < 2 * I_INA) { const int l = r / I_INA; r -= l * I_INA; p0_transpose_item(in[2] + (size_t)l * D * NPA, NPA, NPA, in[1] + l * D, (bf16*)(ws + WS_WINA) + (size_t)l * NPA * D, scr, r, F.lane); continue; } r -= 2 * I_INA;
        if (r < 2 * I_SQ) { const int l = r / I_SQ; r -= l * I_SQ; p0_transpose_item(in[5] + (size_t)l * D * D, D, D, nullptr, (bf16*)(ws + WS_WOUTA) + (size_t)l * D * D, scr, r, F.lane); continue; } r -= 2 * I_SQ;
        if (r < I_4K) { p0_transpose_item(in[7], 2 * D + H, 2 * D, in[6], (bf16*)(ws + WS_WKVQ), scr, r, F.lane); continue; } r -= I_4K;
        if (r < I_4K) { p0_transpose_item(in[11], 2 * D, 2 * D, in[10], (bf16*)(ws + WS_WKVQ) + (size_t)2 * D * D, scr, r, F.lane); continue; } r -= I_4K;
        if (r < I_4K) { p0_transpose_item(in[11] + (size_t)D * 2 * D, 2 * D, 2 * D, in[10] + D, (bf16*)(ws + WS_WINB1), scr, r, F.lane); continue; } r -= I_4K;
        { const int l = r / I_SQ; r -= l * I_SQ; p0_transpose_item(in[14] + (size_t)l * D * D, D, D, nullptr, (bf16*)(ws + WS_WOUTB) + (size_t)l * D * D, scr, r, F.lane); }
    }
    xb_rows(F, in[0], (bf16*)(ws + WS_XN), (unsigned long long*)(F.ctl + CW_SS));
}
__device__ __forceinline__ float sum16(float v) { v += __shfl_xor(v, 1); v += __shfl_xor(v, 2); v += __shfl_xor(v, 4); v += __shfl_xor(v, 8); return v; }
__device__ __forceinline__ void headnorm_rows(Frame& F, bf16* X, const float* w) {
    const int gw = F.vcu * NWAVES + F.wave, NGW = F.G * NWAVES;
    for (int m = gw; m < M; m += NGW) {
        GAS v4u* xr = (GAS v4u*)(X + (size_t)m * D) + F.lane;
#pragma unroll
        for (int j = 0; j < 4; ++j) {
            const v4u x = xr[64 * j]; float f[8] = {bflo(x.x), bfhi(x.x), bflo(x.y), bfhi(x.y), bflo(x.z), bfhi(x.z), bflo(x.w), bfhi(x.w)};
            float s = 0.f;
#pragma unroll
            for (int e = 0; e < 8; ++e) s += f[e] * f[e];
            const float r = 1.0f / sqrtf(sum16(s) * (1.f / HD) + EPS);
            const int d0 = (8 * F.lane) & 127;
            const f32x4 w0 = *(const f32x4*)(w + d0), w1 = *(const f32x4*)(w + d0 + 4);
            v4u o; o.x = pk2(f[0] * r * w0.x, f[1] * r * w0.y); o.y = pk2(f[2] * r * w0.z, f[3] * r * w0.w); o.z = pk2(f[4] * r * w1.x, f[5] * r * w1.y); o.w = pk2(f[6] * r * w1.z, f[7] * r * w1.w);
            xr[64 * j] = o;
        }
    }
}
__device__ __forceinline__ float silu_f(float g) { return g / (1.f + __expf(-g)); }
__device__ __forceinline__ void gatenorm_rows(Frame& F, bf16* O, const bf16* G, const float* w) {
    const int gw = F.vcu * NWAVES + F.wave, NGW = F.G * NWAVES;
    for (int m = gw; m < M; m += NGW) {
        GAS v4u* xr = (GAS v4u*)(O + (size_t)m * D) + F.lane; const GAS v4u* gr = (const GAS v4u*)(G + (size_t)m * D) + F.lane;
#pragma unroll
        for (int j = 0; j < 4; ++j) {
            const v4u x = xr[64 * j], g = gr[64 * j];
            float f[8] = {bflo(x.x), bfhi(x.x), bflo(x.y), bfhi(x.y), bflo(x.z), bfhi(x.z), bflo(x.w), bfhi(x.w)};
            const float q[8] = {bflo(g.x), bfhi(g.x), bflo(g.y), bfhi(g.y), bflo(g.z), bfhi(g.z), bflo(g.w), bfhi(g.w)};
            float s = 0.f;
#pragma unroll
            for (int e = 0; e < 8; ++e) s += f[e] * f[e];
            const float r = 1.0f / sqrtf(sum16(s) * (1.f / HD) + EPS);
            const int c0 = 8 * (F.lane + 64 * j);
            const f32x4 w0 = *(const f32x4*)(w + c0), w1 = *(const f32x4*)(w + c0 + 4);
            const float ww[8] = {w0.x, w0.y, w0.z, w0.w, w1.x, w1.y, w1.z, w1.w};
#pragma unroll
            for (int e = 0; e < 8; ++e) f[e] = f[e] * r * ww[e] * silu_f(q[e]);
            v4u o; o.x = pk2(f[0], f[1]); o.y = pk2(f[2], f[3]); o.z = pk2(f[4], f[5]); o.w = pk2(f[6], f[7]);
            xr[64 * j] = o;
        }
    }
}
__device__ __forceinline__ void fz_rows(Frame& F, const bf16* xn, const unsigned long long* ss, const float* kvw, const float* kvnw, const float* fbias, float* fzls) {
    LAS float* wf = (LAS float*)(F.lds);
    for (int idx = F.tid; idx < D * 16; idx += NWAVES * 64) { const int k = idx >> 4, j = idx & 15; wf[k * 16 + (k >> 3) * 4 + j] = kvw[(size_t)k * (2 * D + H) + 2 * D + j] * kvnw[k]; }
    __syncthreads();
    const int gw = F.vcu * NWAVES + F.wave, NGW = F.G * NWAVES;
    for (int m = gw; m < M; m += NGW) {
        const GAS v4u* xr = (const GAS v4u*)(xn + (size_t)m * D) + F.lane;
        float acc[16];
#pragma unroll
        for (int j = 0; j < 16; ++j) acc[j] = 0.f;
#pragma unroll 1
        for (int jj = 0; jj < 4; ++jj) {
            const v4u x = xr[64 * jj]; const float f[8] = {bflo(x.x), bfhi(x.x), bflo(x.y), bfhi(x.y), bflo(x.z), bfhi(x.z), bflo(x.w), bfhi(x.w)};
            const int c = F.lane + 64 * jj;
#pragma unroll 2
            for (int e = 0; e < 8; ++e) { const LAS f32x4* wr = (const LAS f32x4*)(wf + (8 * c + e) * 16 + c * 4);
#pragma unroll
                for (int q = 0; q < 4; ++q) { const f32x4 w4 = wr[q]; acc[4 * q + 0] += f[e] * w4.x; acc[4 * q + 1] += f[e] * w4.y; acc[4 * q + 2] += f[e] * w4.z; acc[4 * q + 3] += f[e] * w4.w; } }
        }
        float mine = 0.f;
#pragma unroll
        for (int j = 0; j < 16; ++j) { const float s = wave_sum(acc[j]); if (F.lane == j) mine = s; }
        if (F.lane < 16) { const float z = mine * (1.0f / sqrtf((float)ss[m] * (1.0f / 16777216.0f) * (1.f / D) + EPS)) + fbias[F.lane]; fzls[(size_t)m * 16 + F.lane] = fminf(z, 0.f) - __logf(1.f + __expf(-fabsf(z))); }
    }
    __syncthreads();
}
__device__ __forceinline__ void fscan(Frame& F, const float* fzls, float* Fo) {
    LAS float* wt = (LAS float*)(F.lds);
    for (int u = blockIdx.x; u < BATCH * H; u += F.G) {
        const int b = u / H, h = u % H, t0 = F.tid * 8;
        float v[8];
#pragma unroll
        for (int e = 0; e < 8; ++e) v[e] = fzls[(size_t)(b * T + t0 + e) * 16 + h];
#pragma unroll
        for (int e = 1; e < 8; ++e) v[e] += v[e - 1];
        float incl = v[7];
#pragma unroll
        for (int o = 1; o < 64; o <<= 1) { const float n = __shfl_up(incl, o); if (F.lane >= o) incl += n; }
        if (F.lane == 63) wt[F.wave] = incl;
        __syncthreads();
        float base = incl - v[7];
        for (int w = 0; w < F.wave; ++w) base += wt[w];
#pragma unroll
        for (int e = 0; e < 8; ++e) Fo[(size_t)u * T + t0 + e] = -(v[e] + base) * fox::INVS;
        __syncthreads();
    }
}
__device__ __forceinline__ fox::BlockRef attn_ref(int L, const bf16* Q, const bf16* K, const bf16* V, bf16* O, const bf16* G, const float* wo, const float* Fc, float TH) {
    const int bh = L & 63, qb = 15 - (L >> 6), b = bh / H, h = bh % H;
    fox::BlockRef r; const size_t base = (size_t)b * T * D + h * HD;
    r.Q = (const fox::bf16*)Q + base + (size_t)qb * 256 * D; r.O = (fox::bf16*)O + base + (size_t)qb * 256 * D; r.K = (const fox::bf16*)K + base; r.V = (const fox::bf16*)V + base;
    r.G = (const fox::bf16*)G + base + (size_t)qb * 256 * D; r.wo = wo + h * HD;
    r.F = Fc + (size_t)bh * T; r.P0 = qb * 256; r.jlo = fox::fox_jlo(r.F, r.P0, TH); return r;
}
__device__ __forceinline__ float attn_threshold(Frame& F, const float* wq, const float* wk) {
    float a = fmaxf(fabsf(wq[F.lane]), fabsf(wq[F.lane + 64])), c = fmaxf(fabsf(wk[F.lane]), fabsf(wk[F.lane + 64]));
#pragma unroll
    for (int o = 1; o < 64; o <<= 1) { a = fmaxf(a, __shfl_xor(a, o)); c = fmaxf(c, __shfl_xor(c, o)); }
    return 2.f * (128.f * 1.02f * a * c) + 152.f / (1.4426950408889634f * fox::SCALE);
}
__device__ __forceinline__ void attn_phase(Frame& F, char* lds, const bf16* Q, const bf16* K, const bf16* V, bf16* O, const bf16* G, const float* wo, const float* wq, const float* Fc, gu32* ctr, float TH) {
    constexpr int total = BATCH * H * 16;
    volatile LAS int* tk = (volatile LAS int*)(F.lds + 69632);
    if (F.tid == 0) { tk[0] = (int)__hip_atomic_fetch_add(ctr, 1u, RLX_AGENT); tk[1] = (int)__hip_atomic_fetch_add(ctr, 1u, RLX_AGENT); }
    __syncthreads();
    int Lc = tk[0], Ln = tk[1];
    if (Lc >= total) return;
    fox::BlockRef cur = attn_ref(Lc, Q, K, V, O, G, wo, Fc, TH);
    fox::Seam S;
    fox::causal_prime(cur, lds, S);
    for (int i = 0;; ++i) {
        if (F.tid == 0) tk[2 + (i & 1)] = (int)__hip_atomic_fetch_add(ctr, 1u, RLX_AGENT);
        const bool has_next = Ln < total;
        const fox::BlockRef nxt = has_next ? attn_ref(Ln, Q, K, V, O, G, wo, Fc, TH) : cur;
        fox::causal_block(cur, nxt, lds, S, wq);
        if (!has_next) break;
        const int L2 = tk[2 + (i & 1)];
        cur = nxt; Lc = Ln; Ln = L2;
    }
}

constexpr int NPHASE = 29;
__host__ __device__ constexpr bool phase_live(int id) {
    if (id == 0) return true;
    const int L = (id - 1) / 7, s = (id - 1) % 7;
    if (s == 1) return L == 2;
    if (s == 2) return L <= 2;
    if (s == 6) return false;
    if (s == 4) return false;
    return true;
}
struct Args { const float* in[15]; float* out; unsigned char* ws; int ph_lo, ph_hi; };
__global__ void __launch_bounds__(NWAVES * 64, 2) fwd_kernel(Args args) {
    extern __shared__ __attribute__((aligned(16))) unsigned char lds[];
    Frame F;
    F.lds = (LAS unsigned char*)lds;
    F.MISC = (volatile LAS unsigned*)(F.lds + MISC_OFF);
    phase_tid(F);
    F.G = gridDim.x; { const int bx = blockIdx.x; F.vcu = (F.G % 8 == 0) ? (bx % 8) * (F.G / 8) + bx / 8 : bx; }
    unsigned char* ws = args.ws;
    F.ctl = (gu32*)(ws + WS_CTL);
    for (int u = F.tid; u < (LDS_BYTES - LDSCTL_OFF) / 4; u += NWAVES * 64) ((LAS unsigned*)(F.lds + LDSCTL_OFF))[u] = 0u;
    __syncthreads();
#if ONE_LAUNCH
    XcdBarrier bar = xcd_barrier_post((unsigned*)(F.ctl + CW_BAR), F.MISC + 8);
#define GRID_BAR() xcd_barrier(bar)
#else
#define GRID_BAR() do {} while (0)
#endif
    const int lo = args.ph_lo, hi = args.ph_hi;
#ifdef PROBE_PHASE
    unsigned long long pp_t0 = 0, pp_dt = 0;
#define PP_BEGIN(k) do { if ((k) == PROBE_PHASE) pp_t0 = __builtin_amdgcn_s_memrealtime(); } while (0)
#define PP_END(k) do { if ((k) == PROBE_PHASE) pp_dt = __builtin_amdgcn_s_memrealtime() - pp_t0; } while (0)
#else
#define PP_BEGIN(k) do {} while (0)
#define PP_END(k) do {} while (0)
#endif
#define IN(k) (lo <= (k) && (k) < hi)
#define SEAM(k) do { if ((k) + 1 < hi) GRID_BAR(); PP_END(k); } while (0)
    const float* const* in = args.in;
    bf16* XN = (bf16*)(ws + WS_XN); bf16* PROJ = (bf16*)(ws + WS_PROJ); unsigned long long* SS = (unsigned long long*)(F.ctl + CW_SS);
    float* FZ = (float*)(ws + WS_FZ); float* FC = (float*)(ws + WS_F);

    #ifndef NO_P0
    if (IN(0)) { PP_BEGIN(0); phase_tid(F); p0_prologue(F, in, ws); SEAM(0); }
#endif

#ifdef PROBE_CLK
    long long pc0 = 0; unsigned long long pr0 = 0, probe_us = 0;
#endif
#pragma unroll 1
    for (int L = 0; L < 4; ++L) {
        const int pb = 1 + 7 * L; const bool isA = L < 2; const int j = L & 1;
        PP_BEGIN(pb + 0);
        if (IN(pb + 0)) {
#ifdef PROBE_CLK
            if (L == PROBE_CLK - 1) { pc0 = clock64(); pr0 = __builtin_amdgcn_s_memrealtime(); }
#endif
            const bf16* Bt = isA ? (const bf16*)(ws + WS_WINA) + (size_t)j * NPA * D : (L == 2 ? (const bf16*)(ws + WS_WKVQ) : (const bf16*)(ws + WS_WINB1));
            const int N = (L == 3) ? 2 * D : NPA;
            bf16* outp = (L == 3) ? PROJ + 2 * SLOT : PROJ;
            pg8::Gemm g{XN, Bt, M, N, D}; pg8::StaticOrder S; S.init(M, N, F.G, (int)blockIdx.x);
            pg8::EpiBf16R E{outp, D, D, SLOT, SS + (size_t)L * M, 1.f / D, EPS};
#ifndef NO_G1
            pg8::gemm_phase<pg8::EpiBf16R, pg8::StaticOrder, true, true>(F.lds + RING_OFF, g, S, E);
#ifdef DUP_GIN
            pg8::gemm_phase<pg8::EpiBf16R, pg8::StaticOrder, true, true>(F.lds + RING_OFF, g, S, E);
#endif
#ifdef DUP_GIN_NOEPI
            { pg8::EpiNull E0;
#ifdef PROBE_L2RES
              pg8::RepeatOrder S2; S2.n = (M / 256) * (N / 256) / F.G; S2.c = (int)blockIdx.x;
              pg8::gemm_phase<pg8::EpiNull, pg8::RepeatOrder, true, true, false>(F.lds + RING_OFF, g, S2, E0);
#else
              pg8::gemm_phase<pg8::EpiNull, pg8::StaticOrder, true, true, PROBE_BLK>(F.lds + RING_OFF, g, S, E0);
#endif
            }
#endif
#endif
#ifdef PROBE_CLK
            if (L == PROBE_CLK - 1) { const long long dc = clock64() - pc0; const unsigned long long dr = __builtin_amdgcn_s_memrealtime() - pr0; probe_us = PROBE_MODE == 0 ? (unsigned long long)(dc * 100 / (long long)dr) : (unsigned long long)(dc / 256);
              if (PROBE_MODE >= 2 && threadIdx.x == 0) { if (PROBE_MODE == 2) atomicMax((unsigned*)(F.ctl + 2048), (unsigned)probe_us); else atomicMin((unsigned*)(F.ctl + 2048), 0x7fffffffu - (unsigned)probe_us); } }
#endif
            SEAM(pb + 0);
        }
        PP_BEGIN(pb + 1);
        if (IN(pb + 1) && L == 2) { phase_tid(F);
#ifndef NO_FZ
            if (L == 2) { fz_rows(F, XN, SS + (size_t)L * M, in[7], in[6], in[8], FZ); headnorm_rows(F, PROJ, in[9]); }
#endif
            SEAM(pb + 1);
        }
        PP_BEGIN(pb + 2);
        if (IN(pb + 2) && L == 2) { phase_tid(F); fscan(F, FZ, FC); SEAM(pb + 2); }
        PP_BEGIN(pb + 2);
        if (IN(pb + 2) && isA) {
            rec::run<false>(F.lds + RING_OFF, F.G, PROJ, PROJ + SLOT, PROJ + 2 * SLOT, PROJ, in[3], L, (float*)(ws + WS_U), (float*)(ws + WS_DG), PROJ + 3 * SLOT, in[4] + j * D);
#ifdef DUP_REC
            rec::run<false>(F.lds + RING_OFF, F.G, PROJ, PROJ + SLOT, PROJ + 2 * SLOT, PROJ, in[3], L, (float*)(ws + WS_U), (float*)(ws + WS_DG), PROJ + 3 * SLOT, in[4] + j * D);
#endif
            SEAM(pb + 2);
        }
        PP_BEGIN(pb + 3);
        if (IN(pb + 3)) { phase_tid(F);
#ifndef NO_REC
            if (isA) rec::run<true>(F.lds + RING_OFF, F.G, PROJ, PROJ + SLOT, PROJ + 2 * SLOT, PROJ, in[3], L, (float*)(ws + WS_U), (float*)(ws + WS_DG), PROJ + 3 * SLOT, in[4] + j * D);
#ifdef DUP_REC
            if (isA) rec::run<true>(F.lds + RING_OFF, F.G, PROJ, PROJ + SLOT, PROJ + 2 * SLOT, PROJ, in[3], L, (float*)(ws + WS_U), (float*)(ws + WS_DG), PROJ + 3 * SLOT, in[4] + j * D);
#endif
#endif
#ifndef NO_ATT
            if (!isA) attn_phase(F, (char*)lds + RING_OFF, PROJ + 2 * SLOT, PROJ, PROJ + SLOT, PROJ + 2 * SLOT, PROJ + 3 * SLOT, in[13] + j * D, in[12] + j * HD, FC, F.ctl + CW_ATT + 64 * j, attn_threshold(F, in[12] + j * HD, in[9]));
#ifdef DUP_ATT
            if (!isA) { __syncthreads(); attn_phase(F, (char*)lds + RING_OFF, PROJ + 2 * SLOT, PROJ, PROJ + SLOT, PROJ + 2 * SLOT, PROJ + 3 * SLOT, in[13] + j * D, in[12] + j * HD, FC, F.ctl + CW_ATT + 64 * (j + 2), attn_threshold(F, in[12] + j * HD, in[9])); }
#endif
#endif
            SEAM(pb + 3);
        }
        bf16* OB = isA ? PROJ : PROJ + 2 * SLOT;
        if (false) { phase_tid(F); gatenorm_rows(F, OB, PROJ + 3 * SLOT, (isA ? in[4] : in[13]) + j * D); SEAM(pb + 4); }
        PP_BEGIN(pb + 5);
        if (IN(pb + 5)) {
            const bf16* Bt = (const bf16*)(ws + (isA ? WS_WOUTA : WS_WOUTB)) + (size_t)j * D * D;
            pg8::Gemm g{OB, Bt, M, D, D}; pg8::StaticOrder S; S.init(M, D, F.G, (int)blockIdx.x);
            pg8::EpiResB E{XN, D, L < 3 ? nullptr : args.out, SS + (size_t)(L + 1 < 4 ? L + 1 : 3) * M};
#ifndef NO_G2
            pg8::gemm_phase<pg8::EpiResB, pg8::StaticOrder, true, true>(F.lds + RING_OFF, g, S, E);
#endif
            SEAM(pb + 5);
        }
    }
#ifdef PROBE_PHASE
    if (blockIdx.x == 0 && threadIdx.x == 0) { const unsigned long long t0 = __builtin_amdgcn_s_memrealtime(); while (__builtin_amdgcn_s_memrealtime() - t0 < pp_dt) __builtin_amdgcn_s_sleep(10); }
#endif
#ifdef PROBE_CLK
    if (PROBE_MODE >= 2) { __syncthreads(); unsigned v = __hip_atomic_load((unsigned*)(F.ctl + 2048), __ATOMIC_RELAXED, __HIP_MEMORY_SCOPE_AGENT); probe_us = PROBE_MODE == 2 ? v : v; }
    if (blockIdx.x == 0 && threadIdx.x == 0) { const unsigned long long t0 = __builtin_amdgcn_s_memrealtime(); while (__builtin_amdgcn_s_memrealtime() - t0 < probe_us * 100ull) __builtin_amdgcn_s_sleep(10); }
#endif
#undef IN
#undef SEAM
}

extern "C" void kernel_launch(void* const* d_in, const int* in_sizes, int n_in, void* d_out, int out_size, void* d_ws, size_t ws_size, hipStream_t stream) {
    static int grid = 0;
    if (grid == 0) {
        if (n_in != 15 || in_sizes[0] != M * D || out_size != M * D || ws_size < WS_END) { fprintf(stderr, "kernel_launch: unexpected shapes (n_in %d, in0 %d, out %d, ws %zu)\n", n_in, n_in > 0 ? in_sizes[0] : -1, out_size, ws_size); grid = -1; return; }
        int dev = 0, cus = 0;
        if (hipGetDevice(&dev) != hipSuccess || hipDeviceGetAttribute(&cus, hipDeviceAttributeMultiprocessorCount, dev) != hipSuccess) { grid = -1; return; }
        if (hipFuncSetAttribute((const void*)fwd_kernel, hipFuncAttributeMaxDynamicSharedMemorySize, LDS_BYTES) != hipSuccess) { fprintf(stderr, "kernel_launch: hipFuncSetAttribute failed\n"); grid = -1; return; }
        int per_cu = 0;
        if (hipOccupancyMaxActiveBlocksPerMultiprocessor(&per_cu, (const void*)fwd_kernel, NWAVES * 64, LDS_BYTES) != hipSuccess || per_cu < 1) fprintf(stderr, "kernel_launch: occupancy query says %d\n", per_cu);
        (void)hipGetLastError();
        grid = cus;
    }
    if (grid < 0) return;
    (void)hipMemsetAsync((char*)d_ws + WS_CTL, 0, CTL_ZERO_BYTES, stream);
    Args a{};
    for (int i = 0; i < 15; ++i) a.in[i] = (const float*)d_in[i];
    a.out = (float*)d_out; a.ws = (unsigned char*)d_ws;
#if ONE_LAUNCH
    a.ph_lo = 0; a.ph_hi = NPHASE;
    hipLaunchKernelGGL(fwd_kernel, dim3(grid), dim3(NWAVES * 64), LDS_BYTES, stream, a);
#else
    for (int p = 0; p < NPHASE; ++p) { if (!phase_live(p)) continue; a.ph_lo = p; a.ph_hi = p + 1; hipLaunchKernelGGL(fwd_kernel, dim3(grid), dim3(NWAVES * 64), LDS_BYTES, stream, a); }
#endif
}
```

```cpp
#include <hip/hip_runtime.h>
#include <hip/hip_bf16.h>
#include <cstdio>
#include <cstdint>
#include <cmath>
namespace pg8 {
#define PG8_LAS __attribute__((address_space(3)))
typedef unsigned short bf16_t;
typedef short bf16x8 __attribute__((ext_vector_type(8)));
typedef float f32x4 __attribute__((ext_vector_type(4)));
typedef unsigned u32x4 __attribute__((ext_vector_type(4)));
constexpr int BM = 256, BK = 64, HALF = 128, HTB = HALF * BK * 2  , STAGE_BYTES = 8 * HTB, NXCD = 8, WGM = 8;

__host__ __device__ __forceinline__ int lds_byte(int r, int c) { const int st = (r >> 4) * 2 + (c >> 5), rr = r & 15, cc = c & 31, ob = rr * 64 + cc * 2; return st * 1024 + (ob ^ (((ob >> 9) & 1) << 5)); }
__host__ __device__ __forceinline__ void stage_rc(int b, int& R, int& C) { const int st = b / 1024, sb = b % 1024, swz = sb ^ (((sb >> 9) & 1) << 5); R = (st >> 1) * 16 + swz / 64; C = (st & 1) * 32 + (swz % 64) / 2; }
__host__ __device__ __forceinline__ int perm32(int rho) { const int n = rho >> 4, i = rho & 15; return 8 * (i >> 2) + 4 * n + (i & 3); }

struct Unit { int pm, pn; };
struct Gemm { const bf16_t* A; const bf16_t* Bt; int M, N, K; };

struct StaticOrder {
    int nM, nN, nwg, G, c;
    __host__ __device__ void init(int M, int N, int G_, int c_) { nM = M / BM; nN = N / BM; nwg = nM * nN; G = G_; c = c_; }
    __host__ __device__ bool next(int i, Unit& u) const {
        const long L = (long)i * G + c; if (L >= nwg) return false;
        int wgid = (int)L; { const int q = nwg / NXCD, r = nwg % NXCD, xcd = wgid % NXCD, off = wgid / NXCD; wgid = (xcd < r ? xcd * (q + 1) : r * (q + 1) + (xcd - r) * q) + off; }
        const int nig = WGM * nN, gid = wgid / nig, fm = gid * WGM, gsz = (nM - fm) < WGM ? (nM - fm) : WGM;
        u.pm = fm + ((wgid % nig) % gsz); u.pn = (wgid % nig) / gsz; return true;
    }
    __device__ __forceinline__ void a_ready(const Unit&) const {}
    __device__ __forceinline__ void done(const Unit&) const {}
};

__device__ __forceinline__ unsigned cvt_pk_bf16(float lo, float hi) { unsigned r; asm volatile("v_cvt_pk_bf16_f32 %0, %1, %2" : "=v"(r) : "v"(lo), "v"(hi)); return r; }
typedef float f32x2 __attribute__((ext_vector_type(2)));
__device__ __forceinline__ f32x2 gelu_pk(f32x2 v) {
    const f32x2 av = __builtin_elementwise_abs(v), d = av * 0.2316418882f + 1.0f;
    f32x2 t; t.x = __builtin_amdgcn_rcpf(d.x); t.y = __builtin_amdgcn_rcpf(d.y);
    f32x2 q = t * 0.5307027145f + (-0.7265760135f); q = q * t + 0.7107068705f; q = q * t + (-0.142248368f); q = q * t + 0.127414796f; q = q * t;
    const f32x2 s = (v * v) * (-0.72134752044f);
    f32x2 e; e.x = __builtin_amdgcn_exp2f(s.x); e.y = __builtin_amdgcn_exp2f(s.y);
    const f32x2 m = v * (q * e), r = v - m;
    f32x2 o; o.x = v.x < 0.f ? m.x : r.x; o.y = v.y < 0.f ? m.y : r.y; return o;
}

template <int ACT  > struct EpiBf16 {
    static constexpr bool PERM = true, AFTER_DRAIN = false; static_assert(ACT == 0 || ACT == 1, "EpiBf16: ACT is 0 (none) or 1 (gelu_pk)");
    bf16_t* O; int ldc; const float* bias; int split_cols; size_t split_stride; float scale0;
    __device__ __forceinline__ void operator()(const f32x4 (&acc)[2][2][4][2], const Unit& u, int wr, int wc, int fr, int fq) const {
        const int row0 = u.pm * BM + wr * 64 + fr; int colt = u.pn * BM; bf16_t* base = O;
        float sc = 1.f; if (split_cols) { const int t = colt / split_cols; base += (size_t)t * split_stride; colt -= t * split_cols; if (t == 0) sc = scale0; }
        const int col0 = colt + wc * 32 + 8 * fq, bcol0 = u.pn * BM + wc * 32 + 8 * fq;
        f32x4 bv[2][2];
#pragma unroll
        for (int bj = 0; bj < 2; ++bj)
#pragma unroll
            for (int n = 0; n < 2; ++n) bv[bj][n] = bias ? *(const f32x4*)(bias + bcol0 + bj * HALF + 4 * n) : (f32x4){0.f, 0.f, 0.f, 0.f};
#pragma unroll
        for (int ai = 0; ai < 2; ++ai)
#pragma unroll
            for (int m = 0; m < 4; ++m) { bf16_t* rowp = base + (size_t)(row0 + ai * HALF + m * 16) * ldc + col0;
#pragma unroll
                for (int bj = 0; bj < 2; ++bj) { f32x4 v0 = acc[ai][bj][m][0] + bv[bj][0], v1 = acc[ai][bj][m][1] + bv[bj][1];
                    if (ACT == 1) { f32x2 a = gelu_pk((f32x2){v0[0], v0[1]}), b = gelu_pk((f32x2){v0[2], v0[3]}), c = gelu_pk((f32x2){v1[0], v1[1]}), d = gelu_pk((f32x2){v1[2], v1[3]});
                        v0 = (f32x4){a.x, a.y, b.x, b.y}; v1 = (f32x4){c.x, c.y, d.x, d.y}; }
                    v0 = v0 * sc; v1 = v1 * sc; u32x4 w; w.x = cvt_pk_bf16(v0[0], v0[1]); w.y = cvt_pk_bf16(v0[2], v0[3]); w.z = cvt_pk_bf16(v1[0], v1[1]); w.w = cvt_pk_bf16(v1[2], v1[3]);
                    *(u32x4*)(rowp + bj * HALF) = w; } }
    }
};
struct EpiRes {
    static constexpr bool PERM = false, AFTER_DRAIN = false;
    const float* res; float* out; int ldc;
    __device__ __forceinline__ void operator()(const f32x4 (&acc)[2][2][4][2], const Unit& u, int wr, int wc, int fr, int fq) const {
        const int row0 = u.pm * BM + wr * 64 + fr, col0 = u.pn * BM + wc * 32 + 4 * fq;
#pragma unroll
        for (int ai = 0; ai < 2; ++ai)
#pragma unroll
            for (int m = 0; m < 4; ++m) { const size_t off = (size_t)(row0 + ai * HALF + m * 16) * ldc + col0;
                f32x4 r[2][2];
#pragma unroll
                for (int bj = 0; bj < 2; ++bj)
#pragma unroll
                    for (int n = 0; n < 2; ++n) r[bj][n] = *(const f32x4*)(res + off + bj * HALF + n * 16);
#pragma unroll
                for (int bj = 0; bj < 2; ++bj)
#pragma unroll
                    for (int n = 0; n < 2; ++n) *(f32x4*)(out + off + bj * HALF + n * 16) = r[bj][n] + acc[ai][bj][m][n]; }
    }
};
struct EpiBf16R {
    static constexpr bool PERM = true, AFTER_DRAIN = false;
    bf16_t* O; int ldc; int split_cols; size_t split_stride; const unsigned long long* ss; float inv_k, eps;
    __device__ __forceinline__ void operator()(const f32x4 (&acc)[2][2][4][2], const Unit& u, int wr, int wc, int fr, int fq) const {
        const int row0 = u.pm * BM + wr * 64 + fr; int colt = u.pn * BM; bf16_t* base = O;
        { const int t = colt / split_cols; base += (size_t)t * split_stride; colt -= t * split_cols; }
        const int col0 = colt + wc * 32 + 8 * fq;
        float rs[2][4];
#pragma unroll
        for (int ai = 0; ai < 2; ++ai)
#pragma unroll
            for (int m = 0; m < 4; ++m) rs[ai][m] = (float)ss[row0 + ai * HALF + m * 16] * (1.0f / 16777216.0f);
#pragma unroll
        for (int ai = 0; ai < 2; ++ai)
#pragma unroll
            for (int m = 0; m < 4; ++m) { bf16_t* rowp = base + (size_t)(row0 + ai * HALF + m * 16) * ldc + col0;
                const float sc = __builtin_amdgcn_rsqf(rs[ai][m] * inv_k + eps);
#pragma unroll
                for (int bj = 0; bj < 2; ++bj) { const f32x4 v0 = acc[ai][bj][m][0] * sc, v1 = acc[ai][bj][m][1] * sc;
                    u32x4 w; w.x = cvt_pk_bf16(v0[0], v0[1]); w.y = cvt_pk_bf16(v0[2], v0[3]); w.z = cvt_pk_bf16(v1[0], v1[1]); w.w = cvt_pk_bf16(v1[2], v1[3]);
                    *(u32x4*)(rowp + bj * HALF) = w; } }
    }
};
struct EpiResX {
    static constexpr bool PERM = false, AFTER_DRAIN = false;
    const float* res; float* out; int ldc; bf16_t* xb; unsigned long long* ssn;
    __device__ __forceinline__ void operator()(const f32x4 (&acc)[2][2][4][2], const Unit& u, int wr, int wc, int fr, int fq) const {
        typedef unsigned u32x2 __attribute__((ext_vector_type(2)));
        const int row0 = u.pm * BM + wr * 64 + fr, col0 = u.pn * BM + wc * 32 + 4 * fq;
#pragma unroll
        for (int ai = 0; ai < 2; ++ai)
#pragma unroll
            for (int m = 0; m < 4; ++m) { const int row = row0 + ai * HALF + m * 16; const size_t off = (size_t)row * ldc + col0;
                float s = 0.f;
#pragma unroll
                for (int bj = 0; bj < 2; ++bj) { const f32x4 r0 = *(const f32x4*)(res + off + bj * HALF), r1 = *(const f32x4*)(res + off + bj * HALF + 16);
#pragma unroll
                    for (int n = 0; n < 2; ++n) { const f32x4 o = (n ? r1 : r0) + acc[ai][bj][m][n]; *(f32x4*)(out + off + bj * HALF + n * 16) = o;
                        if (xb) { u32x2 w; w.x = cvt_pk_bf16(o[0], o[1]); w.y = cvt_pk_bf16(o[2], o[3]); *(u32x2*)(xb + off + bj * HALF + n * 16) = w;
                                  s += (o[0] * o[0] + o[1] * o[1]) + (o[2] * o[2] + o[3] * o[3]); } } }
                if (xb) { s += __shfl_xor(s, 16); s += __shfl_xor(s, 32); if (fq == 0) atomicAdd(ssn + row, (unsigned long long)(s * 16777216.0f)); } }
    }
};
struct EpiNull {
    static constexpr bool PERM = true, AFTER_DRAIN = false;
    __device__ __forceinline__ void operator()(const f32x4 (&acc)[2][2][4][2], const Unit& u, int wr, int wc, int fr, int fq) const {
#pragma unroll
        for (int ai = 0; ai < 2; ++ai)
#pragma unroll
            for (int bj = 0; bj < 2; ++bj)
#pragma unroll
                for (int m = 0; m < 4; ++m)
#pragma unroll
                    for (int n = 0; n < 2; ++n) asm volatile("" :: "v"(acc[ai][bj][m][n]));
    }
};
struct RepeatOrder {
    int n, c;
    __device__ bool next(int i, Unit& u) const { if (i >= n) return false; u.pm = c & 1; u.pn = 0; return true; }
    __device__ __forceinline__ void a_ready(const Unit&) const {}
    __device__ __forceinline__ void done(const Unit&) const {}
};
struct EpiResB {
    static constexpr bool PERM = false, AFTER_DRAIN = false;
    bf16_t* xb; int ldc; float* outf; unsigned long long* ssn;
    __device__ __forceinline__ void operator()(const f32x4 (&acc)[2][2][4][2], const Unit& u, int wr, int wc, int fr, int fq) const {
        typedef unsigned u32x2 __attribute__((ext_vector_type(2)));
        const int row0 = u.pm * BM + wr * 64 + fr, col0 = u.pn * BM + wc * 32 + 4 * fq;
#pragma unroll
        for (int ai = 0; ai < 2; ++ai)
#pragma unroll
            for (int m = 0; m < 4; ++m) { const int row = row0 + ai * HALF + m * 16; const size_t off = (size_t)row * ldc + col0;
                u32x2 r[2][2];
#pragma unroll
                for (int bj = 0; bj < 2; ++bj)
#pragma unroll
                    for (int n = 0; n < 2; ++n) r[bj][n] = *(const u32x2*)(xb + off + bj * HALF + n * 16);
                float s = 0.f;
#pragma unroll
                for (int bj = 0; bj < 2; ++bj)
#pragma unroll
                    for (int n = 0; n < 2; ++n) { const u32x2 rr = r[bj][n];
                        f32x4 o = acc[ai][bj][m][n]; o[0] += __uint_as_float(rr.x << 16); o[1] += __uint_as_float(rr.x & 0xffff0000u); o[2] += __uint_as_float(rr.y << 16); o[3] += __uint_as_float(rr.y & 0xffff0000u);
                        if (outf) { *(f32x4*)(outf + off + bj * HALF + n * 16) = o; }
                        else { u32x2 w; w.x = cvt_pk_bf16(o[0], o[1]); w.y = cvt_pk_bf16(o[2], o[3]); *(u32x2*)(xb + off + bj * HALF + n * 16) = w;
                               const float q0 = __uint_as_float(w.x << 16), q1 = __uint_as_float(w.x & 0xffff0000u), q2 = __uint_as_float(w.y << 16), q3 = __uint_as_float(w.y & 0xffff0000u);
                               s += (q0 * q0 + q1 * q1) + (q2 * q2 + q3 * q3); } }
                if (!outf) { s += __shfl_xor(s, 16); s += __shfl_xor(s, 32); if (fq == 0) atomicAdd(ssn + row, (unsigned long long)(s * 16777216.0f)); } }
    }
};
template <class Epi, class Sched, bool ALIGN_EPI = false, bool SP2 = false, bool BLK = false>
__device__ __forceinline__ void gemm_phase(PG8_LAS unsigned char* lds, const Gemm g, const Sched& S, const Epi& E, const int tid_in) {
    const int tid = tid_in, wid = __builtin_amdgcn_readfirstlane(tid >> 6), lane = tid & 63, wr = wid >> 2, wc = wid & 3, fr = lane & 15, fq = lane >> 4;
    const int K = g.K, nt = K / BK;
    unsigned voffA[2], voffB[2];
#pragma unroll
    for (int i = 0; i < 2; ++i) { int R, C; stage_rc(tid * 16 + i * 8192, R, C); const int Rb = Epi::PERM ? ((R & ~31) + perm32(R & 31)) : R;
        voffA[i] = (unsigned)(R * (BLK ? BK : K) + C) * 2u; voffB[i] = (unsigned)(Rb * (BLK ? BK : K) + C) * 2u; }
    const size_t kstepA = BLK ? (size_t)g.M * BK * 2 : (size_t)(BK * 2), kstepB = BLK ? (size_t)g.N * BK * 2 : (size_t)(BK * 2);
    const size_t hstep = BLK ? (size_t)HALF * BK * 2 : (size_t)HALF * K * 2;
    const size_t tstep = 2 * hstep;
    const unsigned ldsw = (unsigned)wid * 1024u;
    const int aoff = lds_byte(wr * 64 + fr, fq * 8), boff = lds_byte(wc * 32 + fr, fq * 8);
#define PG8_SA(b, h) (((b) * 2 + (h)) * HTB)
#define PG8_SB(b, h) ((4 + (b) * 2 + (h)) * HTB)
#define PG8_STAGE(bufoff, gbase, voff) do { _Pragma("unroll") for (int _i = 0; _i < 2; ++_i) \
        __builtin_amdgcn_global_load_lds((const unsigned*)((const char*)(gbase) + (voff)[_i]), (PG8_LAS unsigned*)(lds + (bufoff) + ldsw + _i * 8192), 16, 0, 0); } while (0)
#define PG8_LDA(dst, b, h) do { _Pragma("unroll") for (int m = 0; m < 4; ++m) _Pragma("unroll") for (int k = 0; k < 2; ++k) dst[m][k] = *(const PG8_LAS bf16x8*)(lds + PG8_SA(b, h) + aoff + m * 2048 + k * 1024); } while (0)
#define PG8_LDB(dst, b, h) do { _Pragma("unroll") for (int n = 0; n < 2; ++n) _Pragma("unroll") for (int k = 0; k < 2; ++k) dst[n][k] = *(const PG8_LAS bf16x8*)(lds + PG8_SB(b, h) + boff + n * 2048 + k * 1024); } while (0)
#define PG8_MMA(ai, bj, At, Bt) do { __builtin_amdgcn_s_setprio(1); _Pragma("unroll") for (int m = 0; m < 4; ++m) _Pragma("unroll") for (int n = 0; n < 2; ++n) _Pragma("unroll") for (int k = 0; k < 2; ++k) \
        acc[ai][bj][m][n] = __builtin_amdgcn_mfma_f32_16x16x32_bf16(Bt[n][k], At[m][k], acc[ai][bj][m][n], 0, 0, 0); __builtin_amdgcn_s_setprio(0); } while (0)
#define PG8_WAIT_V(n) asm volatile("s_waitcnt vmcnt(" #n ")" ::: "memory")
#define PG8_WAIT_L(n) asm volatile("s_waitcnt lgkmcnt(" #n ")" ::: "memory")
#define PG8_BAR __builtin_amdgcn_s_barrier()
#define PG8_SCHED __builtin_amdgcn_sched_barrier(0)
    Unit cur, nxt; int ui = 0;
    if (!S.next(0, cur)) return;
    f32x4 acc[2][2][4][2];
#pragma unroll
    for (int a = 0; a < 2; ++a)
#pragma unroll
        for (int b = 0; b < 2; ++b)
#pragma unroll
            for (int m = 0; m < 4; ++m)
#pragma unroll
                for (int n = 0; n < 2; ++n) acc[a][b][m][n] = (f32x4){0.f, 0.f, 0.f, 0.f};
    bf16x8 At[4][2], B0[2][2], B1[2][2];
    const char* cA = (const char*)g.A + (size_t)cur.pm * tstep; const char* cB = (const char*)g.Bt + (size_t)cur.pn * tstep;
    S.a_ready(cur);
    if constexpr (SP2) {
        PG8_STAGE(PG8_SB(0, 0), cB, voffB); PG8_STAGE(PG8_SB(0, 1), cB + hstep, voffB); PG8_STAGE(PG8_SA(0, 0), cA, voffA); PG8_STAGE(PG8_SA(0, 1), cA + hstep, voffA);
        if (wr == 1) PG8_BAR;
        PG8_WAIT_V(2); PG8_BAR;
        PG8_STAGE(PG8_SB(1, 0), cB + kstepB, voffB); PG8_STAGE(PG8_SA(1, 0), cA + kstepA, voffA); PG8_STAGE(PG8_SB(1, 1), cB + hstep + kstepB, voffB);
        PG8_WAIT_V(6); PG8_BAR;
    } else {
        PG8_STAGE(PG8_SB(0, 0), cB, voffB); PG8_STAGE(PG8_SA(0, 0), cA, voffA); PG8_STAGE(PG8_SB(0, 1), cB + hstep, voffB); PG8_STAGE(PG8_SA(0, 1), cA + hstep, voffA);
        if (wr == 1) PG8_BAR;
        PG8_WAIT_V(4); PG8_BAR;
        PG8_STAGE(PG8_SB(1, 0), cB + kstepB, voffB); PG8_STAGE(PG8_SA(1, 0), cA + kstepA, voffA); PG8_STAGE(PG8_SB(1, 1), cB + hstep + kstepB, voffB);
        PG8_WAIT_V(6); PG8_BAR;
    }
    for (;;) {
        const bool has_next = S.next(ui + 1, nxt);
        const char* nA = has_next ? (const char*)g.A + (size_t)nxt.pm * tstep : cA; const char* nB = has_next ? (const char*)g.Bt + (size_t)nxt.pn * tstep : cB;
        for (int t = 0; t < nt; t += 2) {
            const bool last = (t == nt - 2);
            const char* a1 = cA + (size_t)(t + 1) * kstepA;
            const char* a2 = last ? nA : cA + (size_t)(t + 2) * kstepA; const char* b2 = last ? nB : cB + (size_t)(t + 2) * kstepB;
            const char* a3 = a2 + kstepA; const char* b3 = b2 + kstepB;
            if (last && has_next) S.a_ready(nxt);
            if constexpr (SP2) {
            PG8_LDB(B0, 0, 0); PG8_LDB(B1, 0, 1); PG8_SCHED; PG8_LDA(At, 0, 0); PG8_STAGE(PG8_SA(1, 1), a1 + hstep, voffA);
            PG8_WAIT_V(8); PG8_WAIT_L(0); PG8_BAR; PG8_MMA(0, 0, At, B0); PG8_MMA(0, 1, At, B1); PG8_BAR; PG8_SCHED;
            PG8_LDA(At, 0, 1); PG8_STAGE(PG8_SB(0, 0), b2, voffB); PG8_STAGE(PG8_SB(0, 1), b2 + hstep, voffB); PG8_STAGE(PG8_SA(0, 0), a2, voffA);
            PG8_WAIT_V(8); PG8_WAIT_L(0); PG8_BAR; PG8_MMA(1, 0, At, B0); PG8_MMA(1, 1, At, B1); PG8_BAR; PG8_SCHED;
            PG8_LDB(B0, 1, 0); PG8_LDB(B1, 1, 1); PG8_SCHED; PG8_LDA(At, 1, 0); PG8_STAGE(PG8_SA(0, 1), a2 + hstep, voffA);
            PG8_WAIT_V(8); PG8_WAIT_L(0); PG8_BAR; PG8_MMA(0, 0, At, B0); PG8_MMA(0, 1, At, B1); PG8_BAR; PG8_SCHED;
            PG8_LDA(At, 1, 1); PG8_STAGE(PG8_SB(1, 0), b3, voffB); PG8_STAGE(PG8_SB(1, 1), b3 + hstep, voffB); PG8_STAGE(PG8_SA(1, 0), a3, voffA);
            PG8_WAIT_V(8); PG8_WAIT_L(0); PG8_BAR; PG8_MMA(1, 0, At, B0); PG8_MMA(1, 1, At, B1); PG8_BAR; PG8_SCHED;
            } else {
            PG8_LDB(B0, 0, 0); PG8_SCHED; PG8_LDA(At, 0, 0); PG8_STAGE(PG8_SA(1, 1), a1 + hstep, voffA);
            PG8_WAIT_L(8); PG8_BAR; PG8_WAIT_L(0); PG8_MMA(0, 0, At, B0); PG8_BAR; PG8_SCHED;
            PG8_LDB(B1, 0, 1); PG8_STAGE(PG8_SB(0, 0), b2, voffB);
            PG8_BAR; PG8_WAIT_L(0); PG8_MMA(0, 1, At, B1); PG8_BAR;
            PG8_LDA(At, 0, 1); PG8_STAGE(PG8_SA(0, 0), a2, voffA);
            PG8_BAR; PG8_WAIT_L(0); PG8_MMA(1, 0, At, B0); PG8_BAR; PG8_SCHED;
            PG8_STAGE(PG8_SB(0, 1), b2 + hstep, voffB);
            PG8_WAIT_V(6); PG8_BAR; PG8_MMA(1, 1, At, B1); PG8_BAR;
            PG8_LDB(B0, 1, 0); PG8_SCHED; PG8_LDA(At, 1, 0); PG8_STAGE(PG8_SA(0, 1), a2 + hstep, voffA);
            PG8_WAIT_L(8); PG8_BAR; PG8_WAIT_L(0); PG8_MMA(0, 0, At, B0); PG8_BAR; PG8_SCHED;
            PG8_LDB(B1, 1, 1); PG8_STAGE(PG8_SB(1, 0), b3, voffB);
            PG8_BAR; PG8_WAIT_L(0); PG8_MMA(0, 1, At, B1); PG8_BAR;
            PG8_LDA(At, 1, 1); PG8_STAGE(PG8_SA(1, 0), a3, voffA);
            PG8_BAR; PG8_WAIT_L(0); PG8_MMA(1, 0, At, B0); PG8_BAR; PG8_SCHED;
            PG8_STAGE(PG8_SB(1, 1), b3 + hstep, voffB);
            PG8_WAIT_V(6); PG8_BAR; PG8_MMA(1, 1, At, B1); PG8_BAR;
            }
        }
        if constexpr (ALIGN_EPI) { if (wr == 0) PG8_BAR; }
        if constexpr (!Epi::AFTER_DRAIN) { E(acc, cur, wr, wc, fr, fq); S.done(cur); }
        if (!has_next) break;
#pragma unroll
        for (int a = 0; a < 2; ++a)
#pragma unroll
            for (int b = 0; b < 2; ++b)
#pragma unroll
                for (int m = 0; m < 4; ++m)
#pragma unroll
                    for (int n = 0; n < 2; ++n) acc[a][b][m][n] = (f32x4){0.f, 0.f, 0.f, 0.f};
        cur = nxt; cA = nA; cB = nB; ++ui;
        if constexpr (ALIGN_EPI) { if (wr == 1) PG8_BAR; }
    }
    PG8_WAIT_V(0);
    if constexpr (!ALIGN_EPI) { if (wr == 0) PG8_BAR; }
    PG8_BAR;
    if constexpr (Epi::AFTER_DRAIN) { E.fused(acc, cur, wr, wc, fr, fq, lds, wid, lane); S.done(cur); }
#undef PG8_SA
#undef PG8_SB
#undef PG8_STAGE
#undef PG8_LDA
#undef PG8_LDB
#undef PG8_MMA
#undef PG8_WAIT_V
#undef PG8_WAIT_L
#undef PG8_BAR
#undef PG8_SCHED
}
}
namespace fox {
constexpr int ALD = 2048;
constexpr int AD = 128;
constexpr float SCALE = 0.08838834764831845f;
constexpr float INVS = 11.313708498984761f;
constexpr float THR = 8.f;
constexpr int NW = 8, QBLK = 32, KVBLK = 64, QB = NW * QBLK;
constexpr int SHM_V = KVBLK * AD * 2, SHM_K = KVBLK * AD * 2;
constexpr int LDS_F = 2 * SHM_V + 2 * SHM_K + NW * 64 * 4;
constexpr int LDS_BYTES = LDS_F + 2 * 256;
constexpr int SO_PITCH = 264, SO_WAVE = 32 * SO_PITCH, LDS_SO = 71680;
constexpr float NEPS = 1e-6f;

using bf16 = __hip_bfloat16;
typedef short bf16x8 __attribute__((ext_vector_type(8)));
typedef short s16x4 __attribute__((ext_vector_type(4)));
typedef float f32x16 __attribute__((ext_vector_type(16)));
typedef float f32x4 __attribute__((ext_vector_type(4)));
typedef unsigned u32x4 __attribute__((ext_vector_type(4)));

#define KSWZ(row, colB) ((row) * 256 + ((colB) ^ (((row) & 7) << 4)))
#define SBAR() __builtin_amdgcn_sched_barrier(0)
__device__ __forceinline__ int v_st(int k, int c) { const int kk = (k & ~0xC) | ((k & 4) << 1) | ((k & 8) >> 1); return ((kk >> 3) * 4 + (c >> 5)) * 512 + ((kk & 7) * 32 + (c & 31)) * 2; }
__device__ __forceinline__ int v_rd_base(int lane) { return ((lane & 3) << 3) | (((lane >> 2) & 3) << 6) | (((lane >> 4) & 1) << 5) | (((lane >> 5) & 1) << 8); }
constexpr int v_rd_off(int d0, int ks, int half) { return d0 * 512 + ks * 4096 + half * 2048; }
__device__ __forceinline__ int fresh_lane() { int l; asm volatile("v_mbcnt_lo_u32_b32 %0, -1, 0\n\tv_mbcnt_hi_u32_b32 %0, -1, %0" : "=v"(l)); return l; }
__device__ __forceinline__ int crow(int r, int hi) { return (r & 3) + 8 * (r >> 2) + 4 * hi; }
__device__ __forceinline__ unsigned cvtpk(float lo, float hi) {
    unsigned r; asm volatile("v_cvt_pk_bf16_f32 %0, %1, %2" : "=v"(r) : "v"(lo), "v"(hi)); return r;
}
typedef __amdgpu_buffer_rsrc_t rsrc_t;
__device__ __forceinline__ rsrc_t mk_rsrc(const void* p) { return __builtin_amdgcn_make_buffer_rsrc((void*)p, (short)0, 0x7ffffff0, 0x00020000); }
__device__ __forceinline__ bf16x8 ldb8(rsrc_t r, int voff, int soff) { return __builtin_bit_cast(bf16x8, __builtin_amdgcn_raw_buffer_load_b128(r, voff, soff, 0)); }
__device__ __forceinline__ f32x4 ldf4(rsrc_t r, int voff, int soff) { return __builtin_bit_cast(f32x4, __builtin_amdgcn_raw_buffer_load_b128(r, voff, soff, 0)); }
__device__ __forceinline__ void mask_tile(f32x16& p0, f32x16& p1, int dq, unsigned W) {
    const float NEG = -__builtin_inff();
#pragma unroll
    for (int r = 0; r < 16; ++r) {
        const int c = (r & 3) + 8 * (r >> 2);
        if ((unsigned)(dq - c) >= W) p0[r] = NEG;
        if ((unsigned)(dq - c - 32) >= W) p1[r] = NEG;
    }
}
__device__ __forceinline__ void partialSM(f32x16& p0, f32x16& p1, float& m_reg, float& mn, float& alpha) {
    float pmax = p0[0]; for (int r = 1; r < 16; ++r) pmax = fmaxf(pmax, p0[r]); for (int r = 0; r < 16; ++r) pmax = fmaxf(pmax, p1[r]);
    { auto rr = __builtin_amdgcn_permlane32_swap(__float_as_uint(pmax), __float_as_uint(pmax), false, false);
      pmax = fmaxf(__uint_as_float(rr[0]), __uint_as_float(rr[1])); }
    constexpr float C2 = 1.4426950408889634f * SCALE;
    if (__builtin_expect(__all((pmax - m_reg) * SCALE <= THR), 1)) { mn = m_reg; alpha = 1.f; }
    else { mn = fmaxf(m_reg, pmax); alpha = __builtin_amdgcn_exp2f((m_reg - mn) * C2); m_reg = mn; }
    const float mnL = -mn * C2;
    for (int r = 0; r < 16; ++r) p0[r] = fmaf(p0[r], C2, mnL); for (int r = 0; r < 16; ++r) p1[r] = fmaf(p1[r], C2, mnL);
    for (int r = 0; r < 16; ++r) p0[r] = __builtin_amdgcn_exp2f(p0[r]);
}
__device__ __forceinline__ void finishSM(f32x16& p0, f32x16& p1, float alpha, float& l_reg, bf16x8& pa0, bf16x8& pa1, bf16x8& pa2, bf16x8& pa3) {
    for (int r = 0; r < 16; ++r) p1[r] = __builtin_amdgcn_exp2f(p1[r]);
    float ps = 0; for (int r = 0; r < 16; ++r) ps += p0[r]; for (int r = 0; r < 16; ++r) ps += p1[r];
    { auto rr = __builtin_amdgcn_permlane32_swap(__float_as_uint(ps), __float_as_uint(ps), false, false);
      ps = __uint_as_float(rr[0]) + __uint_as_float(rr[1]); }
    l_reg = l_reg * alpha + ps;
#define PK4(P, B_, OUT) do { unsigned a0 = cvtpk(P[B_+0], P[B_+1]), a1 = cvtpk(P[B_+2], P[B_+3]);                          \
        unsigned b0 = cvtpk(P[B_+4], P[B_+5]), b1 = cvtpk(P[B_+6], P[B_+7]);                                             \
        auto r0 = __builtin_amdgcn_permlane32_swap(a0, b0, false, false); auto r1 = __builtin_amdgcn_permlane32_swap(a1, b1, false, false); \
        u32x4 w = {r0[0], r1[0], r0[1], r1[1]}; OUT = *reinterpret_cast<bf16x8*>(&w); } while (0)
    PK4(p0, 0, pa0); PK4(p0, 8, pa1); PK4(p1, 0, pa2); PK4(p1, 8, pa3);
#undef PK4
}
template <int KB>
__device__ __forceinline__ void qkt(f32x16& p0, f32x16& p1, const char* K_lds, const char* F_lds, int r32, int hi, const bf16x8* qr) {
    { const f32x4* fk = reinterpret_cast<const f32x4*>(F_lds + KB * 256);
#pragma unroll
      for (int g = 0; g < 4; ++g) { const f32x4 a = fk[2 * g + hi], b = fk[8 + 2 * g + hi];
#pragma unroll
          for (int e = 0; e < 4; ++e) { p0[4 * g + e] = a[e]; p1[4 * g + e] = b[e]; } } }
    const char* kb[4];
#pragma unroll
    for (int dd = 0; dd < 4; ++dd) kb[dd] = K_lds + KB * SHM_K + KSWZ(r32, (dd * 16 + hi * 8) * 2);
#pragma unroll
    for (int d0 = 0; d0 < 8; ++d0) { const char* a = kb[d0 & 3] + (d0 >> 2) * 128;
        bf16x8 b0 = *reinterpret_cast<const bf16x8*>(a);
        bf16x8 b1 = *reinterpret_cast<const bf16x8*>(a + 32 * 256);
        p0 = __builtin_amdgcn_mfma_f32_32x32x16_bf16(b0, qr[d0], p0, 0, 0, 0);
        p1 = __builtin_amdgcn_mfma_f32_32x32x16_bf16(b1, qr[d0], p1, 0, 0, 0); }
}
template <int VB>
__device__ __forceinline__ void pv_tile(f32x16* o, int vb0, bf16x8 pa0, bf16x8 pa1, bf16x8 pa2, bf16x8 pa3) {
#define TRRD(dst, off) asm volatile("ds_read_b64_tr_b16 %0, %1 offset:%2" : "=&v"(dst) : "v"(vb0), "i"(off) : "memory")
#define PV_D0(d0) do { s16x4 l0, l1, l2, l3, h0, h1, h2, h3; constexpr int b_ = VB * SHM_V + v_rd_off(d0, 0, 0);     \
        TRRD(l0, b_); TRRD(h0, b_ + 2048); TRRD(l1, b_ + 4096); TRRD(h1, b_ + 6144); TRRD(l2, b_ + 8192); TRRD(h2, b_ + 10240); TRRD(l3, b_ + 12288); TRRD(h3, b_ + 14336); \
        asm volatile("s_waitcnt lgkmcnt(0)" ::: "memory"); SBAR();                 \
        o[d0] = __builtin_amdgcn_mfma_f32_32x32x16_bf16(pa0, (bf16x8){l0[0], l0[1], l0[2], l0[3], h0[0], h0[1], h0[2], h0[3]}, o[d0], 0, 0, 0);   \
        o[d0] = __builtin_amdgcn_mfma_f32_32x32x16_bf16(pa1, (bf16x8){l1[0], l1[1], l1[2], l1[3], h1[0], h1[1], h1[2], h1[3]}, o[d0], 0, 0, 0);   \
        o[d0] = __builtin_amdgcn_mfma_f32_32x32x16_bf16(pa2, (bf16x8){l2[0], l2[1], l2[2], l2[3], h2[0], h2[1], h2[2], h2[3]}, o[d0], 0, 0, 0);   \
        o[d0] = __builtin_amdgcn_mfma_f32_32x32x16_bf16(pa3, (bf16x8){l3[0], l3[1], l3[2], l3[3], h3[0], h3[1], h3[2], h3[3]}, o[d0], 0, 0, 0); } while (0)
    PV_D0(0); PV_D0(1); PV_D0(2); PV_D0(3);
#undef PV_D0
#undef TRRD
}

struct BlockRef { const bf16* Q; const bf16* K; const bf16* V; bf16* O; const float* F; const bf16* G; const float* wo; int P0; int jlo; };
struct Seam {
    bf16x8 qr[8];
    bf16x8 st_v0, st_v1, st_k0, st_k1; f32x4 st_f;
};
#define VMW() asm volatile("s_waitcnt vmcnt(0)" ::: "memory")
#define VMWN(n) asm volatile("s_waitcnt vmcnt(%0)" :: "i"(n) : "memory")
#define SLOAD_H(rK_, rV_, rF_, k0) do { const int so_ = (k0) * (ALD * 2);                                                    \
                         S.st_v0 = ldb8(rV_, kvoff, so_); S.st_v1 = ldb8(rV_, kvoff, so_ + 32 * ALD * 2);                    \
                         S.st_k0 = ldb8(rK_, kvoff, so_); S.st_k1 = ldb8(rK_, kvoff, so_ + 32 * ALD * 2);                    \
                         if (tid < 16) S.st_f = ldf4(rF_, tid * 16, (k0) * 4); } while (0)
#define QLOAD(rQ_) do { _Pragma("unroll") for (int d0 = 0; d0 < 8; ++d0) S.qr[d0] = ldb8(rQ_, qoff + d0 * 32, 0); } while (0)
#define SWRITE_HK(bf) do { *(bf16x8*)(K_lds + (bf) * SHM_K + kws) = S.st_k0; *(bf16x8*)(K_lds + (bf) * SHM_K + kws + 32 * 256) = S.st_k1; \
                           if (tid < 16) *(f32x4*)(F_lds + (bf) * 256 + tid * 16) = S.st_f; } while (0)
#define SWRITE_HV(bf) do { *(bf16x8*)(V_lds + (bf) * SHM_V + vst0) = S.st_v0; *(bf16x8*)(V_lds + (bf) * SHM_V + vst1) = S.st_v1; } while (0)
#define SWRITE_H(bf) do { SWRITE_HV(bf); SWRITE_HK(bf); } while (0)
__device__ __forceinline__ int fox_jlo(const float* Fn, int P0, float TH) {
    const int lane_ = fresh_lane();
    const int ntf = P0 / KVBLK + 4, kt = lane_ < ntf ? lane_ : ntf - 1;
    int zero_ = 0; asm volatile("" : "+v"(zero_));
    const float fe = Fn[kt * KVBLK + KVBLK - 1], fp0 = Fn[P0 + zero_];
    const unsigned long long mk = __ballot(fp0 - fe <= TH);
    return (int)__builtin_ctzll(mk);
}
__device__ __forceinline__ void normalize_q(bf16x8* qr, const float* wq, int hi) {
    float ss = 0.f;
#pragma unroll
    for (int d0 = 0; d0 < 8; ++d0) { const u32x4 w = __builtin_bit_cast(u32x4, qr[d0]);
#pragma unroll
        for (int e = 0; e < 4; ++e) { const float a = __uint_as_float(w[e] << 16), b = __uint_as_float(w[e] & 0xffff0000u); ss += a * a + b * b; } }
    { auto rr = __builtin_amdgcn_permlane32_swap(__float_as_uint(ss), __float_as_uint(ss), false, false); ss = __uint_as_float(rr[0]) + __uint_as_float(rr[1]); }
    const float rs = __builtin_amdgcn_rsqf(ss * (1.f / AD) + NEPS);
#pragma unroll
    for (int d0 = 0; d0 < 8; ++d0) { const u32x4 w = __builtin_bit_cast(u32x4, qr[d0]); const f32x4 w0 = *(const f32x4*)(wq + d0 * 16 + hi * 8), w1 = *(const f32x4*)(wq + d0 * 16 + hi * 8 + 4);
        u32x4 o; o[0] = cvtpk(__uint_as_float(w[0] << 16) * rs * w0[0], __uint_as_float(w[0] & 0xffff0000u) * rs * w0[1]); o[1] = cvtpk(__uint_as_float(w[1] << 16) * rs * w0[2], __uint_as_float(w[1] & 0xffff0000u) * rs * w0[3]);
        o[2] = cvtpk(__uint_as_float(w[2] << 16) * rs * w1[0], __uint_as_float(w[2] & 0xffff0000u) * rs * w1[1]); o[3] = cvtpk(__uint_as_float(w[3] << 16) * rs * w1[2], __uint_as_float(w[3] & 0xffff0000u) * rs * w1[3]);
        qr[d0] = __builtin_bit_cast(bf16x8, o); }
}
__device__ __forceinline__ void causal_prime(const BlockRef& cur, char* lds, Seam& S, const int wave_in) {
    const int tid = wave_in * 64 + fresh_lane(), wid = __builtin_amdgcn_readfirstlane(tid >> 6), lane = tid & 63, r32 = lane & 31, hi = lane >> 5;
    const int sr = tid >> 4, sc = (tid & 15) * 8, kws = KSWZ(sr, sc * 2); char* K_lds = lds + 2 * SHM_V; char* F_lds = lds + LDS_F;
    const int kvoff = (sr * ALD + sc) * 2, qoff = ((wid * QBLK + r32) * ALD + hi * 8) * 2;
    const rsrc_t rQ = mk_rsrc(cur.Q), rK = mk_rsrc(cur.K), rV = mk_rsrc(cur.V), rF = mk_rsrc(cur.F);
    QLOAD(rQ);
    SLOAD_H(rK, rV, rF, cur.jlo * KVBLK); VMW(); SWRITE_HK(0);
    __syncthreads();
}
__device__ __forceinline__ void causal_block(const BlockRef& cur, const BlockRef& nxt, char* lds, Seam& S, const float* wq, const int wave_in) {
    const int tid = wave_in * 64 + fresh_lane(), wid = __builtin_amdgcn_readfirstlane(tid >> 6), lane = tid & 63, r32 = lane & 31, hi = lane >> 5;
    constexpr int W = 1 << 30;
    const int j_lo = cur.jlo, NT = (cur.P0 + QB - 1) / KVBLK + 1 - j_lo;
    const int qlo = cur.P0 + wid * QBLK, qm = qlo + r32 - 4 * hi;
    char* V_lds = lds; char* K_lds = lds + 2 * SHM_V; char* F_lds = lds + LDS_F;
    float* ws = (float*)(lds + 2 * SHM_V + 2 * SHM_K) + wid * 64; float* li_l = ws, * al_l = ws + 32;
    float m_reg = -1e30f, l_reg = 0; f32x16 o[4] = {};
    const int sr = tid >> 4, sc = (tid & 15) * 8, vst0 = v_st(sr, sc), vst1 = v_st(32 + sr, sc), kws = KSWZ(sr, sc * 2);
    const int vb0 = (int)(uintptr_t)V_lds + v_rd_base(lane);
    const int kvoff = (sr * ALD + sc) * 2, qoff = ((wid * QBLK + r32) * ALD + hi * 8) * 2;
    const rsrc_t Kh = mk_rsrc(cur.K), Vh = mk_rsrc(cur.V), Fh = mk_rsrc(cur.F);
#define RESC(a) do { if (__any((a) < 1.f)) { if (hi == 0) al_l[r32] = (a); asm volatile("s_waitcnt lgkmcnt(0)" ::: "memory");              \
                     for (int d_ = 0; d_ < 4; ++d_) for (int r = 0; r < 16; ++r) o[d_][r] *= al_l[crow(r, hi)]; } } while (0)
#define KBASE(t) ((j_lo + (t)) * KVBLK)
#define MASKT(P0_, P1_, t) do { const int kb_ = KBASE(t); if (kb_ + KVBLK - 1 > qlo) mask_tile(P0_, P1_, qm - kb_, (unsigned)W); } while (0)
    constexpr int NQL = 8;
#define SEAM_K0() do { VMWN(NQL); SWRITE_HK(0); SBAR(); } while (0)
    f32x16 pA0, pA1, pB0, pB1; float mnA, mnB, alA, alB; bf16x8 pa0, pa1, pa2, pa3;
    normalize_q(S.qr, wq, hi);
    SWRITE_HV(0); SBAR();
    if (NT > 1) { SLOAD_H(Kh, Vh, Fh, KBASE(1)); }
    SBAR(); qkt<0>(pA0, pA1, K_lds, F_lds, r32, hi, S.qr);
    MASKT(pA0, pA1, 0); partialSM(pA0, pA1, m_reg, mnA, alA);
    if (NT > 1) { VMW(); SWRITE_H(1); }
    __syncthreads();
#define HALF_STEP(PX0, PX1, mnX, alX, PY0, PY1, alY, t, KB, VB, SB) do {                                                      \
        SBAR(); qkt<KB>(PX0, PX1, K_lds, F_lds, r32, hi, S.qr);                                                               \
        finishSM(PY0, PY1, alY, l_reg, pa0, pa1, pa2, pa3); SBAR();                                                           \
        if ((t) + 1 < NT) { SLOAD_H(Kh, Vh, Fh, KBASE((t) + 1)); SBAR(); }                                                    \
        pv_tile<VB>(o, vb0, pa0, pa1, pa2, pa3); MASKT(PX0, PX1, (t)); partialSM(PX0, PX1, m_reg, mnX, alX);                  \
        __syncthreads();                                                                                                      \
        if ((t) + 1 < NT) { VMW(); SWRITE_H(SB); }                                                                            \
        RESC(alX); __syncthreads(); } while (0)
    for (int t = 1; t + 1 < NT; t += 2) {
        HALF_STEP(pB0, pB1, mnB, alB, pA0, pA1, alA, t, 1, 0, 0);
        HALF_STEP(pA0, pA1, mnA, alA, pB0, pB1, alB, t + 1, 0, 1, 1);
    }
    const bool even = (NT & 1) == 0;
    if (even) { SBAR(); qkt<1>(pB0, pB1, K_lds, F_lds, r32, hi, S.qr); SBAR(); }
    { const rsrc_t nK = mk_rsrc(nxt.K), nV = mk_rsrc(nxt.V), nF = mk_rsrc(nxt.F), nQ = mk_rsrc(nxt.Q);
      SLOAD_H(nK, nV, nF, nxt.jlo * KVBLK); SBAR();
      QLOAD(nQ); }
    SBAR();
    finishSM(pA0, pA1, alA, l_reg, pa0, pa1, pa2, pa3); SBAR();
    pv_tile<0>(o, vb0, pa0, pa1, pa2, pa3);
    if (even) { MASKT(pB0, pB1, NT - 1); partialSM(pB0, pB1, m_reg, mnB, alB); __syncthreads(); RESC(alB);
        finishSM(pB0, pB1, alB, l_reg, pa0, pa1, pa2, pa3); SBAR(); pv_tile<1>(o, vb0, pa0, pa1, pa2, pa3); }
    SBAR(); SEAM_K0();
    { char* so = lds + LDS_SO + wid * SO_WAVE;
      const int erow = lane >> 1, eh = lane & 1, eoff = ((wid * QBLK + erow) * ALD + eh * 64) * 2;
      const rsrc_t rG = mk_rsrc(cur.G), rO = mk_rsrc(cur.O);
      bf16x8 gt[8];
#pragma unroll
      for (int i = 0; i < 8; ++i) gt[i] = ldb8(rG, eoff + i * 16, 0);
      if (hi == 0) li_l[r32] = l_reg; asm volatile("s_waitcnt lgkmcnt(0)" ::: "memory");
#pragma unroll
      for (int r = 0; r < 16; ++r) { const float rl = __builtin_amdgcn_rcpf(li_l[crow(r, hi)]);
#pragma unroll
        for (int d0 = 0; d0 < 4; ++d0) *(unsigned short*)(so + crow(r, hi) * SO_PITCH + (d0 * 32 + r32) * 2) = (unsigned short)(cvtpk(o[d0][r] * rl, 0.f) & 0xffffu); }
      asm volatile("s_waitcnt lgkmcnt(0)" ::: "memory");
      typedef unsigned u32x2 __attribute__((ext_vector_type(2)));
      u32x2 xw[16]; float ssq = 0.f;
#pragma unroll
      for (int i = 0; i < 16; ++i) { xw[i] = *(const u32x2*)(so + erow * SO_PITCH + eh * 128 + i * 8);
#pragma unroll
        for (int e = 0; e < 2; ++e) { const float a = __uint_as_float(xw[i][e] << 16), b = __uint_as_float(xw[i][e] & 0xffff0000u); ssq += a * a + b * b; } }
      ssq += __shfl_xor(ssq, 1);
      const float rs = __builtin_amdgcn_rsqf(ssq * (1.f / AD) + NEPS);
#pragma unroll
      for (int i = 0; i < 8; ++i) { const f32x4 w0 = *(const f32x4*)(cur.wo + eh * 64 + i * 8), w1 = *(const f32x4*)(cur.wo + eh * 64 + i * 8 + 4);
        const u32x4 g = __builtin_bit_cast(u32x4, gt[i]); const float ww[8] = {w0[0], w0[1], w0[2], w0[3], w1[0], w1[1], w1[2], w1[3]};
        u32x4 ow;
#pragma unroll
        for (int e = 0; e < 4; ++e) { const unsigned xv = xw[2 * i + (e >> 1)][e & 1];
            const float x0 = __uint_as_float(xv << 16), x1 = __uint_as_float(xv & 0xffff0000u), g0 = __uint_as_float(g[e] << 16), g1 = __uint_as_float(g[e] & 0xffff0000u);
            const float s0 = g0 * __builtin_amdgcn_rcpf(1.f + __builtin_amdgcn_exp2f(-1.4426950408889634f * g0)), s1 = g1 * __builtin_amdgcn_rcpf(1.f + __builtin_amdgcn_exp2f(-1.4426950408889634f * g1));
            ow[e] = cvtpk(x0 * rs * ww[2 * e] * s0, x1 * rs * ww[2 * e + 1] * s1); }
        __builtin_amdgcn_raw_buffer_store_b128(ow, rO, eoff + i * 16, 0, 0); } }
    __syncthreads();
#undef RESC
#undef KBASE
#undef MASKT
#undef SEAM_K0
#undef HALF_STEP
}
#undef QLOAD
#undef VMW
#undef VMWN
#undef SLOAD_H
#undef SWRITE_HK
#undef SWRITE_HV
#undef SWRITE_H
#undef KSWZ
#undef SBAR
}
namespace rec {
typedef short bf16x8 __attribute__((ext_vector_type(8)));
typedef short bf16x4 __attribute__((ext_vector_type(4)));
typedef float f32x4 __attribute__((ext_vector_type(4)));
typedef float f32x2 __attribute__((ext_vector_type(2)));
typedef __bf16 bf16x2_t __attribute__((ext_vector_type(2)));
typedef unsigned u32x4 __attribute__((ext_vector_type(4)));
typedef unsigned u32x2 __attribute__((ext_vector_type(2)));
#define REC_LAS __attribute__((address_space(3)))
constexpr int RT = 4096, RD = 2048, NSEG = 4, SEG = RT / NSEG, NCH = SEG / 64;
constexpr int QP = 272, TP = 144;
constexpr int OFF_KB = 160 * QP, OFF_KHT = OFF_KB + 64 * QP, OFF_VT = OFF_KHT + 128 * TP, OFF_AM = OFF_VT + 128 * TP, OFF_TOT = OFF_AM + 64 * TP, OFF_DL = OFF_TOT + 8 * 128 * 4, OFF_SO = OFF_DL + 512, LDS_END = OFF_SO + 64 * QP;
static_assert(LDS_END <= 131072, "recurrence LDS map");
__device__ __forceinline__ constexpr int qv_off(int j) { return (64 * j - 8 * j * (j - 1)) * QP; }
__device__ __forceinline__ unsigned cvt2(float lo, float hi) { f32x2 v = {lo, hi}; bf16x2_t b = __builtin_convertvector(v, bf16x2_t); return __builtin_bit_cast(unsigned, b); }
__device__ __forceinline__ float ex2(float x) { return __builtin_amdgcn_exp2f(x); }
__device__ __forceinline__ float lo_f(unsigned w) { return __uint_as_float(w << 16); }
__device__ __forceinline__ float hi_f(unsigned w) { return __uint_as_float(w & 0xffff0000u); }

template <bool OUT>
__device__ __forceinline__ void run(REC_LAS unsigned char* lds, int G, const unsigned short* Qp, const unsigned short* Zp, const unsigned short* Vp, unsigned short* Op,
                                    const float* lbl, int layer, float* Ug, float* Dg, const unsigned short* Gp, const float* wo, const int tid_in) {
    const int tid = tid_in, lane = tid & 63, wv = __builtin_amdgcn_readfirstlane(tid >> 6), fr = lane & 15, fg = lane >> 4;
    constexpr int NU = OUT ? 64 * NSEG : 64 * (NSEG - 1);
    if (OUT) { if (tid < 256) { const int blk = tid >> 7, r = (tid >> 3) & 15, c = tid & 7;
            *(REC_LAS unsigned*)(lds + OFF_AM + (32 * blk + r) * TP + (32 * blk + 16) * 2 + c * 4) = 0u; } }
    for (int u = blockIdx.x; u < NU; u += G) {
        const int bh = OUT ? u / NSEG : u / (NSEG - 1), seg = OUT ? u % NSEG : u % (NSEG - 1), b = bh >> 4, h = bh & 15;
        float lb[2];
#pragma unroll
        for (int dd = 0; dd < 2; ++dd) { const int c = h * 128 + 2 * lane + dd; lb[dd] = layer == 0 ? 0.f : 1.f / (1.f + __expf(lbl[c] - lbl[RD + c])); }
        f32x4 st[8];
#pragma unroll
        for (int kt = 0; kt < 8; ++kt) st[kt] = (f32x4){0.f, 0.f, 0.f, 0.f};
        if (OUT) {
            for (int s2 = 0; s2 < seg; ++s2) {
                const float* U = Ug + ((size_t)(bh * (NSEG - 1) + s2) << 14); const float* Dv = Dg + (bh * (NSEG - 1) + s2) * 128;
                f32x4 uu[8];
#pragma unroll
                for (int kt = 0; kt < 8; ++kt) uu[kt] = *(const f32x4*)(U + ((kt * 8 + wv) * 64 + lane) * 4);
#pragma unroll
                for (int kt = 0; kt < 8; ++kt) { const f32x4 dvv = *(const f32x4*)(Dv + 16 * kt + 4 * fg); st[kt] = dvv * st[kt] + uu[kt]; }
            }
        }
        const int er = tid >> 3, es = tid & 7;
#define REC_FLUSH(cp, g0, g1) do { const REC_LAS unsigned char* sp = lds + OFF_SO + er * QP + es * 32;                                          \
            const u32x4 x0 = *(const REC_LAS u32x4*)sp, x1 = *(const REC_LAS u32x4*)(sp + 16);                                                    \
            float xf[16], gf[16]; float ssq = 0.f;                                                                                                \
            _Pragma("unroll") for (int e = 0; e < 4; ++e) { xf[2 * e] = lo_f(x0[e]); xf[2 * e + 1] = hi_f(x0[e]); xf[8 + 2 * e] = lo_f(x1[e]); xf[9 + 2 * e] = hi_f(x1[e]);   \
                gf[2 * e] = lo_f(g0[e]); gf[2 * e + 1] = hi_f(g0[e]); gf[8 + 2 * e] = lo_f(g1[e]); gf[9 + 2 * e] = hi_f(g1[e]); }                 \
            _Pragma("unroll") for (int e = 0; e < 16; ++e) ssq += xf[e] * xf[e];                                                                  \
            ssq += __shfl_xor(ssq, 1); ssq += __shfl_xor(ssq, 2); ssq += __shfl_xor(ssq, 4);                                                      \
            const float rs_ = __builtin_amdgcn_rsqf(ssq * (1.f / 128.f) + 1e-6f);                                                                 \
            u32x4 y0, y1;                                                                                                                         \
            _Pragma("unroll") for (int q4 = 0; q4 < 4; ++q4) { const f32x4 w4 = *(const f32x4*)(wo + h * 128 + es * 16 + 4 * q4); float yv[4];     \
                _Pragma("unroll") for (int e = 0; e < 4; ++e) { const float g_ = gf[4 * q4 + e]; yv[e] = xf[4 * q4 + e] * rs_ * w4[e] * g_ * __builtin_amdgcn_rcpf(1.f + ex2(-1.4426950408889634f * g_)); } \
                if (q4 < 2) { y0[2 * q4] = cvt2(yv[0], yv[1]); y0[2 * q4 + 1] = cvt2(yv[2], yv[3]); } else { y1[2 * (q4 - 2)] = cvt2(yv[0], yv[1]); y1[2 * (q4 - 2) + 1] = cvt2(yv[2], yv[3]); } }   \
            unsigned short* op_ = Op + row0 + (size_t)(64 * (cp) + er) * RD + es * 16; *(u32x4*)op_ = y0; *(u32x4*)(op_ + 8) = y1; } while (0)
        float dsum[2] = {0.f, 0.f};
        const size_t row0 = (size_t)(b * RT + seg * SEG) * RD + h * 128;
        unsigned nq[8], nz[8], nv[8];
#pragma unroll
        for (int e = 0; e < 8; ++e) { const size_t o = row0 + (size_t)(8 * wv + e) * RD + 2 * lane; nq[e] = *(const unsigned*)(Qp + o); nz[e] = *(const unsigned*)(Zp + o); nv[e] = *(const unsigned*)(Vp + o); }
#pragma unroll 1
        for (int c = 0; c < NCH; ++c) {
            unsigned cq[8], cz[8], cv[8];
#pragma unroll
            for (int e = 0; e < 8; ++e) { cq[e] = nq[e]; cz[e] = nz[e]; cv[e] = nv[e]; }
            if (c + 1 < NCH) {
#pragma unroll
                for (int e = 0; e < 8; ++e) { const size_t o = row0 + (size_t)(64 * (c + 1) + 8 * wv + e) * RD + 2 * lane; nq[e] = *(const unsigned*)(Qp + o); nz[e] = *(const unsigned*)(Zp + o); nv[e] = *(const unsigned*)(Vp + o); }
            }
            float kf[8][2], cs[8][2];
#pragma unroll
            for (int e = 0; e < 8; ++e) {
#pragma unroll
                for (int dd = 0; dd < 2; ++dd) {
                    const float z = dd ? hi_f(cz[e]) : lo_f(cz[e]);
                    const float ez = ex2(-1.4426950408889634f * fabsf(z)), inv = __builtin_amdgcn_rcpf(1.f + ez);
                    const float sig = z >= 0.f ? inv : ez * inv, nsig = z >= 0.f ? ez * inv : inv;
                    const float f = lb[dd] + (1.f - lb[dd]) * sig;
                    kf[e][dd] = (1.f - lb[dd]) * nsig;
                    const float gl = __builtin_amdgcn_logf(f);
                    cs[e][dd] = e ? cs[e - 1][dd] + gl : gl;
                }
            }
            *(REC_LAS f32x2*)(lds + OFF_TOT + (wv * 128 + 2 * lane) * 4) = (f32x2){cs[7][0], cs[7][1]};
            __syncthreads();
            float P[9][2];
            P[0][0] = 0.f; P[0][1] = 0.f;
#pragma unroll
            for (int w = 0; w < 8; ++w) { const f32x2 t2 = *(const REC_LAS f32x2*)(lds + OFF_TOT + (w * 128 + 2 * lane) * 4); P[w + 1][0] = P[w][0] + t2[0]; P[w + 1][1] = P[w][1] + t2[1]; }
            float base[2], bl[2], Bj[4][2];
#pragma unroll
            for (int dd = 0; dd < 2; ++dd) { bl[dd] = P[8][dd]; float bs = 0.f;
#pragma unroll
                for (int w = 0; w < 8; ++w) bs = (w == wv) ? P[w][dd] : bs;
                base[dd] = bs;
#pragma unroll
                for (int j = 0; j < 4; ++j) Bj[j][dd] = P[2 * j][dd]; }
            const int jb = wv >> 1;
            float Bown[2];
#pragma unroll
            for (int dd = 0; dd < 2; ++dd) { float bo = 0.f;
#pragma unroll
                for (int j = 0; j < 4; ++j) bo = (j == jb) ? Bj[j][dd] : bo;
                Bown[dd] = bo; }
            float Ej[4][2], Eend[2];
#pragma unroll
            for (int dd = 0; dd < 2; ++dd) { Eend[dd] = ex2(bl[dd] - Bown[dd]);
#pragma unroll
                for (int j = 0; j < 4; ++j) Ej[j][dd] = (j < jb) ? ex2(Bown[dd] - Bj[j][dd]) : 1.f; }
            unsigned khw[2][4], vtw[2][4];
#pragma unroll
            for (int e = 0; e < 8; ++e) {
                const int t = 8 * wv + e;
                float eo[2], ko[2], qv[2];
#pragma unroll
                for (int dd = 0; dd < 2; ++dd) { const float x = base[dd] + cs[e][dd] - Bown[dd];
                    eo[dd] = ex2(x); ko[dd] = kf[e][dd] * ex2(fminf(-x, 120.f)); qv[dd] = (dd ? hi_f(cq[e]) : lo_f(cq[e])) * eo[dd]; }
                if (OUT) {
#pragma unroll
                    for (int j = 0; j < 4; ++j) if (j <= jb)
                        *(REC_LAS unsigned*)(lds + qv_off(j) + (t - 16 * j) * QP + lane * 4) = cvt2(qv[0] * Ej[j][0], qv[1] * Ej[j][1]);
                    *(REC_LAS unsigned*)(lds + OFF_KB + t * QP + lane * 4) = cvt2(ko[0], ko[1]);
                }
                const float kh0 = ko[0] * Eend[0], kh1 = ko[1] * Eend[1];
                if (e & 1) { khw[0][e >> 1] = cvt2(__uint_as_float(khw[0][e >> 1]), kh0); khw[1][e >> 1] = cvt2(__uint_as_float(khw[1][e >> 1]), kh1);
                             vtw[0][e >> 1] = (vtw[0][e >> 1] >> 16) | (cv[e] << 16); vtw[1][e >> 1] = (vtw[1][e >> 1] >> 16) | (cv[e] & 0xffff0000u); }
                else { khw[0][e >> 1] = __float_as_uint(kh0); khw[1][e >> 1] = __float_as_uint(kh1); vtw[0][e >> 1] = cv[e] << 16; vtw[1][e >> 1] = cv[e] & 0xffff0000u; }
            }
#pragma unroll
            for (int dd = 0; dd < 2; ++dd) {
                *(REC_LAS u32x4*)(lds + OFF_KHT + (2 * lane + dd) * TP + wv * 16) = (u32x4){khw[dd][0], khw[dd][1], khw[dd][2], khw[dd][3]};
                *(REC_LAS u32x4*)(lds + OFF_VT + (2 * lane + dd) * TP + wv * 16) = (u32x4){vtw[dd][0], vtw[dd][1], vtw[dd][2], vtw[dd][3]};
            }
            if (wv == 0) *(REC_LAS f32x2*)(lds + OFF_DL + 2 * lane * 4) = (f32x2){ex2(bl[0]), ex2(bl[1])};
            dsum[0] += bl[0]; dsum[1] += bl[1];
            __syncthreads();
            if (OUT) {
#pragma unroll 1
                for (int blk = wv; blk < 10; blk += 8) {
                    const int i = blk < 1 ? 0 : blk < 3 ? 1 : blk < 6 ? 2 : 3, j = blk - (i * (i + 1)) / 2;
                    f32x4 a = {0.f, 0.f, 0.f, 0.f};
                    const REC_LAS unsigned char* ka = lds + OFF_KB + (16 * j + fr) * QP + fg * 16;
                    const REC_LAS unsigned char* qa = lds + qv_off(j) + (16 * (i - j) + fr) * QP + fg * 16;
#pragma unroll
                    for (int kk = 0; kk < 4; ++kk) a = __builtin_amdgcn_mfma_f32_16x16x32_bf16(*(const REC_LAS bf16x8*)(ka + kk * 64), *(const REC_LAS bf16x8*)(qa + kk * 64), a, 0, 0, 0);
                    if (i == j) {
#pragma unroll
                        for (int e = 0; e < 4; ++e) a[e] = (4 * fg + e <= fr) ? a[e] : 0.f; }
                    u32x2 w2; w2.x = cvt2(a[0], a[1]); w2.y = cvt2(a[2], a[3]);
                    *(REC_LAS u32x2*)(lds + OFF_AM + (16 * i + fr) * TP + (16 * j + 4 * fg) * 2) = w2;
                }
                __syncthreads();
            }
            u32x4 gq0 = {0u, 0u, 0u, 0u}, gq1 = {0u, 0u, 0u, 0u};
            if (OUT) { const unsigned short* gp_ = Gp + row0 + (size_t)(64 * c + er) * RD + es * 16; gq0 = *(const u32x4*)gp_; gq1 = *(const u32x4*)(gp_ + 8); }
            bf16x8 vb[2];
#pragma unroll
            for (int kk = 0; kk < 2; ++kk) vb[kk] = *(const REC_LAS bf16x8*)(lds + OFF_VT + (16 * wv + fr) * TP + kk * 64 + fg * 16);
            if (OUT) {
                bf16x8 sb[4];
#pragma unroll
                for (int k4 = 0; k4 < 4; ++k4) { u32x4 w4; w4.x = cvt2(st[2 * k4][0], st[2 * k4][1]); w4.y = cvt2(st[2 * k4][2], st[2 * k4][3]); w4.z = cvt2(st[2 * k4 + 1][0], st[2 * k4 + 1][1]); w4.w = cvt2(st[2 * k4 + 1][2], st[2 * k4 + 1][3]);
                    sb[k4] = __builtin_bit_cast(bf16x8, w4); }
#pragma unroll
                for (int mt = 0; mt < 4; ++mt) {
                    f32x4 acc = {0.f, 0.f, 0.f, 0.f};
#pragma unroll
                    for (int kk = 0; kk < 2; ++kk) if (kk <= (mt >> 1))
                        acc = __builtin_amdgcn_mfma_f32_16x16x32_bf16(*(const REC_LAS bf16x8*)(lds + OFF_AM + (16 * mt + fr) * TP + kk * 64 + fg * 16), vb[kk], acc, 0, 0, 0);
#pragma unroll
                    for (int k4 = 0; k4 < 4; ++k4) {
                        const REC_LAS unsigned char* qa = lds + (16 * mt + fr) * QP + k4 * 64 + fg * 8;
                        const u32x2 lo2 = *(const REC_LAS u32x2*)qa, hi2 = *(const REC_LAS u32x2*)(qa + 32);
                        const u32x4 w4 = {lo2.x, lo2.y, hi2.x, hi2.y};
                        acc = __builtin_amdgcn_mfma_f32_16x16x32_bf16(__builtin_bit_cast(bf16x8, w4), sb[k4], acc, 0, 0, 0);
                    }
#pragma unroll
                    for (int e = 0; e < 4; ++e) *(REC_LAS unsigned short*)(lds + OFF_SO + (16 * mt + 4 * fg + e) * QP + (16 * wv + fr) * 2) = (unsigned short)(cvt2(acc[e], 0.f) & 0xffffu);
                }
            }
#pragma unroll
            for (int kt = 0; kt < 8; ++kt) {
                const f32x4 dl4 = *(const REC_LAS f32x4*)(lds + OFF_DL + (16 * kt + 4 * fg) * 4);
                st[kt] = st[kt] * dl4;
#pragma unroll
                for (int kk = 0; kk < 2; ++kk)
                    st[kt] = __builtin_amdgcn_mfma_f32_16x16x32_bf16(*(const REC_LAS bf16x8*)(lds + OFF_KHT + (16 * kt + fr) * TP + kk * 64 + fg * 16), vb[kk], st[kt], 0, 0, 0);
            }
            if (OUT) { __syncthreads();
                REC_FLUSH(c, gq0, gq1); }
        }
        if (!OUT) {
            float* U = Ug + ((size_t)u << 14);
#pragma unroll
            for (int kt = 0; kt < 8; ++kt) *(f32x4*)(U + ((kt * 8 + wv) * 64 + lane) * 4) = st[kt];
            if (wv == 0) *(f32x2*)(Dg + u * 128 + 2 * lane) = (f32x2){ex2(dsum[0]), ex2(dsum[1])};
        }
        __syncthreads();
    }
}
#undef REC_FLUSH
#undef REC_LAS
}
#define GAS __attribute__((address_space(1)))
#define LAS __attribute__((address_space(3)))
typedef unsigned short bf16;
typedef unsigned v4u __attribute__((ext_vector_type(4)));
typedef float f32x4 __attribute__((ext_vector_type(4)));
typedef short bf16x8 __attribute__((ext_vector_type(8)));
typedef GAS unsigned gu32;
typedef GAS unsigned long long gu64;
#define RLX_AGENT __ATOMIC_RELAXED, __HIP_MEMORY_SCOPE_AGENT
#define LDS_WAIT() asm volatile("s_waitcnt lgkmcnt(0)" ::: "memory")
#define VM_WAIT() asm volatile("s_waitcnt vmcnt(0)" ::: "memory")
__device__ __forceinline__ unsigned long long rt() { return __builtin_amdgcn_s_memrealtime(); }
__device__ __forceinline__ unsigned f2bf(float f) { unsigned u = __builtin_bit_cast(unsigned, f); return (u + 0x7fffu + ((u >> 16) & 1u)) >> 16; }
__device__ __forceinline__ unsigned pk2(float lo, float hi) { return f2bf(lo) | (f2bf(hi) << 16); }
#define XB_TMO      128
#define XB_XCNT(j)  (256  + 64 * (j))
#define XB_XSUB(j)  (1280 + 64 * (j))
#define XB_XGEN(j)  (2304 + 64 * (j))
#define XB_TOP      3328
#define XB_TOPGEN   3392
#define XCD_BAR_WORDS 3456
#define XB_SPIN_CAP (1u << 18)

__device__ __forceinline__ unsigned xb_ld(unsigned* p)              { return __hip_atomic_load(p, __ATOMIC_RELAXED, __HIP_MEMORY_SCOPE_AGENT); }
__device__ __forceinline__ unsigned xb_add(unsigned* p, unsigned v) { return __hip_atomic_fetch_add(p, v, __ATOMIC_RELAXED, __HIP_MEMORY_SCOPE_AGENT); }
__device__ __forceinline__ unsigned xb_xcc_id() { return (unsigned)__builtin_amdgcn_s_getreg((3 << 11) | 20) & 0xFu; }
#define XB_SPIN(cond, bar) do { unsigned _sp = 0; while (cond) { __builtin_amdgcn_s_sleep(1); \
    if ((++_sp & 255u) == 0u) { if (xb_ld(&(bar)[XB_TMO])) break; if (_sp > XB_SPIN_CAP) { atomicAdd(&(bar)[XB_TMO], 1u); break; } } } } while (0)

struct XcdBarrier {
    unsigned* bar; unsigned x;
    volatile LAS unsigned* st;
};

__device__ __forceinline__ XcdBarrier xcd_barrier_post(unsigned* bar, volatile LAS unsigned* st) {
    XcdBarrier b; b.bar = bar; b.x = xb_xcc_id(); b.st = st;
    if (threadIdx.x == 0) (void)xb_add(&bar[XB_XCNT(b.x)], 1u);
    return b;
}
__device__ __forceinline__ void xcd_barrier_complete(unsigned* bar, unsigned x, unsigned& nloc, unsigned& nx) {
    const unsigned G = gridDim.x * gridDim.y * gridDim.z;
    unsigned sum, cnt, mine, sp = 0u;
    for (;;) {
        sum = 0u; cnt = 0u; mine = 0u;
#pragma unroll
        for (unsigned j = 0; j < 16; ++j) { const unsigned c = xb_ld(&bar[XB_XCNT(j)]); sum += c; cnt += (c > 0u) ? 1u : 0u; mine = (j == x) ? c : mine; }
        if (sum == G) break;
        __builtin_amdgcn_s_sleep(1);
        if ((++sp & 255u) == 0u) { if (xb_ld(&bar[XB_TMO])) break; if (sp > XB_SPIN_CAP) { atomicAdd(&bar[XB_TMO], 1u); break; } }
    }
    nloc = mine > 0u ? mine : 1u; nx = cnt > 0u ? cnt : 1u;
}

__device__ __forceinline__ void xcd_barrier(const XcdBarrier& b, const bool leader  ) {
    asm volatile("s_waitcnt vmcnt(0)" ::: "memory");
    __syncthreads();
    if (leader) {
        unsigned* bar = b.bar;
        __builtin_amdgcn_s_waitcnt(0);
        unsigned nloc = b.st[0], nx = b.st[1];
        if (nloc == 0u) { xcd_barrier_complete(bar, b.x, nloc, nx); b.st[0] = nloc; b.st[1] = nx; }
        const unsigned old = xb_add(&bar[XB_XSUB(b.x)], 1u);
        const unsigned gen = old / nloc;
        if (old + 1u == (gen + 1u) * nloc) {
            __builtin_amdgcn_fence(__ATOMIC_RELEASE, "agent");
            asm volatile("s_waitcnt vmcnt(0)" ::: "memory");
            const unsigned og = xb_add(&bar[XB_TOP], 1u);
            const unsigned tg = og / nx;
            if (og + 1u == (tg + 1u) * nx) xb_add(&bar[XB_TOPGEN], 1u);
            else XB_SPIN(xb_ld(&bar[XB_TOPGEN]) == tg, bar);
            __builtin_amdgcn_fence(__ATOMIC_ACQUIRE, "agent");
            xb_add(&bar[XB_XGEN(b.x)], 1u);
            asm volatile("s_waitcnt vmcnt(0)" ::: "memory");
        } else {
            XB_SPIN(xb_ld(&bar[XB_XGEN(b.x)]) == gen, bar);
            __builtin_amdgcn_fence(__ATOMIC_ACQUIRE, "agent");
            asm volatile("s_waitcnt vmcnt(0)" ::: "memory");
        }
    }
    __syncthreads();
}
#define PROBE_MODE 0
constexpr int NWAVES = 8;
#ifndef ONE_LAUNCH
#define ONE_LAUNCH 1
#endif
constexpr int BATCH = 4, T = 4096, D = 2048, H = 16, HD = 128;
constexpr int M = BATCH * T;
constexpr int NPA = 8192;
constexpr float EPS = 1e-6f;
constexpr size_t MiB = 1u << 20;
constexpr size_t WS_CTL = 0, CTL_ZERO_BYTES = 1 * MiB;
constexpr size_t WS_WINA = 2 * MiB;
constexpr size_t WS_WOUTA = 66 * MiB;
constexpr size_t WS_WKVQ = 82 * MiB;
constexpr size_t WS_WINB1 = 114 * MiB;
constexpr size_t WS_WOUTB = 130 * MiB;
constexpr size_t WS_XN = 146 * MiB;
constexpr size_t WS_PROJ = 210 * MiB;
constexpr size_t WS_FZ = 466 * MiB;
constexpr size_t WS_F = 467 * MiB;
constexpr size_t WS_WF = 481 * MiB;
constexpr size_t WS_U = 468 * MiB;
constexpr size_t WS_DG = 480 * MiB;
constexpr size_t WS_END = 482 * MiB;
constexpr size_t SLOT = (size_t)M * D;
constexpr int CW_TMO = 0, CW_CODE = 1;
constexpr int CW_BAR = 4096;
constexpr int CW_ATT = 16384;
constexpr int CW_SS = 32768;
constexpr int RING_OFF = 0, RING_BYTES = 131072;
constexpr int SCRATCH_BYTES = 139264;
constexpr int LDSCTL_OFF = SCRATCH_BYTES, MISC_OFF = LDSCTL_OFF + 320;
constexpr int LDS_BYTES = 147456;
static_assert(MISC_OFF + 128 <= LDS_BYTES, "LDS map");

struct Frame {
    LAS unsigned char* lds;
    volatile LAS unsigned* MISC;
    gu32* ctl;
    int tid, lane, wave;
    int vcu, G;
};
__device__ __forceinline__ void phase_tid(Frame& F) { int l; asm volatile("v_mbcnt_lo_u32_b32 %0, -1, 0\n\tv_mbcnt_hi_u32_b32 %0, -1, %0" : "=v"(l)); const int t = F.wave * 64 + l; F.tid = t; F.lane = l; }

__device__ __forceinline__ float wave_sum(float v) {
#pragma unroll
    for (int o = 1; o < 64; o <<= 1) v += __shfl_xor(v, o);
    return v;
}
__device__ __forceinline__ float bf2f(unsigned short b) { return __uint_as_float((unsigned)b << 16); }
__device__ __forceinline__ float bflo(unsigned w) { return __uint_as_float(w << 16); }
__device__ __forceinline__ float bfhi(unsigned w) { return __uint_as_float(w & 0xffff0000u); }

__device__ __forceinline__ void p0_transpose_item(const float* W, int ldw, int ncols, const float* nw, bf16* WT, LAS float* scr, int item, int lane) {
    const int nblk = ncols / 64, kb = item / nblk, nb = item % nblk, k0 = 64 * kb, n0 = 64 * nb;
    const int a = lane & 15, b = lane >> 4;
#pragma unroll 4
    for (int i = 0; i < 16; ++i) { const int k = 4 * i + b; const float s = nw ? nw[k0 + k] : 1.f;
        const f32x4 v = *(const GAS f32x4*)(W + (size_t)(k0 + k) * ldw + n0 + 4 * a);
        scr[(4 * a + 0) * 65 + k] = v.x * s; scr[(4 * a + 1) * 65 + k] = v.y * s; scr[(4 * a + 2) * 65 + k] = v.z * s; scr[(4 * a + 3) * 65 + k] = v.w * s; }
    LDS_WAIT(); asm volatile("" ::: "memory");
    const int c = lane & 7;
#pragma unroll 4
    for (int j = 0; j < 8; ++j) { const int n = (lane >> 3) + 8 * j; const LAS float* s = scr + n * 65 + 8 * c;
        v4u o; o.x = pk2(s[0], s[1]); o.y = pk2(s[2], s[3]); o.z = pk2(s[4], s[5]); o.w = pk2(s[6], s[7]);
        *(GAS v4u*)(WT + (size_t)(n0 + n) * D + k0 + 8 * c) = o; }
    LDS_WAIT(); asm volatile("" ::: "memory");
}
__device__ __forceinline__ void xb_rows(Frame& F, const float* xin, bf16* xb, unsigned long long* ss) {
    const int gw = F.vcu * NWAVES + F.wave, NGW = F.G * NWAVES;
    for (int m = gw; m < M; m += NGW) {
        const GAS f32x4* xr = (const GAS f32x4*)(xin + (size_t)m * D) + F.lane;
        f32x4 v[8]; float s = 0.f;
#pragma unroll
        for (int j = 0; j < 8; ++j) { v[j] = xr[64 * j]; s += (v[j].x * v[j].x + v[j].y * v[j].y) + (v[j].z * v[j].z + v[j].w * v[j].w); }
        s = wave_sum(s);
        GAS unsigned long long* o8 = (GAS unsigned long long*)(xb + (size_t)m * D) + F.lane;
#pragma unroll
        for (int j = 0; j < 8; ++j) o8[64 * j] = (unsigned long long)pk2(v[j].x, v[j].y) | ((unsigned long long)pk2(v[j].z, v[j].w) << 32);
        if (F.lane == 0) ss[m] = (unsigned long long)(s * 16777216.0f);
    }
}
__device__ __forceinline__ void p0_prologue(Frame& F, const float* const* in, unsigned char* ws) {
    LAS float* scr = (LAS float*)(F.lds + RING_OFF + F.wave * 16640);
    const int gw = F.vcu * NWAVES + F.wave, NGW = F.G * NWAVES;
    constexpr int I_INA = 32 * 128, I_SQ = 32 * 32, I_4K = 32 * 64;
    constexpr int NITEMS = 2 * I_INA + 2 * I_SQ + 3 * I_4K + 2 * I_SQ;
    for (int it = gw; it < NITEMS; it += NGW) {
        int r = it;
        if (r < 2 * I_INA) { const int l = r / I_INA; r -= l * I_INA; p0_transpose_item(in[2] + (size_t)l * D * NPA, NPA, NPA, in[1] + l * D, (bf16*)(ws + WS_WINA) + (size_t)l * NPA * D, scr, r, F.lane); continue; } r -= 2 * I_INA;
        if (r < 2 * I_SQ) { const int l = r / I_SQ; r -= l * I_SQ; p0_transpose_item(in[5] + (size_t)l * D * D, D, D, nullptr, (bf16*)(ws + WS_WOUTA) + (size_t)l * D * D, scr, r, F.lane); continue; } r -= 2 * I_SQ;
        if (r < I_4K) { p0_transpose_item(in[7], 2 * D + H, 2 * D, in[6], (bf16*)(ws + WS_WKVQ), scr, r, F.lane); continue; } r -= I_4K;
        if (r < I_4K) { p0_transpose_item(in[11], 2 * D, 2 * D, in[10], (bf16*)(ws + WS_WKVQ) + (size_t)2 * D * D, scr, r, F.lane); continue; } r -= I_4K;
        if (r < I_4K) { p0_transpose_item(in[11] + (size_t)D * 2 * D, 2 * D, 2 * D, in[10] + D, (bf16*)(ws + WS_WINB1), scr, r, F.lane); continue; } r -= I_4K;
        { const int l = r / I_SQ; r -= l * I_SQ; p0_transpose_item(in[14] + (size_t)l * D * D, D, D, nullptr, (bf16*)(ws + WS_WOUTB) + (size_t)l * D * D, scr, r, F.lane); }
    }
    for (int idx = (F.vcu * NWAVES + F.wave) * 64 + F.lane; idx < H * D; idx += NGW * 64) { const int n = idx / D, k = idx % D;
        ((bf16*)(ws + WS_WF))[idx] = (bf16)f2bf(in[7][(size_t)k * (2 * D + H) + 2 * D + n] * in[6][k]); }
    xb_rows(F, in[0], (bf16*)(ws + WS_XN), (unsigned long long*)(F.ctl + CW_SS));
}
__device__ __forceinline__ float sum16(float v) { v += __shfl_xor(v, 1); v += __shfl_xor(v, 2); v += __shfl_xor(v, 4); v += __shfl_xor(v, 8); return v; }
__device__ __forceinline__ void headnorm_rows(Frame& F, bf16* X, const float* w) {
    const int gw = F.vcu * NWAVES + F.wave, NGW = F.G * NWAVES;
    for (int m = gw; m < M; m += NGW) {
        GAS v4u* xr = (GAS v4u*)(X + (size_t)m * D) + F.lane;
#pragma unroll
        for (int j = 0; j < 4; ++j) {
            const v4u x = xr[64 * j]; float f[8] = {bflo(x.x), bfhi(x.x), bflo(x.y), bfhi(x.y), bflo(x.z), bfhi(x.z), bflo(x.w), bfhi(x.w)};
            float s = 0.f;
#pragma unroll
            for (int e = 0; e < 8; ++e) s += f[e] * f[e];
            const float r = 1.0f / sqrtf(sum16(s) * (1.f / HD) + EPS);
            const int d0 = (8 * F.lane) & 127;
            const f32x4 w0 = *(const f32x4*)(w + d0), w1 = *(const f32x4*)(w + d0 + 4);
            v4u o; o.x = pk2(f[0] * r * w0.x, f[1] * r * w0.y); o.y = pk2(f[2] * r * w0.z, f[3] * r * w0.w); o.z = pk2(f[4] * r * w1.x, f[5] * r * w1.y); o.w = pk2(f[6] * r * w1.z, f[7] * r * w1.w);
            xr[64 * j] = o;
        }
    }
}
__device__ __forceinline__ float silu_f(float g) { return g / (1.f + __expf(-g)); }
__device__ __forceinline__ void gatenorm_rows(Frame& F, bf16* O, const bf16* G, const float* w) {
    const int gw = F.vcu * NWAVES + F.wave, NGW = F.G * NWAVES;
    for (int m = gw; m < M; m += NGW) {
        GAS v4u* xr = (GAS v4u*)(O + (size_t)m * D) + F.lane; const GAS v4u* gr = (const GAS v4u*)(G + (size_t)m * D) + F.lane;
#pragma unroll
        for (int j = 0; j < 4; ++j) {
            const v4u x = xr[64 * j], g = gr[64 * j];
            float f[8] = {bflo(x.x), bfhi(x.x), bflo(x.y), bfhi(x.y), bflo(x.z), bfhi(x.z), bflo(x.w), bfhi(x.w)};
            const float q[8] = {bflo(g.x), bfhi(g.x), bflo(g.y), bfhi(g.y), bflo(g.z), bfhi(g.z), bflo(g.w), bfhi(g.w)};
            float s = 0.f;
#pragma unroll
            for (int e = 0; e < 8; ++e) s += f[e] * f[e];
            const float r = 1.0f / sqrtf(sum16(s) * (1.f / HD) + EPS);
            const int c0 = 8 * (F.lane + 64 * j);
            const f32x4 w0 = *(const f32x4*)(w + c0), w1 = *(const f32x4*)(w + c0 + 4);
            const float ww[8] = {w0.x, w0.y, w0.z, w0.w, w1.x, w1.y, w1.z, w1.w};
#pragma unroll
            for (int e = 0; e < 8; ++e) f[e] = f[e] * r * ww[e] * silu_f(q[e]);
            v4u o; o.x = pk2(f[0], f[1]); o.y = pk2(f[2], f[3]); o.z = pk2(f[4], f[5]); o.w = pk2(f[6], f[7]);
            xr[64 * j] = o;
        }
    }
}
__device__ __forceinline__ void fz_rows(Frame& F, const bf16* xb, const unsigned long long* ss, const bf16* wft, const float* fbias, float* fzls) {
    LAS f32x4* red = (LAS f32x4*)(F.lds);
    const int grp = F.wave & 3, kh = F.wave >> 2, r = F.lane & 15, g = F.lane >> 4;
    for (int rb = F.vcu; rb < M / 64; rb += F.G) {
        const int R0 = 64 * rb + 16 * grp;
        const GAS v4u* ap = (const GAS v4u*)(xb + (size_t)(R0 + r) * D + 1024 * kh + 8 * g);
        const GAS v4u* bp = (const GAS v4u*)(wft + (size_t)r * D + 1024 * kh + 8 * g);
        f32x4 acc = {0.f, 0.f, 0.f, 0.f};
#pragma unroll 8
        for (int s = 0; s < 32; ++s) { const v4u av = ap[4 * s], bv = bp[4 * s];
            acc = __builtin_amdgcn_mfma_f32_16x16x32_bf16(__builtin_bit_cast(bf16x8, av), __builtin_bit_cast(bf16x8, bv), acc, 0, 0, 0); }
        if (kh == 1) red[grp * 64 + F.lane] = acc;
        __syncthreads();
        if (kh == 0) { const f32x4 o = acc + red[grp * 64 + F.lane]; const float bz = fbias[r];
#pragma unroll
            for (int e = 0; e < 4; ++e) { const int row = R0 + 4 * g + e;
                const float z = o[e] * (1.0f / sqrtf((float)ss[row] * (1.0f / 16777216.0f) * (1.f / D) + EPS)) + bz;
                fzls[(size_t)row * 16 + r] = fminf(z, 0.f) - __logf(1.f + __expf(-fabsf(z))); } }
        __syncthreads();
    }
}
__device__ __forceinline__ void fscan(Frame& F, const float* fzls, float* Fo) {
    LAS float* wt = (LAS float*)(F.lds);
    for (int u = blockIdx.x; u < BATCH * H; u += F.G) {
        const int b = u / H, h = u % H, t0 = F.tid * 8;
        float v[8];
#pragma unroll
        for (int e = 0; e < 8; ++e) v[e] = fzls[(size_t)(b * T + t0 + e) * 16 + h];
#pragma unroll
        for (int e = 1; e < 8; ++e) v[e] += v[e - 1];
        float incl = v[7];
#pragma unroll
        for (int o = 1; o < 64; o <<= 1) { const float n = __shfl_up(incl, o); if (F.lane >= o) incl += n; }
        if (F.lane == 63) wt[F.wave] = incl;
        __syncthreads();
        float base = incl - v[7];
        for (int w = 0; w < F.wave; ++w) base += wt[w];
#pragma unroll
        for (int e = 0; e < 8; ++e) Fo[(size_t)u * T + t0 + e] = -(v[e] + base) * fox::INVS;
        __syncthreads();
    }
}
__device__ __forceinline__ fox::BlockRef attn_ref(int L, const bf16* Q, const bf16* K, const bf16* V, bf16* O, const bf16* G, const float* wo, const float* Fc, float TH) {
    const int bh = L & 63, qb = 15 - (L >> 6), b = bh / H, h = bh % H;
    fox::BlockRef r; const size_t base = (size_t)b * T * D + h * HD;
    r.Q = (const fox::bf16*)Q + base + (size_t)qb * 256 * D; r.O = (fox::bf16*)O + base + (size_t)qb * 256 * D; r.K = (const fox::bf16*)K + base; r.V = (const fox::bf16*)V + base;
    r.G = (const fox::bf16*)G + base + (size_t)qb * 256 * D; r.wo = wo + h * HD;
    r.F = Fc + (size_t)bh * T; r.P0 = qb * 256; r.jlo = fox::fox_jlo(r.F, r.P0, TH); return r;
}
__device__ __forceinline__ float attn_threshold(Frame& F, const float* wq, const float* wk) {
    float a = fmaxf(fabsf(wq[F.lane]), fabsf(wq[F.lane + 64])), c = fmaxf(fabsf(wk[F.lane]), fabsf(wk[F.lane + 64]));
#pragma unroll
    for (int o = 1; o < 64; o <<= 1) { a = fmaxf(a, __shfl_xor(a, o)); c = fmaxf(c, __shfl_xor(c, o)); }
    return 2.f * (128.f * 1.02f * a * c) + 152.f / (1.4426950408889634f * fox::SCALE);
}
__device__ __forceinline__ void attn_phase(Frame& F, char* lds, const bf16* Q, const bf16* K, const bf16* V, bf16* O, const bf16* G, const float* wo, const float* wq, const float* Fc, gu32* ctr, float TH) {
    constexpr int total = BATCH * H * 16;
    volatile LAS int* tk = (volatile LAS int*)(F.lds + 69632);
    if (F.tid == 0) { tk[0] = (int)__hip_atomic_fetch_add(ctr, 1u, RLX_AGENT); tk[1] = (int)__hip_atomic_fetch_add(ctr, 1u, RLX_AGENT); }
    __syncthreads();
    int Lc = __builtin_amdgcn_readfirstlane(tk[0]), Ln = __builtin_amdgcn_readfirstlane(tk[1]);
    if (Lc >= total) return;
    fox::BlockRef cur = attn_ref(Lc, Q, K, V, O, G, wo, Fc, TH);
    fox::Seam S;
    fox::causal_prime(cur, lds, S, F.wave);
    for (int i = 0;; ++i) {
        if (F.wave == 0 && fox::fresh_lane() == 0) tk[2 + (i & 1)] = (int)__hip_atomic_fetch_add(ctr, 1u, RLX_AGENT);
        const bool has_next = Ln < total;
        const fox::BlockRef nxt = has_next ? attn_ref(Ln, Q, K, V, O, G, wo, Fc, TH) : cur;
        fox::causal_block(cur, nxt, lds, S, wq, F.wave);
        if (!has_next) break;
        const int L2 = __builtin_amdgcn_readfirstlane(tk[2 + (i & 1)]);
        cur = nxt; Lc = Ln; Ln = L2;
    }
}

constexpr int NPHASE = 29;
__host__ __device__ constexpr bool phase_live(int id) {
    if (id == 0) return true;
    const int L = (id - 1) / 7, s = (id - 1) % 7;
    if (s == 1) return L == 2;
    if (s == 2) return L <= 2;
    if (s == 6) return false;
    if (s == 4) return false;
    return true;
}
struct Args { const float* in[15]; float* out; unsigned char* ws; int ph_lo, ph_hi; };
__global__ void __launch_bounds__(NWAVES * 64, 2) fwd_kernel(Args args) {
    extern __shared__ __attribute__((aligned(16))) unsigned char lds[];
    Frame F;
    F.lds = (LAS unsigned char*)lds;
    F.MISC = (volatile LAS unsigned*)(F.lds + MISC_OFF);
    F.wave = __builtin_amdgcn_readfirstlane((int)threadIdx.x >> 6); phase_tid(F);
    F.G = gridDim.x; { const int bx = blockIdx.x; F.vcu = (F.G % 8 == 0) ? (bx % 8) * (F.G / 8) + bx / 8 : bx; }
    unsigned char* ws = args.ws;
    F.ctl = (gu32*)(ws + WS_CTL);
    for (int u = F.tid; u < (LDS_BYTES - LDSCTL_OFF) / 4; u += NWAVES * 64) ((LAS unsigned*)(F.lds + LDSCTL_OFF))[u] = 0u;
    __syncthreads();
#if ONE_LAUNCH
    XcdBarrier bar = xcd_barrier_post((unsigned*)(F.ctl + CW_BAR), F.MISC + 8);
#define GRID_BAR() do { phase_tid(F); xcd_barrier(bar, F.tid == 0); } while (0)
#else
#define GRID_BAR() do {} while (0)
#endif
    const int lo = args.ph_lo, hi = args.ph_hi;
#ifdef PROBE_PHASE
    unsigned long long pp_t0 = 0, pp_dt = 0;
#define PP_BEGIN(k) do { if ((k) == PROBE_PHASE) pp_t0 = __builtin_amdgcn_s_memrealtime(); } while (0)
#define PP_END(k) do { if ((k) == PROBE_PHASE) pp_dt = __builtin_amdgcn_s_memrealtime() - pp_t0; } while (0)
#else
#define PP_BEGIN(k) do {} while (0)
#define PP_END(k) do {} while (0)
#endif
#define IN(k) (lo <= (k) && (k) < hi)
#define SEAM(k) do { if ((k) + 1 < hi) GRID_BAR(); PP_END(k); } while (0)
    const float* const* in = args.in;
    bf16* XN = (bf16*)(ws + WS_XN); bf16* PROJ = (bf16*)(ws + WS_PROJ); unsigned long long* SS = (unsigned long long*)(F.ctl + CW_SS);
    float* FZ = (float*)(ws + WS_FZ); float* FC = (float*)(ws + WS_F);

    #ifndef NO_P0
    if (IN(0)) { PP_BEGIN(0); phase_tid(F); p0_prologue(F, in, ws); SEAM(0); }
#endif

#ifdef PROBE_CLK
    long long pc0 = 0; unsigned long long pr0 = 0, probe_us = 0;
#endif
#pragma unroll 1
    for (int L = 0; L < 4; ++L) {
        const int pb = 1 + 7 * L; const bool isA = L < 2; const int j = L & 1;
        PP_BEGIN(pb + 0);
        if (IN(pb + 0)) { phase_tid(F);
#ifdef PROBE_CLK
            if (L == PROBE_CLK - 1) { pc0 = clock64(); pr0 = __builtin_amdgcn_s_memrealtime(); }
#endif
            const bf16* Bt = isA ? (const bf16*)(ws + WS_WINA) + (size_t)j * NPA * D : (L == 2 ? (const bf16*)(ws + WS_WKVQ) : (const bf16*)(ws + WS_WINB1));
            const int N = (L == 3) ? 2 * D : NPA;
            bf16* outp = (L == 3) ? PROJ + 2 * SLOT : PROJ;
            pg8::Gemm g{XN, Bt, M, N, D}; pg8::StaticOrder S; S.init(M, N, F.G, (int)blockIdx.x);
            pg8::EpiBf16R E{outp, D, D, SLOT, SS + (size_t)L * M, 1.f / D, EPS};
#ifndef NO_G1
            pg8::gemm_phase<pg8::EpiBf16R, pg8::StaticOrder, true, true>(F.lds + RING_OFF, g, S, E, F.tid);
#ifdef DUP_GIN
            pg8::gemm_phase<pg8::EpiBf16R, pg8::StaticOrder, true, true>(F.lds + RING_OFF, g, S, E, F.tid);
#endif
#ifdef DUP_GIN_NOEPI
            { pg8::EpiNull E0;
#ifdef PROBE_L2RES
              pg8::RepeatOrder S2; S2.n = (M / 256) * (N / 256) / F.G; S2.c = (int)blockIdx.x;
              pg8::gemm_phase<pg8::EpiNull, pg8::RepeatOrder, true, true, false>(F.lds + RING_OFF, g, S2, E0, F.tid);
#else
              pg8::gemm_phase<pg8::EpiNull, pg8::StaticOrder, true, true, PROBE_BLK>(F.lds + RING_OFF, g, S, E0, F.tid);
#endif
            }
#endif
#endif
#ifdef PROBE_CLK
            if (L == PROBE_CLK - 1) { const long long dc = clock64() - pc0; const unsigned long long dr = __builtin_amdgcn_s_memrealtime() - pr0; probe_us = PROBE_MODE == 0 ? (unsigned long long)(dc * 100 / (long long)dr) : (unsigned long long)(dc / 256);
              if (PROBE_MODE >= 2 && threadIdx.x == 0) { if (PROBE_MODE == 2) atomicMax((unsigned*)(F.ctl + 2048), (unsigned)probe_us); else atomicMin((unsigned*)(F.ctl + 2048), 0x7fffffffu - (unsigned)probe_us); } }
#endif
            SEAM(pb + 0);
        }
        PP_BEGIN(pb + 1);
        if (IN(pb + 1) && L == 2) { phase_tid(F);
#ifndef NO_FZ
            if (L == 2) { fz_rows(F, XN, SS + (size_t)L * M, (const bf16*)(ws + WS_WF), in[8], FZ); headnorm_rows(F, PROJ, in[9]); }
#endif
            SEAM(pb + 1);
        }
        PP_BEGIN(pb + 2);
        if (IN(pb + 2) && L == 2) { phase_tid(F); fscan(F, FZ, FC); SEAM(pb + 2); }
        PP_BEGIN(pb + 2);
        if (IN(pb + 2) && isA) { phase_tid(F);
            rec::run<false>(F.lds + RING_OFF, F.G, PROJ, PROJ + SLOT, PROJ + 2 * SLOT, PROJ, in[3], L, (float*)(ws + WS_U), (float*)(ws + WS_DG), PROJ + 3 * SLOT, in[4] + j * D, F.tid);
#ifdef DUP_REC
            rec::run<false>(F.lds + RING_OFF, F.G, PROJ, PROJ + SLOT, PROJ + 2 * SLOT, PROJ, in[3], L, (float*)(ws + WS_U), (float*)(ws + WS_DG), PROJ + 3 * SLOT, in[4] + j * D, F.tid);
#endif
            SEAM(pb + 2);
        }
        PP_BEGIN(pb + 3);
        if (IN(pb + 3)) { phase_tid(F);
#ifndef NO_REC
            if (isA) rec::run<true>(F.lds + RING_OFF, F.G, PROJ, PROJ + SLOT, PROJ + 2 * SLOT, PROJ, in[3], L, (float*)(ws + WS_U), (float*)(ws + WS_DG), PROJ + 3 * SLOT, in[4] + j * D, F.tid);
#ifdef DUP_REC
            if (isA) rec::run<true>(F.lds + RING_OFF, F.G, PROJ, PROJ + SLOT, PROJ + 2 * SLOT, PROJ, in[3], L, (float*)(ws + WS_U), (float*)(ws + WS_DG), PROJ + 3 * SLOT, in[4] + j * D, F.tid);
#endif
#endif
#ifndef NO_ATT
            if (!isA) attn_phase(F, (char*)lds + RING_OFF, PROJ + 2 * SLOT, PROJ, PROJ + SLOT, PROJ + 2 * SLOT, PROJ + 3 * SLOT, in[13] + j * D, in[12] + j * HD, FC, F.ctl + CW_ATT + 64 * j, attn_threshold(F, in[12] + j * HD, in[9]));
#ifdef DUP_ATT
            if (!isA) { __syncthreads(); attn_phase(F, (char*)lds + RING_OFF, PROJ + 2 * SLOT, PROJ, PROJ + SLOT, PROJ + 2 * SLOT, PROJ + 3 * SLOT, in[13] + j * D, in[12] + j * HD, FC, F.ctl + CW_ATT + 64 * (j + 2), attn_threshold(F, in[12] + j * HD, in[9])); }
#endif
#endif
            SEAM(pb + 3);
        }
        bf16* OB = isA ? PROJ : PROJ + 2 * SLOT;
        if (false) { phase_tid(F); gatenorm_rows(F, OB, PROJ + 3 * SLOT, (isA ? in[4] : in[13]) + j * D); SEAM(pb + 4); }
        PP_BEGIN(pb + 5);
        if (IN(pb + 5)) { phase_tid(F);
            const bf16* Bt = (const bf16*)(ws + (isA ? WS_WOUTA : WS_WOUTB)) + (size_t)j * D * D;
            pg8::Gemm g{OB, Bt, M, D, D}; pg8::StaticOrder S; S.init(M, D, F.G, (int)blockIdx.x);
            pg8::EpiResB E{XN, D, L < 3 ? nullptr : args.out, SS + (size_t)(L + 1 < 4 ? L + 1 : 3) * M};
#ifndef NO_G2
            pg8::gemm_phase<pg8::EpiResB, pg8::StaticOrder, true, true>(F.lds + RING_OFF, g, S, E, F.tid);
#endif
            SEAM(pb + 5);
        }
    }
#ifdef PROBE_PHASE
    if (blockIdx.x == 0 && F.tid == 0) { const unsigned long long t0 = __builtin_amdgcn_s_memrealtime(); while (__builtin_amdgcn_s_memrealtime() - t0 < pp_dt) __builtin_amdgcn_s_sleep(10); }
#endif
#ifdef PROBE_CLK
    if (PROBE_MODE >= 2) { __syncthreads(); unsigned v = __hip_atomic_load((unsigned*)(F.ctl + 2048), __ATOMIC_RELAXED, __HIP_MEMORY_SCOPE_AGENT); probe_us = PROBE_MODE == 2 ? v : v; }
    if (blockIdx.x == 0 && F.tid == 0) { const unsigned long long t0 = __builtin_amdgcn_s_memrealtime(); while (__builtin_amdgcn_s_memrealtime() - t0 < probe_us * 100ull) __builtin_amdgcn_s_sleep(10); }
#endif
#undef IN
#undef SEAM
}

extern "C" void kernel_launch(void* const* d_in, const int* in_sizes, int n_in, void* d_out, int out_size, void* d_ws, size_t ws_size, hipStream_t stream) {
    static int grid = 0;
    if (grid == 0) {
        if (n_in != 15 || in_sizes[0] != M * D || out_size != M * D || ws_size < WS_END) { fprintf(stderr, "kernel_launch: unexpected shapes (n_in %d, in0 %d, out %d, ws %zu)\n", n_in, n_in > 0 ? in_sizes[0] : -1, out_size, ws_size); grid = -1; return; }
        int dev = 0, cus = 0;
        if (hipGetDevice(&dev) != hipSuccess || hipDeviceGetAttribute(&cus, hipDeviceAttributeMultiprocessorCount, dev) != hipSuccess) { grid = -1; return; }
        if (hipFuncSetAttribute((const void*)fwd_kernel, hipFuncAttributeMaxDynamicSharedMemorySize, LDS_BYTES) != hipSuccess) { fprintf(stderr, "kernel_launch: hipFuncSetAttribute failed\n"); grid = -1; return; }
        int per_cu = 0;
        if (hipOccupancyMaxActiveBlocksPerMultiprocessor(&per_cu, (const void*)fwd_kernel, NWAVES * 64, LDS_BYTES) != hipSuccess || per_cu < 1) fprintf(stderr, "kernel_launch: occupancy query says %d\n", per_cu);
        (void)hipGetLastError();
        grid = cus;
    }
    if (grid < 0) return;
    (void)hipMemsetAsync((char*)d_ws + WS_CTL, 0, CTL_ZERO_BYTES, stream);
    Args a{};
    for (int i = 0; i < 15; ++i) a.in[i] = (const float*)d_in[i];
    a.out = (float*)d_out; a.ws = (unsigned char*)d_ws;
#if ONE_LAUNCH
    a.ph_lo = 0; a.ph_hi = NPHASE;
    hipLaunchKernelGGL(fwd_kernel, dim3(grid), dim3(NWAVES * 64), LDS_BYTES, stream, a);
#else
    for (int p = 0; p < NPHASE; ++p) { if (!phase_live(p)) continue; a.ph_lo = p; a.ph_hi = p + 1; hipLaunchKernelGGL(fwd_kernel, dim3(grid), dim3(NWAVES * 64), LDS_BYTES, stream, a); }
#endif
}
```
